# Optimizing an MI355X kernel written in HIP

```python
import math
import jax, jax.numpy as jnp
from jax import lax
import numpy as np

D_MODEL = 1024
BATCH = 2
SEQ = 8192
DEPTH = 1

HEAD_DIM = 64
ROT_DIM = HEAD_DIM // 4
ROPE_THETA = 500000.0
BLOCK = 128
EPS = 1e-6
DIL_PAIRS = ((128, 1), (512, 4), (2048, 16))
A_SLOTS = 8
A_HEADS = A_SLOTS * len(DIL_PAIRS)
B_HEADS = 8
B_KV = 2
CMP_LEN = 32
CMP_STRIDE = 16
CMP_HIDDEN = 4 * HEAD_DIM
SEL_LEN = 64
SEL_TOP = 16
WIN_LEN = 512
FORCE = 1e4
D_FF = 4 * D_MODEL
A_QKV = 3 * A_HEADS * HEAD_DIM
B_Q = B_HEADS * HEAD_DIM
B_KV_COLS = 6 * B_KV * HEAD_DIM
B_GATE = 3 * B_HEADS
MERGE_GATE = 2 * D_MODEL
IN_COLS = A_QKV + B_Q + B_KV_COLS + B_GATE + MERGE_GATE

kernel_name = "hybrid_dilated_nsa_gated_block"


def rms_norm(x, g):
    xf = x.astype(jnp.float32)
    y = xf * lax.rsqrt(jnp.mean(xf * xf, axis=-1, keepdims=True) + EPS)
    return (y * g.astype(jnp.float32)).astype(x.dtype)


def rope_tables(seq):
    pos = jnp.arange(seq, dtype=jnp.float32)
    inv = ROPE_THETA ** (-jnp.arange(0, ROT_DIM, 2, dtype=jnp.float32) / ROT_DIM)
    ang = pos[:, None] * inv[None, :]
    return jnp.cos(ang), jnp.sin(ang)


def partial_rotary(x, cos, sin):
    half = ROT_DIM // 2
    c = cos[None, :, None, :].astype(x.dtype)
    s = sin[None, :, None, :].astype(x.dtype)
    x1 = x[..., :half]
    x2 = x[..., half:ROT_DIM]
    return jnp.concatenate([x1 * c - x2 * s, x2 * c + x1 * s, x[..., ROT_DIM:]], axis=-1)


def banded_attention(q, k, v, max_offset):
    n, L, H, hd = q.shape
    hk = k.shape[2]
    rep = H // hk
    n_prev = -(-max_offset // BLOCK)
    nb = -(-L // BLOCK)
    lp = nb * BLOCK
    pad_end = ((0, 0), (0, lp - L), (0, 0), (0, 0))
    q = jnp.pad(q, pad_end)
    front = ((0, 0), (n_prev * BLOCK, lp - L), (0, 0), (0, 0))
    kb = jnp.pad(k, front).reshape(n, nb + n_prev, BLOCK, hk, hd)
    vb = jnp.pad(v, front).reshape(n, nb + n_prev, BLOCK, hk, hd)
    kwin = jnp.concatenate([kb[:, o:o + nb] for o in range(n_prev + 1)], axis=2)
    vwin = jnp.concatenate([vb[:, o:o + nb] for o in range(n_prev + 1)], axis=2)
    qb = q.reshape(n, nb, BLOCK, hk, rep, hd)
    qpos = jnp.arange(nb)[:, None] * BLOCK + jnp.arange(BLOCK)[None, :]
    kpos = (jnp.arange(nb)[:, None] - n_prev) * BLOCK + jnp.arange((n_prev + 1) * BLOCK)[None, :]
    diff = qpos[:, :, None] - kpos[:, None, :]
    mask = (diff >= 0) & (diff <= max_offset) & (kpos[:, None, :] >= 0)
    s = jnp.einsum('bnqkrd,bnwkd->bnkrqw', qb, kwin,
                   preferred_element_type=jnp.float32) * (hd ** -0.5)
    s = jnp.where(mask[None, :, None, None], s, -1e30)
    m = jnp.max(s, axis=-1, keepdims=True)
    p = jnp.exp(s - m)
    den = jnp.sum(p, axis=-1, keepdims=True)
    o = jnp.einsum('bnkrqw,bnwkd->bnqkrd', (p / den).astype(v.dtype), vwin)
    lse = (m + jnp.log(den))[..., 0]
    o = o.reshape(n, lp, H, hd)[:, :L]
    lse = lse.transpose(0, 1, 4, 2, 3).reshape(n, lp, H)[:, :L]
    return o, lse


def dilated_attention(q, k, v):
    b, s_len, _, hd = q.shape
    outs, lses = [], []
    for g, (w, d) in enumerate(DIL_PAIRS):
        sl = slice(g * A_SLOTS, (g + 1) * A_SLOTS)

        def split(t):
            return t[:, :, sl].reshape(b, s_len // d, d, A_SLOTS, hd).transpose(0, 2, 1, 3, 4) \
                .reshape(b * d, s_len // d, A_SLOTS, hd)

        o, lse = banded_attention(split(q), split(k), split(v), w // d)
        outs.append(o.reshape(b, d, s_len // d, A_SLOTS, hd).transpose(0, 2, 1, 3, 4)
                    .reshape(b, s_len, A_SLOTS, hd))
        lses.append(lse.reshape(b, d, s_len // d, A_SLOTS).transpose(0, 2, 1, 3)
                    .reshape(b, s_len, A_SLOTS))
    wts = jax.nn.softmax(jnp.stack(lses, axis=0), axis=0)
    y = jnp.sum(wts[..., None] * jnp.stack(outs, axis=0).astype(jnp.float32), axis=0)
    return y.astype(q.dtype).reshape(b, s_len, A_SLOTS * hd)


def compress(t, pos_emb, w1, w2):
    b, s_len, g, hd = t.shape
    ch = t.reshape(b, s_len // CMP_STRIDE, CMP_STRIDE, g, hd)
    blocks = jnp.concatenate([ch[:, :-1], ch[:, 1:]], axis=2)
    blocks = blocks + pos_emb[None, None, :, None, :]
    nc = blocks.shape[1]
    flat = blocks.transpose(0, 1, 3, 2, 4).reshape(b, nc, g, CMP_LEN * hd)
    return jax.nn.gelu(flat @ w1) @ w2


def nsa_compressed_selected(q, kc, vc, ks, vs):
    b, s_len, hq, hd = q.shape
    g = kc.shape[2]
    rep = hq // g
    nc = kc.shape[1]
    ns = s_len // SEL_LEN
    n_sel = min(SEL_TOP, ns)
    nq = s_len // BLOCK
    scale = hd ** -0.5
    c_start = jnp.arange(nc) * CMP_STRIDE
    s_start = jnp.arange(ns) * SEL_LEN
    overlap = ((c_start[:, None] < s_start[None, :] + SEL_LEN) &
               (c_start[:, None] + CMP_LEN > s_start[None, :])).astype(jnp.float32)
    c_end = c_start + CMP_LEN - 1
    ks_b = ks.reshape(b, ns, SEL_LEN, g, hd).transpose(0, 3, 1, 2, 4)
    vs_b = vs.reshape(b, ns, SEL_LEN, g, hd).transpose(0, 3, 1, 2, 4)
    b_idx = jnp.arange(b)[:, None, None, None]
    g_idx = jnp.arange(g)[None, None, :, None]
    blk = jnp.arange(ns)
    tok = jnp.arange(SEL_LEN)
    qc = q.reshape(b, nq, BLOCK, g, rep, hd).transpose(1, 0, 2, 3, 4, 5)

    def chunk(args):
        q_c, c = args
        t = c * BLOCK + jnp.arange(BLOCK)
        s = jnp.einsum('bqgrd,bngd->bqgrn', q_c, kc, preferred_element_type=jnp.float32) * scale
        cmask = (c_end[None, :] <= t[:, None])[None, :, None, None, :]
        s = jnp.where(cmask, s, -1e30)
        p = jnp.where(cmask, jnp.exp(s - jnp.max(s, axis=-1, keepdims=True)), 0.0)
        p = p / jnp.maximum(jnp.sum(p, axis=-1, keepdims=True), 1e-30)
        o_cmp = jnp.einsum('bqgrn,bngd->bqgrd', p.astype(vc.dtype), vc)
        imp = jnp.einsum('bqgn,nm->bqgm', jnp.sum(p, axis=3), overlap)
        cur = (t // SEL_LEN)[:, None]
        forced = (blk[None, :] == 0) | (blk[None, :] == cur) | (blk[None, :] == cur - 1)
        imp = jnp.where(forced[None, :, None, :], FORCE, imp)
        imp = jnp.where((blk[None, :] > cur)[None, :, None, :], -FORCE, imp)
        _, idx = lax.top_k(imp, n_sel)
        ksel = ks_b[b_idx, g_idx, idx].reshape(b, BLOCK, g, n_sel * SEL_LEN, hd)
        vsel = vs_b[b_idx, g_idx, idx].reshape(b, BLOCK, g, n_sel * SEL_LEN, hd)
        kpos = (idx[..., None] * SEL_LEN + tok).reshape(b, BLOCK, g, n_sel * SEL_LEN)
        smask = (kpos <= t[None, :, None, None])[:, :, :, None, :]
        s2 = jnp.einsum('bqgrd,bqgkd->bqgrk', q_c, ksel, preferred_element_type=jnp.float32) * scale
        s2 = jnp.where(smask, s2, -1e30)
        p2 = jax.nn.softmax(s2, axis=-1)
        o_slc = jnp.einsum('bqgrk,bqgkd->bqgrd', p2.astype(vsel.dtype), vsel)
        return o_cmp, o_slc

    o_cmp, o_slc = lax.map(chunk, (qc, jnp.arange(nq)))
    o_cmp = o_cmp.transpose(1, 0, 2, 3, 4, 5).reshape(b, s_len, hq, hd)
    o_slc = o_slc.transpose(1, 0, 2, 3, 4, 5).reshape(b, s_len, hq, hd)
    return o_cmp, o_slc


def hybrid_layer(x, g_mix, w_in, cmp_pos_k, cmp_w1_k, cmp_w2_k, cmp_pos_v, cmp_w1_v, cmp_w2_v,
                 w_branch_a, w_branch_b, w_out, g_mlp, w_up, w_down, cos, sin):
    b, s_len, d = x.shape
    u = rms_norm(x, g_mix)
    proj = u @ w_in
    o1 = A_QKV
    o2 = o1 + B_Q
    o3 = o2 + B_KV_COLS
    o4 = o3 + B_GATE
    qkv_a, q_b, kv_b, gate_b, gate_m = jnp.split(proj, [o1, o2, o3, o4], axis=-1)
    qkv_a = qkv_a.reshape(b, s_len, 3, A_HEADS, HEAD_DIM)
    qa = partial_rotary(qkv_a[:, :, 0], cos, sin)
    ka = partial_rotary(qkv_a[:, :, 1], cos, sin)
    va = qkv_a[:, :, 2]
    q_b = partial_rotary(q_b.reshape(b, s_len, B_HEADS, HEAD_DIM), cos, sin)
    kv_b = kv_b.reshape(b, s_len, 6, B_KV, HEAD_DIM)
    k_cmp = partial_rotary(kv_b[:, :, 0], cos, sin)
    v_cmp = kv_b[:, :, 1]
    k_slc = partial_rotary(kv_b[:, :, 2], cos, sin)
    v_slc = kv_b[:, :, 3]
    k_win = partial_rotary(kv_b[:, :, 4], cos, sin)
    v_win = kv_b[:, :, 5]
    y_a = dilated_attention(qa, ka, va)
    kc = compress(k_cmp, cmp_pos_k, cmp_w1_k, cmp_w2_k)
    vc = compress(v_cmp, cmp_pos_v, cmp_w1_v, cmp_w2_v)
    o_cmp, o_slc = nsa_compressed_selected(q_b, kc, vc, k_slc, v_slc)
    o_win, _ = banded_attention(q_b, k_win, v_win, WIN_LEN - 1)
    gb = jax.nn.sigmoid(gate_b.reshape(b, s_len, B_HEADS, 3))
    y_b = (gb[..., 0:1] * o_cmp + gb[..., 1:2] * o_slc + gb[..., 2:3] * o_win).reshape(b, s_len, B_Q)
    gm = jax.nn.sigmoid(gate_m.reshape(b, s_len, 2, d))
    merged = gm[:, :, 0] * (y_a @ w_branch_a) + gm[:, :, 1] * (y_b @ w_branch_b)
    x = x + merged @ w_out
    h = rms_norm(x, g_mlp) @ w_up
    x = x + jnp.square(jax.nn.relu(h)) @ w_down
    return x


def setup_inputs(seed: int = 0) -> dict:
    key = jax.random.key(seed)
    ks = jax.random.split(key, 16)
    f = jnp.float32
    L = DEPTH

    def nrm(k, shape, fan_in):
        return jax.random.normal(k, shape, f) * (fan_in ** -0.5)

    hd = HEAD_DIM
    return {
        "x": jax.random.normal(ks[0], (BATCH, SEQ, D_MODEL), f),
        "norm_mix_g": 1.0 + 0.02 * jax.random.normal(ks[1], (L, D_MODEL), f),
        "w_in": nrm(ks[2], (L, D_MODEL, IN_COLS), D_MODEL),
        "cmp_pos_k": 0.02 * jax.random.normal(ks[3], (L, CMP_LEN, hd), f),
        "cmp_w1_k": nrm(ks[4], (L, CMP_LEN * hd, CMP_HIDDEN), CMP_LEN * hd),
        "cmp_w2_k": nrm(ks[5], (L, CMP_HIDDEN, hd), CMP_HIDDEN),
        "cmp_pos_v": 0.02 * jax.random.normal(ks[6], (L, CMP_LEN, hd), f),
        "cmp_w1_v": nrm(ks[7], (L, CMP_LEN * hd, CMP_HIDDEN), CMP_LEN * hd),
        "cmp_w2_v": nrm(ks[8], (L, CMP_HIDDEN, hd), CMP_HIDDEN),
        "w_branch_a": nrm(ks[9], (L, A_SLOTS * hd, D_MODEL), A_SLOTS * hd),
        "w_branch_b": nrm(ks[10], (L, B_Q, D_MODEL), B_Q),
        "w_out": nrm(ks[11], (L, D_MODEL, D_MODEL), D_MODEL),
        "norm_mlp_g": 1.0 + 0.02 * jax.random.normal(ks[12], (L, D_MODEL), f),
        "w_up": nrm(ks[13], (L, D_MODEL, D_FF), D_MODEL),
        "w_down": nrm(ks[14], (L, D_FF, D_MODEL), D_FF),
        "norm_final_g": 1.0 + 0.02 * jax.random.normal(ks[15], (D_MODEL,), f),
    }


def reference(x, norm_mix_g, w_in, cmp_pos_k, cmp_w1_k, cmp_w2_k, cmp_pos_v, cmp_w1_v, cmp_w2_v,
              w_branch_a, w_branch_b, w_out, norm_mlp_g, w_up, w_down, norm_final_g):
    cos, sin = rope_tables(x.shape[1])
    for l in range(DEPTH):
        x = hybrid_layer(x, norm_mix_g[l], w_in[l], cmp_pos_k[l], cmp_w1_k[l], cmp_w2_k[l],
                         cmp_pos_v[l], cmp_w1_v[l], cmp_w2_v[l], w_branch_a[l], w_branch_b[l],
                         w_out[l], norm_mlp_g[l], w_up[l], w_down[l], cos, sin)
    return rms_norm(x, norm_final_g)
```

```cpp
#include <hip/hip_runtime.h>
#include <hip/hip_cooperative_groups.h>
#include <cstdio>
#include <cstdint>
namespace cg = cooperative_groups;

namespace pg8 {
#define PG8_LAS __attribute__((address_space(3)))
typedef unsigned short bf16_t;
typedef short bf16x8 __attribute__((ext_vector_type(8)));
typedef float f32x4 __attribute__((ext_vector_type(4)));
typedef unsigned u32x4 __attribute__((ext_vector_type(4)));
constexpr int BM = 256, BK = 64, HALF = 128, HTB = HALF * BK * 2  , STAGE_BYTES = 8 * HTB, NXCD = 8, WGM = 8;

__host__ __device__ __forceinline__ int lds_byte(int r, int c) { const int st = (r >> 4) * 2 + (c >> 5), rr = r & 15, cc = c & 31, ob = rr * 64 + cc * 2; return st * 1024 + (ob ^ (((ob >> 9) & 1) << 5)); }
__host__ __device__ __forceinline__ void stage_rc(int b, int& R, int& C) { const int st = b / 1024, sb = b % 1024, swz = sb ^ (((sb >> 9) & 1) << 5); R = (st >> 1) * 16 + swz / 64; C = (st & 1) * 32 + (swz % 64) / 2; }
__host__ __device__ __forceinline__ int perm32(int rho) { const int n = rho >> 4, i = rho & 15; return 8 * (i >> 2) + 4 * n + (i & 3); }

struct Unit { int pm, pn; };
struct Gemm { const bf16_t* A; const bf16_t* Bt; int M, N, K; };

struct StaticOrder {
    int nM, nN, nwg, G, c;
    __host__ __device__ void init(int M, int N, int G_, int c_) { nM = M / BM; nN = N / BM; nwg = nM * nN; G = G_; c = c_; }
    __host__ __device__ bool next(int i, Unit& u) const {
        const long L = (long)i * G + c; if (L >= nwg) return false;
        int wgid = (int)L; { const int q = nwg / NXCD, r = nwg % NXCD, xcd = wgid % NXCD, off = wgid / NXCD; wgid = (xcd < r ? xcd * (q + 1) : r * (q + 1) + (xcd - r) * q) + off; }
        const int nig = WGM * nN, gid = wgid / nig, fm = gid * WGM, gsz = (nM - fm) < WGM ? (nM - fm) : WGM;
        u.pm = fm + ((wgid % nig) % gsz); u.pn = (wgid % nig) / gsz; return true;
    }
    __device__ __forceinline__ void a_ready(const Unit&) const {}
    __device__ __forceinline__ void done(const Unit&) const {}
};

__device__ __forceinline__ unsigned cvt_pk_bf16(float lo, float hi) { unsigned r; asm volatile("v_cvt_pk_bf16_f32 %0, %1, %2" : "=v"(r) : "v"(lo), "v"(hi)); return r; }
__device__ __forceinline__ float bf_lo(unsigned w) { return __builtin_bit_cast(float, w << 16); }
__device__ __forceinline__ float bf_hi(unsigned w) { return __builtin_bit_cast(float, w & 0xffff0000u); }
__device__ __forceinline__ float sigmoidf_(float x) { return __builtin_amdgcn_rcpf(1.f + __expf(-x)); }

struct EpiInProj {
    static constexpr bool PERM = true, AFTER_DRAIN = false;
    bf16_t* qkva; bf16_t* qb; bf16_t* kvb; bf16_t* gm; bf16_t* gb; const float* cs;
    __device__ __forceinline__ void operator()(const f32x4 (&acc)[2][2][4][2], const Unit& u, int wr, int wc, int fr, int fq) const {
        const int pn = u.pn;
        const int row0 = u.pm * BM + wr * 64 + fr;
        const bool rope_wave = !(wc & 1);
#pragma unroll
        for (int ai = 0; ai < 2; ++ai)
#pragma unroll
            for (int m = 0; m < 4; ++m) {
                const int row = row0 + ai * HALF + m * 16; const int b = row >> 13, s = row & 8191;
                f32x4 c0, c1, s0, s1;
                { const f32x4* t = (const f32x4*)(cs + (size_t)s * 16); c0 = t[0]; c1 = t[1]; s0 = t[2]; s1 = t[3]; }
#pragma unroll
                for (int bj = 0; bj < 2; ++bj) {
                    const int c = pn * BM + bj * HALF + wc * 32 + 8 * fq;
                    f32x4 v0 = acc[ai][bj][m][0], v1 = acc[ai][bj][m][1];
                    bool rope; bf16_t* dst;
                    if (pn < 18) { const int which = c / 1536, hc = c - which * 1536, head = hc >> 6, d0 = hc & 63, lg = (head >> 3) * 2;
                        const int prow = ((s & ((1 << lg) - 1)) << (13 - lg)) | (s >> lg);
                        dst = qkva + ((size_t)((((which * 24 + head) * 2 + b) << 13) + prow) << 6) + d0; rope = (pn < 12); }
                    else if (pn < 20) { dst = qb + (size_t)row * 512 + (c - 4608); rope = true; }
                    else if (pn < 23) { const int cc = c - 5120, j = cc >> 7, g = (cc >> 6) & 1, d0 = cc & 63;
                        dst = kvb + ((size_t)((((j * 4 + b * 2 + g)) << 13) + s) << 6) + d0; rope = (bj == 0); }
                    else if (pn < 31) { dst = gm + (size_t)row * 2048 + (c - 5888); rope = false; }
                    else { dst = gb + (size_t)row * 32 + (c - 7936); rope = false; }
                    if (rope && rope_wave) {
                        f32x4 p0, p1;
#pragma unroll
                        for (int e = 0; e < 4; ++e) { p0[e] = __shfl_xor(v0[e], 16); p1[e] = __shfl_xor(v1[e], 16); }
                        if (fq == 0) { v0 = v0 * c0 - p0 * s0; v1 = v1 * c1 - p1 * s1; }
                        else if (fq == 1) { v0 = v0 * c0 + p0 * s0; v1 = v1 * c1 + p1 * s1; }
                    }
                    if (pn < 31 || (bj == 0 && wc == 0)) {
                        u32x4 w; w.x = cvt_pk_bf16(v0[0], v0[1]); w.y = cvt_pk_bf16(v0[2], v0[3]); w.z = cvt_pk_bf16(v1[0], v1[1]); w.w = cvt_pk_bf16(v1[2], v1[3]);
                        *(u32x4*)dst = w; }
                }
            }
    }
};
template <int STEP> struct EpiMerge {
    static constexpr bool PERM = true, AFTER_DRAIN = false;
    const bf16_t* gm; float* tmp; bf16_t* merged;
    __device__ __forceinline__ void operator()(const f32x4 (&acc)[2][2][4][2], const Unit& u, int wr, int wc, int fr, int fq) const {
        const int row0 = u.pm * BM + wr * 64 + fr, col0 = u.pn * BM + wc * 32 + 8 * fq;
#pragma unroll
        for (int ai = 0; ai < 2; ++ai)
#pragma unroll
            for (int m = 0; m < 4; ++m)
#pragma unroll
                for (int bj = 0; bj < 2; ++bj) {
                    const int row = row0 + ai * HALF + m * 16, c = col0 + bj * HALF;
                    const u32x4 g = *(const u32x4*)(gm + (size_t)row * 2048 + (STEP - 1) * 1024 + c);
                    f32x4 v0 = acc[ai][bj][m][0], v1 = acc[ai][bj][m][1];
                    v0[0] *= sigmoidf_(bf_lo(g.x)); v0[1] *= sigmoidf_(bf_hi(g.x)); v0[2] *= sigmoidf_(bf_lo(g.y)); v0[3] *= sigmoidf_(bf_hi(g.y));
                    v1[0] *= sigmoidf_(bf_lo(g.z)); v1[1] *= sigmoidf_(bf_hi(g.z)); v1[2] *= sigmoidf_(bf_lo(g.w)); v1[3] *= sigmoidf_(bf_hi(g.w));
                    float* tp = tmp + (size_t)row * 1024 + c;
                    if (STEP == 1) { *(f32x4*)tp = v0; *(f32x4*)(tp + 4) = v1; }
                    else { v0 += *(const f32x4*)tp; v1 += *(const f32x4*)(tp + 4);
                        u32x4 w; w.x = cvt_pk_bf16(v0[0], v0[1]); w.y = cvt_pk_bf16(v0[2], v0[3]); w.z = cvt_pk_bf16(v1[0], v1[1]); w.w = cvt_pk_bf16(v1[2], v1[3]);
                        *(u32x4*)(merged + (size_t)row * 1024 + c) = w; }
                    __builtin_amdgcn_sched_barrier(0);
                }
    }
};
struct EpiResF32 {
    static constexpr bool PERM = true, AFTER_DRAIN = false;
    const float* res; float* out; int ldc;
    __device__ __forceinline__ void operator()(const f32x4 (&acc)[2][2][4][2], const Unit& u, int wr, int wc, int fr, int fq) const {
        const int row0 = u.pm * BM + wr * 64 + fr, col0 = u.pn * BM + wc * 32 + 8 * fq;
#pragma unroll
        for (int ai = 0; ai < 2; ++ai)
#pragma unroll
            for (int m = 0; m < 4; ++m)
#pragma unroll
                for (int bj = 0; bj < 2; ++bj) {
                    const size_t off = (size_t)(row0 + ai * HALF + m * 16) * ldc + col0 + bj * HALF;
                    const f32x4 r0 = *(const f32x4*)(res + off), r1 = *(const f32x4*)(res + off + 4);
                    *(f32x4*)(out + off) = r0 + acc[ai][bj][m][0]; *(f32x4*)(out + off + 4) = r1 + acc[ai][bj][m][1];
                    __builtin_amdgcn_sched_barrier(0);
                }
    }
};
struct EpiRelu2 {
    static constexpr bool PERM = true, AFTER_DRAIN = false;
    bf16_t* O; int ldc;
    __device__ __forceinline__ void operator()(const f32x4 (&acc)[2][2][4][2], const Unit& u, int wr, int wc, int fr, int fq) const {
        const int row0 = u.pm * BM + wr * 64 + fr, col0 = u.pn * BM + wc * 32 + 8 * fq;
#pragma unroll
        for (int ai = 0; ai < 2; ++ai)
#pragma unroll
            for (int m = 0; m < 4; ++m)
#pragma unroll
                for (int bj = 0; bj < 2; ++bj) {
                    f32x4 v0 = acc[ai][bj][m][0], v1 = acc[ai][bj][m][1];
#pragma unroll
                    for (int e = 0; e < 4; ++e) { const float a = fmaxf(v0[e], 0.f), b = fmaxf(v1[e], 0.f); v0[e] = a * a; v1[e] = b * b; }
                    u32x4 w; w.x = cvt_pk_bf16(v0[0], v0[1]); w.y = cvt_pk_bf16(v0[2], v0[3]); w.z = cvt_pk_bf16(v1[0], v1[1]); w.w = cvt_pk_bf16(v1[2], v1[3]);
                    *(u32x4*)(O + (size_t)(row0 + ai * HALF + m * 16) * ldc + col0 + bj * HALF) = w;
                    __builtin_amdgcn_sched_barrier(0);
                }
    }
};

template <class Epi, class Sched, bool ALIGN_EPI = false, bool SP2 = false>
__device__ __forceinline__ void gemm_phase(PG8_LAS unsigned char* lds, const Gemm g, const Sched& S, const Epi& E) {
    int tid_ = threadIdx.x; asm volatile("" : "+v"(tid_));
    const int tid = tid_, wid = __builtin_amdgcn_readfirstlane(tid >> 6), lane = tid & 63, wr = wid >> 2, wc = wid & 3, fr = lane & 15, fq = lane >> 4;
    const int K = g.K, nt = K / BK;
    unsigned voffA[2], voffB[2];
#pragma unroll
    for (int i = 0; i < 2; ++i) { int R, C; stage_rc(tid * 16 + i * 8192, R, C); const int Rb = Epi::PERM ? ((R & ~31) + perm32(R & 31)) : R;
        voffA[i] = (unsigned)(R * K + C) * 2u; voffB[i] = (unsigned)(Rb * K + C) * 2u; }
    const size_t kstep = (size_t)(BK * 2);
    const size_t hstep = (size_t)HALF * K * 2;
    const size_t tstep = 2 * hstep;
    const unsigned ldsw = (unsigned)wid * 1024u;
    const int aoff = lds_byte(wr * 64 + fr, fq * 8), boff = lds_byte(wc * 32 + fr, fq * 8);
#define PG8_SA(b, h) (((b) * 2 + (h)) * HTB)
#define PG8_SB(b, h) ((4 + (b) * 2 + (h)) * HTB)
#define PG8_STAGE(bufoff, gbase, voff) do { _Pragma("unroll") for (int _i = 0; _i < 2; ++_i) \
        __builtin_amdgcn_global_load_lds((const unsigned*)((const char*)(gbase) + (voff)[_i]), (PG8_LAS unsigned*)(lds + (bufoff) + ldsw + _i * 8192), 16, 0, 0); } while (0)
#define PG8_LDA(dst, b, h) do { _Pragma("unroll") for (int m = 0; m < 4; ++m) _Pragma("unroll") for (int k = 0; k < 2; ++k) dst[m][k] = *(const PG8_LAS bf16x8*)(lds + PG8_SA(b, h) + aoff + m * 2048 + k * 1024); } while (0)
#define PG8_LDB(dst, b, h) do { _Pragma("unroll") for (int n = 0; n < 2; ++n) _Pragma("unroll") for (int k = 0; k < 2; ++k) dst[n][k] = *(const PG8_LAS bf16x8*)(lds + PG8_SB(b, h) + boff + n * 2048 + k * 1024); } while (0)
#define PG8_MMA(ai, bj, At, Bt) do { __builtin_amdgcn_s_setprio(1); _Pragma("unroll") for (int m = 0; m < 4; ++m) _Pragma("unroll") for (int n = 0; n < 2; ++n) _Pragma("unroll") for (int k = 0; k < 2; ++k) \
        acc[ai][bj][m][n] = __builtin_amdgcn_mfma_f32_16x16x32_bf16(Bt[n][k], At[m][k], acc[ai][bj][m][n], 0, 0, 0); __builtin_amdgcn_s_setprio(0); } while (0)
#define PG8_WAIT_V(n) asm volatile("s_waitcnt vmcnt(" #n ")" ::: "memory")
#define PG8_WAIT_L(n) asm volatile("s_waitcnt lgkmcnt(" #n ")" ::: "memory")
#define PG8_BAR __builtin_amdgcn_s_barrier()
#define PG8_SCHED __builtin_amdgcn_sched_barrier(0)
    Unit cur, nxt; int ui = 0;
    if (!S.next(0, cur)) return;
    f32x4 acc[2][2][4][2];
#pragma unroll
    for (int a = 0; a < 2; ++a)
#pragma unroll
        for (int b = 0; b < 2; ++b)
#pragma unroll
            for (int m = 0; m < 4; ++m)
#pragma unroll
                for (int n = 0; n < 2; ++n) acc[a][b][m][n] = (f32x4){0.f, 0.f, 0.f, 0.f};
    bf16x8 At[4][2], B0[2][2], B1[2][2];
    const char* cA = (const char*)g.A + (size_t)cur.pm * tstep; const char* cB = (const char*)g.Bt + (size_t)cur.pn * tstep;
    S.a_ready(cur);
    if constexpr (SP2) {
        PG8_STAGE(PG8_SB(0, 0), cB, voffB); PG8_STAGE(PG8_SB(0, 1), cB + hstep, voffB); PG8_STAGE(PG8_SA(0, 0), cA, voffA); PG8_STAGE(PG8_SA(0, 1), cA + hstep, voffA);
        if (wr == 1) PG8_BAR;
        PG8_WAIT_V(2); PG8_BAR;
        PG8_STAGE(PG8_SB(1, 0), cB + kstep, voffB); PG8_STAGE(PG8_SA(1, 0), cA + kstep, voffA); PG8_STAGE(PG8_SB(1, 1), cB + hstep + kstep, voffB);
        PG8_WAIT_V(6); PG8_BAR;
    } else {
        PG8_STAGE(PG8_SB(0, 0), cB, voffB); PG8_STAGE(PG8_SA(0, 0), cA, voffA); PG8_STAGE(PG8_SB(0, 1), cB + hstep, voffB); PG8_STAGE(PG8_SA(0, 1), cA + hstep, voffA);
        if (wr == 1) PG8_BAR;
        PG8_WAIT_V(4); PG8_BAR;
        PG8_STAGE(PG8_SB(1, 0), cB + kstep, voffB); PG8_STAGE(PG8_SA(1, 0), cA + kstep, voffA); PG8_STAGE(PG8_SB(1, 1), cB + hstep + kstep, voffB);
        PG8_WAIT_V(6); PG8_BAR;
    }
    for (;;) {
        const bool has_next = S.next(ui + 1, nxt);
        const char* nA = has_next ? (const char*)g.A + (size_t)nxt.pm * tstep : cA; const char* nB = has_next ? (const char*)g.Bt + (size_t)nxt.pn * tstep : cB;
        for (int t = 0; t < nt; t += 2) {
            const bool last = (t == nt - 2);
            const char* a1 = cA + (size_t)(t + 1) * kstep;
            const char* a2 = last ? nA : cA + (size_t)(t + 2) * kstep; const char* b2 = last ? nB : cB + (size_t)(t + 2) * kstep;
            const char* a3 = a2 + kstep; const char* b3 = b2 + kstep;
            if (last && has_next) S.a_ready(nxt);
            if constexpr (SP2) {
            PG8_LDB(B0, 0, 0); PG8_LDB(B1, 0, 1); PG8_SCHED; PG8_LDA(At, 0, 0); PG8_STAGE(PG8_SA(1, 1), a1 + hstep, voffA);
            PG8_WAIT_V(8); PG8_WAIT_L(0); PG8_BAR; PG8_MMA(0, 0, At, B0); PG8_MMA(0, 1, At, B1); PG8_BAR; PG8_SCHED;
            PG8_LDA(At, 0, 1); PG8_STAGE(PG8_SB(0, 0), b2, voffB); PG8_STAGE(PG8_SB(0, 1), b2 + hstep, voffB); PG8_STAGE(PG8_SA(0, 0), a2, voffA);
            PG8_WAIT_V(8); PG8_WAIT_L(0); PG8_BAR; PG8_MMA(1, 0, At, B0); PG8_MMA(1, 1, At, B1); PG8_BAR; PG8_SCHED;
            PG8_LDB(B0, 1, 0); PG8_LDB(B1, 1, 1); PG8_SCHED; PG8_LDA(At, 1, 0); PG8_STAGE(PG8_SA(0, 1), a2 + hstep, voffA);
            PG8_WAIT_V(8); PG8_WAIT_L(0); PG8_BAR; PG8_MMA(0, 0, At, B0); PG8_MMA(0, 1, At, B1); PG8_BAR; PG8_SCHED;
            PG8_LDA(At, 1, 1); PG8_STAGE(PG8_SB(1, 0), b3, voffB); PG8_STAGE(PG8_SB(1, 1), b3 + hstep, voffB); PG8_STAGE(PG8_SA(1, 0), a3, voffA);
            PG8_WAIT_V(8); PG8_WAIT_L(0); PG8_BAR; PG8_MMA(1, 0, At, B0); PG8_MMA(1, 1, At, B1); PG8_BAR; PG8_SCHED;
            } else {
            PG8_LDB(B0, 0, 0); PG8_SCHED; PG8_LDA(At, 0, 0); PG8_STAGE(PG8_SA(1, 1), a1 + hstep, voffA);
            PG8_WAIT_L(8); PG8_BAR; PG8_WAIT_L(0); PG8_MMA(0, 0, At, B0); PG8_BAR; PG8_SCHED;
            PG8_LDB(B1, 0, 1); PG8_STAGE(PG8_SB(0, 0), b2, voffB);
            PG8_BAR; PG8_WAIT_L(0); PG8_MMA(0, 1, At, B1); PG8_BAR;
            PG8_LDA(At, 0, 1); PG8_STAGE(PG8_SA(0, 0), a2, voffA);
            PG8_BAR; PG8_WAIT_L(0); PG8_MMA(1, 0, At, B0); PG8_BAR; PG8_SCHED;
            PG8_STAGE(PG8_SB(0, 1), b2 + hstep, voffB);
            PG8_WAIT_V(6); PG8_BAR; PG8_MMA(1, 1, At, B1); PG8_BAR;
            PG8_LDB(B0, 1, 0); PG8_SCHED; PG8_LDA(At, 1, 0); PG8_STAGE(PG8_SA(0, 1), a2 + hstep, voffA);
            PG8_WAIT_L(8); PG8_BAR; PG8_WAIT_L(0); PG8_MMA(0, 0, At, B0); PG8_BAR; PG8_SCHED;
            PG8_LDB(B1, 1, 1); PG8_STAGE(PG8_SB(1, 0), b3, voffB);
            PG8_BAR; PG8_WAIT_L(0); PG8_MMA(0, 1, At, B1); PG8_BAR;
            PG8_LDA(At, 1, 1); PG8_STAGE(PG8_SA(1, 0), a3, voffA);
            PG8_BAR; PG8_WAIT_L(0); PG8_MMA(1, 0, At, B0); PG8_BAR; PG8_SCHED;
            PG8_STAGE(PG8_SB(1, 1), b3 + hstep, voffB);
            PG8_WAIT_V(6); PG8_BAR; PG8_MMA(1, 1, At, B1); PG8_BAR;
            }
        }
        if constexpr (ALIGN_EPI) { if (wr == 0) PG8_BAR; }
        if constexpr (!Epi::AFTER_DRAIN) { E(acc, cur, wr, wc, fr, fq); S.done(cur); }
        if (!has_next) break;
#pragma unroll
        for (int a = 0; a < 2; ++a)
#pragma unroll
            for (int b = 0; b < 2; ++b)
#pragma unroll
                for (int m = 0; m < 4; ++m)
#pragma unroll
                    for (int n = 0; n < 2; ++n) acc[a][b][m][n] = (f32x4){0.f, 0.f, 0.f, 0.f};
        cur = nxt; cA = nA; cB = nB; ++ui;
        if constexpr (ALIGN_EPI) { if (wr == 1) PG8_BAR; }
    }
    PG8_WAIT_V(0);
    if constexpr (!ALIGN_EPI) { if (wr == 0) PG8_BAR; }
    PG8_BAR;
    if constexpr (Epi::AFTER_DRAIN) { E.fused(acc, cur, wr, wc, fr, fq, lds, wid, lane); S.done(cur); }
#undef PG8_SA
#undef PG8_SB
#undef PG8_STAGE
#undef PG8_LDA
#undef PG8_LDB
#undef PG8_MMA
#undef PG8_WAIT_V
#undef PG8_WAIT_L
#undef PG8_BAR
#undef PG8_SCHED
}
}

#define DI __device__ __forceinline__
#define LAS __attribute__((address_space(3)))
typedef unsigned short bf16;
typedef short bf16x8 __attribute__((ext_vector_type(8)));
typedef short s16x4 __attribute__((ext_vector_type(4)));
typedef float f32x4 __attribute__((ext_vector_type(4)));
typedef float f32x16 __attribute__((ext_vector_type(16)));
typedef unsigned u32x4 __attribute__((ext_vector_type(4)));
typedef unsigned u32x2 __attribute__((ext_vector_type(2)));
#define MFMA32(a, b, c) __builtin_amdgcn_mfma_f32_32x32x16_bf16((a), (b), (c), 0, 0, 0)
#define LDS_WAIT() asm volatile("s_waitcnt lgkmcnt(0)" ::: "memory")

constexpr int SEQ = 8192, TOK = 16384, DM = 1024, FF = 4096, NIN = 8192, NTHR = 512;
constexpr size_t MiB = 1u << 20;
constexpr size_t WS_WIN = 1 * MiB, WS_WA = 17 * MiB, WS_WB = 18 * MiB, WS_WO = 19 * MiB, WS_W1K = 21 * MiB, WS_W1V = 22 * MiB, WS_SMALL = 23 * MiB,
                 WS_KC = 24 * MiB, WS_LSE = 25 * MiB, WS_GB = 27 * MiB, WS_QB = 28 * MiB, WS_KVB = 44 * MiB, WS_R2 = 68 * MiB, WS_R1 = 100 * MiB,
                 WS_WUP = 228 * MiB, WS_WDN = 236 * MiB, WS_END = 244 * MiB;
constexpr int LDS_BYTES = 147456;
constexpr int KVROW = 144, KVT = 64 * KVROW;
constexpr float SC_LOG2E = 0.125f * 1.4426950408889634f;

struct Args { const float* in[16]; float* out; unsigned char* ws; };

struct Frame {
    LAS unsigned char* lds; int tid, lane, wave, G, bid;
    const float *x, *g_mix, *w_in, *pos_k, *w1_k, *w2_k, *pos_v, *w1_v, *w2_v, *w_a, *w_b, *w_out, *g_mlp, *w_up, *w_down, *g_fin;
    float* out; unsigned char* ws;
    DI bf16* WIN() const { return (bf16*)(ws + (WS_WIN)); }
    DI bf16* WA() const { return (bf16*)(ws + (WS_WA)); }
    DI bf16* WB() const { return (bf16*)(ws + (WS_WB)); }
    DI bf16* WO() const { return (bf16*)(ws + (WS_WO)); }
    DI bf16* W1K() const { return (bf16*)(ws + (WS_W1K)); }
    DI bf16* W1V() const { return (bf16*)(ws + (WS_W1V)); }
    DI bf16* W2K() const { return (bf16*)(ws + (WS_SMALL)); }
    DI bf16* W2V() const { return (bf16*)(ws + (WS_SMALL + 32768)); }
    DI bf16* KC() const { return (bf16*)(ws + (WS_KC)); }
    DI bf16* VC() const { return (bf16*)(ws + (WS_KC + 262144)); }
    DI bf16* GB() const { return (bf16*)(ws + (WS_GB)); }
    DI bf16* QB() const { return (bf16*)(ws + (WS_QB)); }
    DI bf16* KVB() const { return (bf16*)(ws + (WS_KVB)); }
    DI bf16* U() const { return (bf16*)(ws + (WS_R2)); }
    DI bf16* OG0() const { return (bf16*)(ws + (WS_R2)); }
    DI bf16* OG1() const { return (bf16*)(ws + (WS_R2 + 16 * MiB)); }
    DI bf16* OG2() const { return (bf16*)(ws + (WS_WIN)); }
    DI bf16* QKVA() const { return (bf16*)(ws + (WS_R1)); }
    DI bf16* YA() const { return (bf16*)(ws + (WS_R1)); }
    DI bf16* YB() const { return (bf16*)(ws + (WS_R1 + 16 * MiB)); }
    DI bf16* MERGED() const { return (bf16*)(ws + (WS_R1 + 96 * MiB)); }
    DI bf16* H() const { return (bf16*)(ws + (WS_R1)); }
    DI bf16* WUP() const { return (bf16*)(ws + (WS_WUP)); }
    DI bf16* WDN() const { return (bf16*)(ws + (WS_WDN)); }
    DI float* BIASK() const { return (float*)(ws + (WS_SMALL + 65536)); }
    DI float* BIASV() const { return (float*)(ws + (WS_SMALL + 69632)); }
    DI float* CS() const { return (float*)(ws + (WS_SMALL + 131072)); }
    DI float* LSE() const { return (float*)(ws + (WS_LSE)); }
    DI float* TMP() const { return (float*)(ws + (WS_R1 + 32 * MiB)); }
    DI bf16* GM() const { return (bf16*)out; }
};

DI float wave_sum(float v) {
#pragma unroll
    for (int o = 1; o < 64; o <<= 1) v += __shfl_xor(v, o);
    return v;
}
DI unsigned f2bf(float f) { unsigned u = __builtin_bit_cast(unsigned, f); return (u + 0x7fffu + ((u >> 16) & 1u)) >> 16; }
DI unsigned pk2(float lo, float hi) { return f2bf(lo) | (f2bf(hi) << 16); }
DI float bf2f(bf16 v) { return __builtin_bit_cast(float, (unsigned)v << 16); }
DI float sigm(float x) { return 1.f / (1.f + __expf(-x)); }
DI f32x16 zero16() { f32x16 z;
#pragma unroll
    for (int i = 0; i < 16; ++i) z[i] = 0.f;
    return z; }

DI void transpose_item(const float* W, int ldw, int col0, int ncols, int k0, bf16* WT, int K, int drow0, LAS float* scr, int lane) {
    const int cl = lane & 31;
#pragma unroll 8
    for (int i = 0; i < 32; ++i) { const int kk = 2 * i + (lane >> 5); scr[kk * 33 + cl] = (cl < ncols) ? W[(size_t)(k0 + kk) * ldw + col0 + cl] : 0.f; }
    LDS_WAIT();
    const int c = lane & 7;
#pragma unroll
    for (int j = 0; j < 4; ++j) { const int n = (lane >> 3) + 8 * j; const LAS float* s = scr + (8 * c) * 33 + n;
        u32x4 o; o.x = pk2(s[0 * 33], s[1 * 33]); o.y = pk2(s[2 * 33], s[3 * 33]); o.z = pk2(s[4 * 33], s[5 * 33]); o.w = pk2(s[6 * 33], s[7 * 33]);
        if (n < ncols) *(u32x4*)(WT + (size_t)(drow0 + n) * K + k0 + 8 * c) = o; }
    LDS_WAIT();
}
DI bool transpose_job(int& item, const float* W, int ldw, int scol0, int ncols, int K, bf16* WT, int drow0, LAS float* scr, int lane) {
    const int nblk = (ncols + 31) >> 5, nitems = (K >> 6) * nblk;
    if (item >= nitems) { item -= nitems; return false; }
    const int kb = item / nblk, nb = item - kb * nblk;
    const int rem = ncols - 32 * nb;
    transpose_item(W, ldw, scol0 + 32 * nb, rem < 32 ? rem : 32, 64 * kb, WT, K, drow0 + 32 * nb, scr, lane);
    return true;
}
DI void rms_row_bf16(const float* xrow, const float* g, bf16* orow, int lane) {
    const f32x4* xr = (const f32x4*)xrow + lane; const f32x4* gr = (const f32x4*)g + lane;
    f32x4 v[4]; float s = 0.f;
#pragma unroll
    for (int j = 0; j < 4; ++j) { v[j] = xr[64 * j]; s += (v[j].x * v[j].x + v[j].y * v[j].y) + (v[j].z * v[j].z + v[j].w * v[j].w); }
    const float rstd = 1.f / sqrtf(wave_sum(s) * (1.f / DM) + 1e-6f);
    unsigned long long* o8 = (unsigned long long*)orow + lane;
#pragma unroll
    for (int j = 0; j < 4; ++j) { const f32x4 gg = gr[64 * j];
        o8[64 * j] = (unsigned long long)pk2(v[j].x * rstd * gg.x, v[j].y * rstd * gg.y) | ((unsigned long long)pk2(v[j].z * rstd * gg.z, v[j].w * rstd * gg.w) << 32); }
}
DI void rms_row_f32_inplace(float* xrow, const float* g, int lane) {
    f32x4* xr = (f32x4*)xrow + lane; const f32x4* gr = (const f32x4*)g + lane;
    f32x4 v[4]; float s = 0.f;
#pragma unroll
    for (int j = 0; j < 4; ++j) { v[j] = xr[64 * j]; s += (v[j].x * v[j].x + v[j].y * v[j].y) + (v[j].z * v[j].z + v[j].w * v[j].w); }
    const float rstd = 1.f / sqrtf(wave_sum(s) * (1.f / DM) + 1e-6f);
#pragma unroll
    for (int j = 0; j < 4; ++j) xr[64 * j] = v[j] * rstd * gr[64 * j];
}

DI void p0_prologue(const Frame& F) {
    LAS float* scr = (LAS float*)(F.lds + F.wave * 16384);
    const int gw = F.bid * 8 + F.wave, NGW = F.G * 8;
    constexpr int NITEMS = 16 * 184 + 16 * 64 + 16 + 256 + 256 + 512 + 256 + 256 + 8 + 8;
    for (int it = gw; it < NITEMS; it += NGW) {
        int r = it;
        if (transpose_job(r, F.w_in, 7960, 0, 5888, DM, F.WIN(), 0, scr, F.lane)) continue;
        if (transpose_job(r, F.w_in, 7960, 5912, 2048, DM, F.WIN(), 5888, scr, F.lane)) continue;
        if (transpose_job(r, F.w_in, 7960, 5888, 24, DM, F.WIN(), 7936, scr, F.lane)) continue;
        if (transpose_job(r, F.w_a, 1024, 0, 1024, 512, F.WA(), 0, scr, F.lane)) continue;
        if (transpose_job(r, F.w_b, 1024, 0, 1024, 512, F.WB(), 0, scr, F.lane)) continue;
        if (transpose_job(r, F.w_out, 1024, 0, 1024, 1024, F.WO(), 0, scr, F.lane)) continue;
        if (transpose_job(r, F.w1_k, 256, 0, 256, 2048, F.W1K(), 0, scr, F.lane)) continue;
        if (transpose_job(r, F.w1_v, 256, 0, 256, 2048, F.W1V(), 0, scr, F.lane)) continue;
        if (transpose_job(r, F.w2_k, 64, 0, 64, 256, F.W2K(), 0, scr, F.lane)) continue;
        transpose_job(r, F.w2_v, 64, 0, 64, 256, F.W2V(), 0, scr, F.lane);
    }
    const int gt = F.bid * NTHR + F.tid, NGT = F.G * NTHR;
    for (int i = gt; i < 232 * 1024 / 8; i += NGT) *(u32x4*)(F.WIN() + (size_t)7960 * 1024 + (size_t)i * 8) = (u32x4){0u, 0u, 0u, 0u};
    for (int i = gt; i < SEQ * 8; i += NGT) {
        const int s = i >> 3, k = i & 7;
        const double inv[8] = {1.0, 0.19392274474868576, 0.03760603093086393, 0.007292664737217109, 0.001414213562373095, 0.0002742481756762073, 5.318295896944988e-05, 1.031338537721246e-05};
        double iv = inv[0];
#pragma unroll
        for (int q = 1; q < 8; ++q) iv = (k == q) ? inv[q] : iv;
        const double rev = (double)s * iv * 0.15915494309189535;
        const float fr = (float)(rev - __builtin_rint(rev));
        F.CS()[s * 16 + k] = __builtin_amdgcn_cosf(fr); F.CS()[s * 16 + 8 + k] = __builtin_amdgcn_sinf(fr);
    }
    for (int m = gw; m < TOK; m += NGW) rms_row_bf16(F.x + (size_t)m * DM, F.g_mix, F.U() + (size_t)m * DM, F.lane);
    if (F.bid < 2 && F.tid < 256) {
        const float* pe = F.bid ? F.pos_v : F.pos_k; const float* W1 = F.bid ? F.w1_v : F.w1_k; float acc = 0.f;
        for (int k = 0; k < 2048; ++k) acc += pe[k] * W1[(size_t)k * 256 + F.tid];
        (F.bid ? F.BIASV() : F.BIASK())[F.tid] = acc;
    }
    if (F.bid == 2) { const int kv = F.tid >> 8, bg = (F.tid >> 6) & 3, d = F.tid & 63; (kv ? F.VC() : F.KC())[((bg * 512 + 511) << 6) + d] = 0; }
}

struct Stg { u32x4 k, v; };
DI void stage_load(Stg& s, const bf16* Kg, const bf16* Vg, int row0, int tid) {
    s.k = *(const u32x4*)(Kg + ((size_t)row0 << 6) + tid * 8); s.v = *(const u32x4*)(Vg + ((size_t)row0 << 6) + tid * 8);
}
DI void stage_store(const Stg& s, LAS unsigned char* lds, int buf, int tid) {
    const int off = (tid >> 3) * KVROW + (tid & 7) * 16;
    *(LAS u32x4*)(lds + buf * 2 * KVT + off) = s.k; *(LAS u32x4*)(lds + buf * 2 * KVT + KVT + off) = s.v;
}
DI unsigned pkbf(float a, float b) {
    typedef __bf16 bf2 __attribute__((ext_vector_type(2))); typedef float f2 __attribute__((ext_vector_type(2)));
    f2 v = {a, b}; bf2 r = __builtin_convertvector(v, bf2); return __builtin_bit_cast(unsigned, r);
}
DI void qk_tile(LAS const unsigned char* kt, const bf16x8 (&qf)[4], f32x16 (&s)[2], int lane) {
    const int r = lane & 31, h = lane >> 5;
    const int sr = (r & 19) | ((r & 4) << 1) | ((r & 8) >> 1);
#pragma unroll
    for (int kh = 0; kh < 2; ++kh) { s[kh] = zero16(); LAS const unsigned char* kp = kt + (kh * 32 + sr) * KVROW + h * 16;
#pragma unroll
        for (int ks = 0; ks < 4; ++ks) { const bf16x8 a = *(LAS const bf16x8*)(kp + ks * 32); s[kh] = MFMA32(a, qf[ks], s[kh]); } }
}
DI void flash_tile(LAS const unsigned char* kt, LAS const unsigned char* vt, const bf16x8 (&qf)[4], f32x16 (&o)[2], float& m, float& l, int dq, unsigned maxoff, bool sel, int lane) {
    const int h = lane >> 5;
    f32x16 s[2];
    qk_tile(kt, qf, s, lane);
    float mx = -1e30f;
#pragma unroll
    for (int kh = 0; kh < 2; ++kh)
#pragma unroll
        for (int i = 0; i < 16; ++i) { const int kk = 32 * kh + 16 * (i >> 3) + (i & 7); const bool v = sel && ((unsigned)(dq - kk) <= maxoff);
            s[kh][i] = v ? s[kh][i] : -1e30f; mx = fmaxf(mx, s[kh][i]); }
    mx = fmaxf(mx, __shfl_xor(mx, 32));
    const float mn = fmaxf(m, mx);
    const float alpha = __builtin_amdgcn_exp2f((m - mn) * SC_LOG2E); m = mn;
    const float mb = mn * SC_LOG2E;
    float ps = 0.f;
#pragma unroll
    for (int kh = 0; kh < 2; ++kh)
#pragma unroll
        for (int i = 0; i < 16; ++i) { const float p = (s[kh][i] > -1e29f) ? __builtin_amdgcn_exp2f(s[kh][i] * SC_LOG2E - mb) : 0.f; ps += p; s[kh][i] = p; }
    l = l * alpha + ps;
    o[0] *= alpha; o[1] *= alpha;
    const int q4 = (lane & 15) >> 2, p4 = lane & 3, blk = (lane >> 4) & 1;
    LAS const unsigned char* vb = vt + (8 * h + q4) * KVROW + 8 * (4 * blk + p4);
#pragma unroll
    for (int kh = 0; kh < 2; ++kh)
#pragma unroll
        for (int s2 = 0; s2 < 2; ++s2) {
            u32x4 pw; pw.x = pkbf(s[kh][8 * s2 + 0], s[kh][8 * s2 + 1]); pw.y = pkbf(s[kh][8 * s2 + 2], s[kh][8 * s2 + 3]);
            pw.z = pkbf(s[kh][8 * s2 + 4], s[kh][8 * s2 + 5]); pw.w = pkbf(s[kh][8 * s2 + 6], s[kh][8 * s2 + 7]);
            const bf16x8 pf = __builtin_bit_cast(bf16x8, pw);
#pragma unroll
            for (int db = 0; db < 2; ++db) {
                LAS const unsigned char* vp = vb + (32 * kh + 16 * s2) * KVROW + db * 64;
                const s16x4 lo = __builtin_amdgcn_ds_read_tr16_b64_v4i16((LAS s16x4*)(vp));
                const s16x4 hi = __builtin_amdgcn_ds_read_tr16_b64_v4i16((LAS s16x4*)(vp + 4 * KVROW));
                const bf16x8 vf = __builtin_shufflevector(lo, hi, 0, 1, 2, 3, 4, 5, 6, 7);
                o[db] = MFMA32(vf, pf, o[db]);
            }
        }
}
DI void write_o_row(bf16* dst, const f32x16 (&o)[2], float scale, int h) {
#pragma unroll
    for (int db = 0; db < 2; ++db)
#pragma unroll
        for (int i4 = 0; i4 < 4; ++i4) {
            u32x2 w; w.x = pkbf(o[db][4 * i4] * scale, o[db][4 * i4 + 1] * scale); w.y = pkbf(o[db][4 * i4 + 2] * scale, o[db][4 * i4 + 3] * scale);
            *(u32x2*)(dst + 32 * db + 8 * i4 + 4 * h) = w;
        }
}

DI void mixa_task(const Frame& F, int task) {
    const int tile32 = task & 31, hb = task >> 5, b = hb & 1, head = hb >> 1;
    const int g = head >> 3, slot = head & 7, lg = 2 * g;
    const int prow0 = tile32 * 256, L = SEQ >> lg, res = prow0 >> (13 - lg), p0 = prow0 & (L - 1);
    const bf16* Q = F.QKVA() + ((size_t)((head) * 2 + b) << 19);
    const bf16* K = F.QKVA() + ((size_t)((24 + head) * 2 + b) << 19);
    const bf16* V = F.QKVA() + ((size_t)((48 + head) * 2 + b) << 19);
    const int w = F.wave, lane = F.lane, r = lane & 31, h = lane >> 5;
    bf16x8 qf[4];
    { const bf16* qr = Q + ((size_t)(prow0 + 32 * w + r) << 6) + 8 * h;
#pragma unroll
      for (int ks = 0; ks < 4; ++ks) qf[ks] = *(const bf16x8*)(qr + 16 * ks); }
    f32x16 o[2] = {zero16(), zero16()}; float m = -1e30f, l = 0.f;
    const int kt0 = (p0 == 0) ? 2 : 0;
    Stg st; stage_load(st, K, V, prow0 - 128 + 64 * kt0, F.tid);
    for (int kt = kt0; kt < 6; ++kt) {
        const int buf = kt & 1;
        stage_store(st, F.lds, buf, F.tid);
        __syncthreads();
        if (kt + 1 < 6) stage_load(st, K, V, prow0 - 128 + 64 * (kt + 1), F.tid);
        if (kt >= (w >> 1) && kt <= (w >> 1) + 2)
            flash_tile(F.lds + buf * 2 * KVT, F.lds + buf * 2 * KVT + KVT, qf, o, m, l, 128 + 32 * w + r - 64 * kt - 8 * h, 128u, true, lane);
    }
    __syncthreads();
    const float lt = l + __shfl_xor(l, 32);
    const float inv = 1.f / lt;
    const int s = ((p0 + 32 * w + r) << lg) | res;
    const size_t row = (size_t)b * SEQ + s;
    bf16* og = (bf16*)(F.ws + ((g == 0) ? WS_R2 : (g == 1) ? (WS_R2 + 16 * MiB) : WS_WIN));
    write_o_row(og + row * 512 + slot * 64, o, inv, h);
    if (h == 0) F.LSE()[((size_t)g * TOK + row) * 8 + slot] = m * 0.125f + __logf(lt);
}

DI float gelu_tanh(float x) { const float u = 0.7978845608028654f * (x + 0.044715f * x * x * x); const float e = __expf(2.f * u); const float t = 1.f - 2.f / (e + 1.f); return 0.5f * x * (1.f + t); }
DI void compress_task(const Frame& F, int task) {
    const int kv = task >> 5, bg = (task >> 3) & 3, it = task & 7;
    const bf16* A = F.KVB() + ((size_t)(kv * 4 + bg) << 19);
    const bf16* W1T = kv ? F.W1V() : F.W1K(); const bf16* W2T = kv ? F.W2V() : F.W2K(); const float* bias = kv ? F.BIASV() : F.BIASK();
    bf16* OUT = (kv ? F.VC() : F.KC()) + ((size_t)bg << 15);
    const int w = F.wave, lane = F.lane, r = lane & 31, h = lane >> 5;
    LAS unsigned char* hid = F.lds;
    f32x16 acc[2] = {zero16(), zero16()};
    int i0 = 64 * it + r, i1 = i0 + 32; i0 = i0 > 510 ? 510 : i0; i1 = i1 > 510 ? 510 : i1;
    const bf16* a0p = A + (size_t)i0 * 1024 + 8 * h; const bf16* a1p = A + (size_t)i1 * 1024 + 8 * h;
    const bf16* bp = W1T + (size_t)(32 * w + r) * 2048 + 8 * h;
#pragma unroll 4
    for (int k0 = 0; k0 < 2048; k0 += 16) {
        const bf16x8 bfr = *(const bf16x8*)(bp + k0), a0 = *(const bf16x8*)(a0p + k0), a1 = *(const bf16x8*)(a1p + k0);
        acc[0] = MFMA32(a0, bfr, acc[0]); acc[1] = MFMA32(a1, bfr, acc[1]);
    }
    const float bs = bias[32 * w + r];
#pragma unroll
    for (int rb = 0; rb < 2; ++rb)
#pragma unroll
        for (int i = 0; i < 16; ++i) { const int row = 32 * rb + (i & 3) + 8 * (i >> 2) + 4 * h;
            *(LAS bf16*)(hid + row * 528 + (32 * w + r) * 2) = (bf16)f2bf(gelu_tanh(acc[rb][i] + bs)); }
    __syncthreads();
    if (w < 4) {
        const int rb = w & 1, cb = w >> 1; f32x16 c = zero16();
        const bf16* b2 = W2T + (size_t)(32 * cb + r) * 256 + 8 * h;
#pragma unroll
        for (int k0 = 0; k0 < 256; k0 += 16) { const bf16x8 a = *(LAS const bf16x8*)(hid + (32 * rb + r) * 528 + (k0 + 8 * h) * 2); const bf16x8 bb = *(const bf16x8*)(b2 + k0); c = MFMA32(a, bb, c); }
#pragma unroll
        for (int i = 0; i < 16; ++i) { const int row = 64 * it + 32 * rb + (i & 3) + 8 * (i >> 2) + 4 * h;
            if (row < 511) OUT[((size_t)row << 6) + 32 * cb + r] = (bf16)f2bf(c[i]); }
    }
    __syncthreads();
}

DI float dpp_quad_sum(float p) {
    p += __builtin_bit_cast(float, __builtin_amdgcn_update_dpp(0, __builtin_bit_cast(int, p), 0xB1, 0xF, 0xF, true));
    p += __builtin_bit_cast(float, __builtin_amdgcn_update_dpp(0, __builtin_bit_cast(int, p), 0x4E, 0xF, 0xF, true));
    return p;
}
DI void nsa_task(const Frame& F, int b, int g, int tt) {
    const int w = F.wave, lane = F.lane, r = lane & 31, h = lane >> 5, tid = F.tid;
    const int t0 = tt * 64, tok = 8 * w + (r >> 2), t = t0 + tok, head = 4 * g + (r & 3);
    const size_t row = (size_t)b * SEQ + t;
    const int bg = b * 2 + g;
    bf16x8 qf[4];
    { const bf16* qr = F.QB() + row * 512 + head * 64 + 8 * h;
#pragma unroll
      for (int ks = 0; ks < 4; ++ks) qf[ks] = *(const bf16x8*)(qr + 16 * ks); }
    float g0, g1, g2;
    { const bf16* gp = F.GB() + row * 32 + head * 3; g0 = sigm(bf2f(gp[0])); g1 = sigm(bf2f(gp[1])); g2 = sigm(bf2f(gp[2])); }
    LAS float* imp = (LAS float*)(F.lds + 4 * KVT);
    for (int i = tid; i < 64 * 132; i += NTHR) imp[i] = 0.f;
    f32x16 yacc[2];
    const int nvis = (4 * tt + 3) < 511 ? (4 * tt + 3) : 511, nct = (nvis + 63) >> 6;
    const bf16* Kc = F.KC() + ((size_t)bg << 15); const bf16* Vc = F.VC() + ((size_t)bg << 15);
    const int lim = (t - 31) >> 4;
    float mc, invc;
    {
        f32x16 o[2] = {zero16(), zero16()}; float m = -1e30f, l = 0.f;
        Stg st; stage_load(st, Kc, Vc, 0, tid);
        for (int ct = 0; ct < nct; ++ct) {
            const int buf = ct & 1;
            stage_store(st, F.lds, buf, tid);
            __syncthreads();
            if (ct + 1 < nct) stage_load(st, Kc, Vc, 64 * (ct + 1), tid);
            flash_tile(F.lds + buf * 2 * KVT, F.lds + buf * 2 * KVT + KVT, qf, o, m, l, lim - 64 * ct - 8 * h, 0x7fffffffu, true, lane);
        }
        __syncthreads();
        const float lt = l + __shfl_xor(l, 32);
        invc = lt > 0.f ? 1.f / lt : 0.f; mc = m;
        yacc[0] = o[0] * (g0 * invc); yacc[1] = o[1] * (g0 * invc);
    }
    {
        const float mb = mc * SC_LOG2E;
        Stg st; stage_load(st, Kc, Vc, 0, tid);
        for (int ct = 0; ct < nct; ++ct) {
            const int buf = ct & 1;
            stage_store(st, F.lds, buf, tid);
            __syncthreads();
            if (ct + 1 < nct) stage_load(st, Kc, Vc, 64 * (ct + 1), tid);
            f32x16 s[2];
            qk_tile(F.lds + buf * 2 * KVT, qf, s, lane);
            const int dq = lim - 64 * ct - 8 * h;
#pragma unroll
            for (int kh = 0; kh < 2; ++kh)
#pragma unroll
                for (int s2 = 0; s2 < 2; ++s2) {
                    float ps[8];
#pragma unroll
                    for (int j = 0; j < 8; ++j) { const int kk = 32 * kh + 16 * s2 + j; const bool v = (dq - kk) >= 0;
                        const float p = v ? __builtin_amdgcn_exp2f(s[kh][8 * s2 + j] * SC_LOG2E - mb) * invc : 0.f; ps[j] = dpp_quad_sum(p); }
                    const float sa = (ps[0] + ps[1]) + (ps[2] + ps[3]), sb = (ps[4] + ps[5]) + (ps[6] + ps[7]);
                    LAS float* ip = imp + tok * 132 + 16 * ct + 8 * kh + 4 * s2 + 2 * h;
                    if ((r & 3) == 0) {
                        __hip_atomic_fetch_add(ip, sa, __ATOMIC_RELAXED, __HIP_MEMORY_SCOPE_WORKGROUP);
                        __hip_atomic_fetch_add(ip + 1, sb + ps[3], __ATOMIC_RELAXED, __HIP_MEMORY_SCOPE_WORKGROUP);
                        __hip_atomic_fetch_add(ip + 2, ps[7], __ATOMIC_RELAXED, __HIP_MEMORY_SCOPE_WORKGROUP);
                    }
                }
        }
        LDS_WAIT();
        __syncthreads();
    }
    unsigned long long mlo = 0ull, mhi = 0ull;
    if (tt <= 15) { mlo = (2ull << tt) - 1ull; }
    else {
        for (int tk = 0; tk < 8; ++tk) {
            LAS float* rowp = imp + (8 * w + tk) * 132;
            const int ma = lane, mb2 = lane + 64;
            const bool ca = (ma >= 1 && ma <= tt - 2), cb = (mb2 <= tt - 2);
            const float va = ca ? rowp[ma] : -1.f, vb = cb ? rowp[mb2] : -1.f;
            LDS_WAIT();
            rowp[ma] = va; rowp[mb2] = vb;
            LDS_WAIT();
            int cnta = 0, cntb = 0;
            for (int j = 0; j < 128; j += 4) { const f32x4 v = *(LAS const f32x4*)(rowp + j);
#pragma unroll
                for (int e = 0; e < 4; ++e) { const float xv = v[e]; const int jj = j + e;
                    cnta += ((xv > va) || (xv == va && jj < ma)) ? 1 : 0; cntb += ((xv > vb) || (xv == vb && jj < mb2)) ? 1 : 0; } }
            const bool sa = ca && cnta < 13, sb = cb && cntb < 13;
            unsigned long long ba = __ballot(sa), bb = __ballot(sb);
            ba |= 1ull;
            if (tt < 64) ba |= 1ull << tt; else bb |= 1ull << (tt - 64);
            if (tt - 1 < 64) ba |= 1ull << (tt - 1); else bb |= 1ull << (tt - 1 - 64);
            if ((r >> 2) == tk) { mlo = ba; mhi = bb; }
        }
    }
    {
        const bf16* Ks = F.KVB() + ((size_t)(2 * 4 + bg) << 19); const bf16* Vs = F.KVB() + ((size_t)(3 * 4 + bg) << 19);
        f32x16 o[2] = {zero16(), zero16()}; float m = -1e30f, l = 0.f;
        Stg st; stage_load(st, Ks, Vs, 0, tid);
        for (int ct = 0; ct <= tt; ++ct) {
            const int buf = ct & 1;
            stage_store(st, F.lds, buf, tid);
            __syncthreads();
            if (ct + 1 <= tt) stage_load(st, Ks, Vs, 64 * (ct + 1), tid);
            const bool sel = ((ct < 64 ? (mlo >> ct) : (mhi >> (ct - 64))) & 1ull) != 0ull;
            if (__ballot(sel) != 0ull)
                flash_tile(F.lds + buf * 2 * KVT, F.lds + buf * 2 * KVT + KVT, qf, o, m, l, t - 64 * ct - 8 * h, 0x7fffffffu, sel, lane);
        }
        __syncthreads();
        const float lt = l + __shfl_xor(l, 32); const float sc = g1 / lt;
        yacc[0] += o[0] * sc; yacc[1] += o[1] * sc;
    }
    {
        const bf16* Kw = F.KVB() + ((size_t)(4 * 4 + bg) << 19); const bf16* Vw = F.KVB() + ((size_t)(5 * 4 + bg) << 19);
        f32x16 o[2] = {zero16(), zero16()}; float m = -1e30f, l = 0.f;
        const int c0 = tt > 8 ? tt - 8 : 0;
        Stg st; stage_load(st, Kw, Vw, 64 * c0, tid);
        for (int ct = c0; ct <= tt; ++ct) {
            const int buf = ct & 1;
            stage_store(st, F.lds, buf, tid);
            __syncthreads();
            if (ct + 1 <= tt) stage_load(st, Kw, Vw, 64 * (ct + 1), tid);
            flash_tile(F.lds + buf * 2 * KVT, F.lds + buf * 2 * KVT + KVT, qf, o, m, l, t - 64 * ct - 8 * h, 511u, true, lane);
        }
        __syncthreads();
        const float lt = l + __shfl_xor(l, 32); const float sc = g2 / lt;
        yacc[0] += o[0] * sc; yacc[1] += o[1] * sc;
    }
    write_o_row(F.YB() + row * 512 + head * 64, yacc, 1.f, h);
}

DI void combine_ya(const Frame& F) {
    const int gt = F.bid * NTHR + F.tid, NGT = F.G * NTHR;
    for (int i = gt; i < TOK * 64; i += NGT) {
        const int row = i >> 6, ch = i & 63, slot = ch >> 3;
        const float l0 = F.LSE()[((size_t)0 * TOK + row) * 8 + slot], l1 = F.LSE()[((size_t)1 * TOK + row) * 8 + slot], l2 = F.LSE()[((size_t)2 * TOK + row) * 8 + slot];
        const float mx = fmaxf(l0, fmaxf(l1, l2)); float w0 = __expf(l0 - mx), w1 = __expf(l1 - mx), w2 = __expf(l2 - mx);
        const float inv = 1.f / (w0 + w1 + w2); w0 *= inv; w1 *= inv; w2 *= inv;
        const size_t off = (size_t)row * 512 + ch * 8;
        const u32x4 a = *(const u32x4*)(F.OG0() + off), bb = *(const u32x4*)(F.OG1() + off), c = *(const u32x4*)(F.OG2() + off);
        u32x4 o;
#pragma unroll
        for (int e = 0; e < 4; ++e) {
            const float lo = w0 * pg8::bf_lo(a[e]) + w1 * pg8::bf_lo(bb[e]) + w2 * pg8::bf_lo(c[e]);
            const float hi = w0 * pg8::bf_hi(a[e]) + w1 * pg8::bf_hi(bb[e]) + w2 * pg8::bf_hi(c[e]);
            o[e] = pk2(lo, hi);
        }
        *(u32x4*)(F.YA() + off) = o;
    }
}

#ifndef PH_MAX
#define PH_MAX 99
#endif
__global__ void __launch_bounds__(NTHR) fwd_mega(Args args) {
    extern __shared__ __attribute__((aligned(16))) unsigned char lds_raw[];
    cg::grid_group grid = cg::this_grid();
    Frame F;
    F.lds = (LAS unsigned char*)lds_raw; F.tid = threadIdx.x; F.lane = F.tid & 63; F.wave = __builtin_amdgcn_readfirstlane(F.tid >> 6); F.G = gridDim.x; F.bid = blockIdx.x;
    F.x = args.in[0]; F.g_mix = args.in[1]; F.w_in = args.in[2]; F.pos_k = args.in[3]; F.w1_k = args.in[4]; F.w2_k = args.in[5]; F.pos_v = args.in[6]; F.w1_v = args.in[7]; F.w2_v = args.in[8];
    F.w_a = args.in[9]; F.w_b = args.in[10]; F.w_out = args.in[11]; F.g_mlp = args.in[12]; F.w_up = args.in[13]; F.w_down = args.in[14]; F.g_fin = args.in[15];
    F.out = args.out; F.ws = args.ws;
    unsigned char* ws = args.ws;
    PG8_LAS unsigned char* glds = (PG8_LAS unsigned char*)lds_raw;
    const int gw = F.bid * 8 + F.wave, NGW = F.G * 8;

    p0_prologue(F);
    grid.sync();
    if (PH_MAX >= 1) {
        pg8::Gemm gm{F.U(), F.WIN(), TOK, NIN, DM}; pg8::StaticOrder S; S.init(TOK, NIN, F.G, F.bid);
        pg8::EpiInProj E{F.QKVA(), F.QB(), F.KVB(), F.GM(), F.GB(), F.CS()};
        pg8::gemm_phase<pg8::EpiInProj, pg8::StaticOrder, true, true>(glds, gm, S, E);
    }
    grid.sync();
    if (PH_MAX >= 2) {
        for (int task = F.bid; task < 1536; task += F.G) mixa_task(F, task);
        for (int task = F.G - 1 - F.bid; task < 64; task += F.G) compress_task(F, task);
    }
    grid.sync();
    if (PH_MAX >= 3) {
        combine_ya(F);
        for (int st = F.bid; st < 256; st += F.G) { const int bg = st >> 6, i = st & 63; nsa_task(F, bg >> 1, bg & 1, 127 - i); nsa_task(F, bg >> 1, bg & 1, i); }
    }
    grid.sync();
    if (PH_MAX >= 4) {
        pg8::StaticOrder S; S.init(TOK, DM, F.G, F.bid);
        { pg8::Gemm gm{F.YA(), F.WA(), TOK, DM, 512}; pg8::EpiMerge<1> E{F.GM(), F.TMP(), F.MERGED()}; pg8::gemm_phase<pg8::EpiMerge<1>, pg8::StaticOrder, true, true>(glds, gm, S, E); }
        { pg8::Gemm gm{F.YB(), F.WB(), TOK, DM, 512}; pg8::EpiMerge<2> E{F.GM(), F.TMP(), F.MERGED()}; pg8::gemm_phase<pg8::EpiMerge<2>, pg8::StaticOrder, true, true>(glds, gm, S, E); }
    }
    grid.sync();
    if (PH_MAX >= 5) {
        pg8::StaticOrder S; S.init(TOK, DM, F.G, F.bid);
        pg8::Gemm gm{F.MERGED(), F.WO(), TOK, DM, DM}; pg8::EpiResF32 E{F.x, F.out, DM}; pg8::gemm_phase<pg8::EpiResF32, pg8::StaticOrder, true, true>(glds, gm, S, E);
    }
    grid.sync();
    if (PH_MAX >= 6) {
        LAS float* scr = (LAS float*)(F.lds + F.wave * 16384);
        for (int it = gw; it < 4096; it += NGW) { int r = it;
            if (transpose_job(r, F.w_up, 4096, 0, 4096, DM, F.WUP(), 0, scr, F.lane)) continue;
            transpose_job(r, F.w_down, 1024, 0, 1024, FF, F.WDN(), 0, scr, F.lane); }
        for (int m = gw; m < TOK; m += NGW) rms_row_bf16(F.out + (size_t)m * DM, F.g_mlp, F.U() + (size_t)m * DM, F.lane);
    }
    grid.sync();
    if (PH_MAX >= 7) {
        pg8::StaticOrder S; S.init(TOK, FF, F.G, F.bid);
        pg8::Gemm gm{F.U(), F.WUP(), TOK, FF, DM}; pg8::EpiRelu2 E{F.H(), FF}; pg8::gemm_phase<pg8::EpiRelu2, pg8::StaticOrder, true, true>(glds, gm, S, E);
    }
    grid.sync();
    if (PH_MAX >= 8) {
        pg8::StaticOrder S; S.init(TOK, DM, F.G, F.bid);
        pg8::Gemm gm{F.H(), F.WDN(), TOK, DM, FF}; pg8::EpiResF32 E{F.out, F.out, DM}; pg8::gemm_phase<pg8::EpiResF32, pg8::StaticOrder, true, true>(glds, gm, S, E);
    }
    grid.sync();
    for (int m = gw; m < TOK; m += NGW) rms_row_f32_inplace(F.out + (size_t)m * DM, F.g_fin, F.lane);
}

extern "C" void kernel_launch(void* const* d_in, const int* in_sizes, int n_in, void* d_out, int out_size, void* d_ws, size_t ws_size, hipStream_t stream) {
    static int grid = 0;
    if (grid == 0) {
        if (n_in != 16 || out_size != TOK * DM || ws_size < WS_END) { fprintf(stderr, "kernel_launch: unexpected shapes (n_in %d out %d ws %zu)\n", n_in, out_size, ws_size); grid = -1; return; }
        int dev = 0, cus = 0, per_cu = 0;
        hipGetDevice(&dev); hipDeviceGetAttribute(&cus, hipDeviceAttributeMultiprocessorCount, dev);
        hipFuncSetAttribute((const void*)fwd_mega, hipFuncAttributeMaxDynamicSharedMemorySize, LDS_BYTES);
        if (hipOccupancyMaxActiveBlocksPerMultiprocessor(&per_cu, (const void*)fwd_mega, NTHR, LDS_BYTES) != hipSuccess || per_cu < 1) { fprintf(stderr, "kernel_launch: occupancy query gave %d\n", per_cu); per_cu = 1; }
        (void)hipGetLastError();
        grid = cus * 1;
    }
    if (grid < 0) return;
    Args a{};
    for (int i = 0; i < 16; ++i) a.in[i] = (const float*)d_in[i];
    a.out = (float*)d_out; a.ws = (unsigned char*)d_ws;
    void* kargs[] = {&a};
    hipError_t e = hipLaunchCooperativeKernel((const void*)fwd_mega, dim3(grid), dim3(NTHR), kargs, LDS_BYTES, stream);
    if (e != hipSuccess) fprintf(stderr, "cooperative launch failed: %s (grid %d)\n", hipGetErrorString(e), grid);
}
```

```cpp
#include <hip/hip_runtime.h>
#include <hip/hip_cooperative_groups.h>
#include <cstdio>
#include <cstdint>
namespace cg = cooperative_groups;

namespace pg8 {
#define PG8_LAS __attribute__((address_space(3)))
typedef unsigned short bf16_t;
typedef short bf16x8 __attribute__((ext_vector_type(8)));
typedef float f32x4 __attribute__((ext_vector_type(4)));
typedef unsigned u32x4 __attribute__((ext_vector_type(4)));
constexpr int BM = 256, BK = 64, HALF = 128, HTB = HALF * BK * 2  , STAGE_BYTES = 8 * HTB, NXCD = 8, WGM = 8;

__host__ __device__ __forceinline__ int lds_byte(int r, int c) { const int st = (r >> 4) * 2 + (c >> 5), rr = r & 15, cc = c & 31, ob = rr * 64 + cc * 2; return st * 1024 + (ob ^ (((ob >> 9) & 1) << 5)); }
__host__ __device__ __forceinline__ void stage_rc(int b, int& R, int& C) { const int st = b / 1024, sb = b % 1024, swz = sb ^ (((sb >> 9) & 1) << 5); R = (st >> 1) * 16 + swz / 64; C = (st & 1) * 32 + (swz % 64) / 2; }
__host__ __device__ __forceinline__ int perm32(int rho) { const int n = rho >> 4, i = rho & 15; return 8 * (i >> 2) + 4 * n + (i & 3); }

struct Unit { int pm, pn; };
struct Gemm { const bf16_t* A; const bf16_t* Bt; int M, N, K; };

struct StaticOrder {
    int nM, nN, nwg, G, c;
    __host__ __device__ void init(int M, int N, int G_, int c_) { nM = M / BM; nN = N / BM; nwg = nM * nN; G = G_; c = c_; }
    __host__ __device__ bool next(int i, Unit& u) const {
        const long L = (long)i * G + c; if (L >= nwg) return false;
        int wgid = (int)L; { const int q = nwg / NXCD, r = nwg % NXCD, xcd = wgid % NXCD, off = wgid / NXCD; wgid = (xcd < r ? xcd * (q + 1) : r * (q + 1) + (xcd - r) * q) + off; }
        const int nig = WGM * nN, gid = wgid / nig, fm = gid * WGM, gsz = (nM - fm) < WGM ? (nM - fm) : WGM;
        u.pm = fm + ((wgid % nig) % gsz); u.pn = (wgid % nig) / gsz; return true;
    }
    __device__ __forceinline__ void a_ready(const Unit&) const {}
    __device__ __forceinline__ void done(const Unit&) const {}
};

__device__ __forceinline__ unsigned cvt_pk_bf16(float lo, float hi) { unsigned r; asm volatile("v_cvt_pk_bf16_f32 %0, %1, %2" : "=v"(r) : "v"(lo), "v"(hi)); return r; }
__device__ __forceinline__ float bf_lo(unsigned w) { return __builtin_bit_cast(float, w << 16); }
__device__ __forceinline__ float bf_hi(unsigned w) { return __builtin_bit_cast(float, w & 0xffff0000u); }
__device__ __forceinline__ float sigmoidf_(float x) { return __builtin_amdgcn_rcpf(1.f + __expf(-x)); }

struct EpiInProj {
    static constexpr bool PERM = true, AFTER_DRAIN = false;
    bf16_t* qkva; bf16_t* qb; bf16_t* kvb; bf16_t* gm; bf16_t* gb; const float* cs;
    __device__ __forceinline__ void operator()(const f32x4 (&acc)[2][2][4][2], const Unit& u, int wr, int wc, int fr, int fq) const {
        const int pn = u.pn;
        const int row0 = u.pm * BM + wr * 64 + fr;
        const bool rope_wave = !(wc & 1);
#pragma unroll
        for (int ai = 0; ai < 2; ++ai)
#pragma unroll
            for (int m = 0; m < 4; ++m) {
                const int row = row0 + ai * HALF + m * 16; const int b = row >> 13, s = row & 8191;
                f32x4 c0, c1, s0, s1;
                { const f32x4* t = (const f32x4*)(cs + (size_t)s * 16); c0 = t[0]; c1 = t[1]; s0 = t[2]; s1 = t[3]; }
#pragma unroll
                for (int bj = 0; bj < 2; ++bj) {
                    const int c = pn * BM + bj * HALF + wc * 32 + 8 * fq;
                    f32x4 v0 = acc[ai][bj][m][0], v1 = acc[ai][bj][m][1];
                    bool rope; bf16_t* dst;
                    if (pn < 18) { const int which = c / 1536, hc = c - which * 1536, head = hc >> 6, d0 = hc & 63, lg = (head >> 3) * 2;
                        const int prow = ((s & ((1 << lg) - 1)) << (13 - lg)) | (s >> lg);
                        dst = qkva + ((size_t)((((which * 24 + head) * 2 + b) << 13) + prow) << 6) + d0; rope = (pn < 12); }
                    else if (pn < 20) { dst = qb + (size_t)row * 512 + (c - 4608); rope = true; }
                    else if (pn < 23) { const int cc = c - 5120, j = cc >> 7, g = (cc >> 6) & 1, d0 = cc & 63;
                        dst = kvb + ((size_t)((((j * 4 + b * 2 + g)) << 13) + s) << 6) + d0; rope = (bj == 0); }
                    else if (pn < 31) { dst = gm + (size_t)row * 2048 + (c - 5888); rope = false; }
                    else { dst = gb + (size_t)row * 32 + (c - 7936); rope = false; }
                    if (rope && rope_wave) {
                        f32x4 p0, p1;
#pragma unroll
                        for (int e = 0; e < 4; ++e) { p0[e] = __shfl_xor(v0[e], 16); p1[e] = __shfl_xor(v1[e], 16); }
                        if (fq == 0) { v0 = v0 * c0 - p0 * s0; v1 = v1 * c1 - p1 * s1; }
                        else if (fq == 1) { v0 = v0 * c0 + p0 * s0; v1 = v1 * c1 + p1 * s1; }
                    }
                    if (pn < 31 || (bj == 0 && wc == 0)) {
                        u32x4 w; w.x = cvt_pk_bf16(v0[0], v0[1]); w.y = cvt_pk_bf16(v0[2], v0[3]); w.z = cvt_pk_bf16(v1[0], v1[1]); w.w = cvt_pk_bf16(v1[2], v1[3]);
                        *(u32x4*)dst = w; }
                }
            }
    }
};
template <int STEP> struct EpiMerge {
    static constexpr bool PERM = true, AFTER_DRAIN = false;
    const bf16_t* gm; float* tmp; bf16_t* merged;
    __device__ __forceinline__ void operator()(const f32x4 (&acc)[2][2][4][2], const Unit& u, int wr, int wc, int fr, int fq) const {
        const int row0 = u.pm * BM + wr * 64 + fr, col0 = u.pn * BM + wc * 32 + 8 * fq;
#pragma unroll
        for (int ai = 0; ai < 2; ++ai)
#pragma unroll
            for (int m = 0; m < 4; ++m)
#pragma unroll
                for (int bj = 0; bj < 2; ++bj) {
                    const int row = row0 + ai * HALF + m * 16, c = col0 + bj * HALF;
                    const u32x4 g = *(const u32x4*)(gm + (size_t)row * 2048 + (STEP - 1) * 1024 + c);
                    f32x4 v0 = acc[ai][bj][m][0], v1 = acc[ai][bj][m][1];
                    v0[0] *= sigmoidf_(bf_lo(g.x)); v0[1] *= sigmoidf_(bf_hi(g.x)); v0[2] *= sigmoidf_(bf_lo(g.y)); v0[3] *= sigmoidf_(bf_hi(g.y));
                    v1[0] *= sigmoidf_(bf_lo(g.z)); v1[1] *= sigmoidf_(bf_hi(g.z)); v1[2] *= sigmoidf_(bf_lo(g.w)); v1[3] *= sigmoidf_(bf_hi(g.w));
                    float* tp = tmp + (size_t)row * 1024 + c;
                    if (STEP == 1) { *(f32x4*)tp = v0; *(f32x4*)(tp + 4) = v1; }
                    else { v0 += *(const f32x4*)tp; v1 += *(const f32x4*)(tp + 4);
                        u32x4 w; w.x = cvt_pk_bf16(v0[0], v0[1]); w.y = cvt_pk_bf16(v0[2], v0[3]); w.z = cvt_pk_bf16(v1[0], v1[1]); w.w = cvt_pk_bf16(v1[2], v1[3]);
                        *(u32x4*)(merged + (size_t)row * 1024 + c) = w; }
                    __builtin_amdgcn_sched_barrier(0);
                }
    }
};
struct EpiResF32 {
    static constexpr bool PERM = true, AFTER_DRAIN = false;
    const float* res; float* out; int ldc;
    __device__ __forceinline__ void operator()(const f32x4 (&acc)[2][2][4][2], const Unit& u, int wr, int wc, int fr, int fq) const {
        const int row0 = u.pm * BM + wr * 64 + fr, col0 = u.pn * BM + wc * 32 + 8 * fq;
#pragma unroll
        for (int ai = 0; ai < 2; ++ai)
#pragma unroll
            for (int m = 0; m < 4; ++m)
#pragma unroll
                for (int bj = 0; bj < 2; ++bj) {
                    const size_t off = (size_t)(row0 + ai * HALF + m * 16) * ldc + col0 + bj * HALF;
                    const f32x4 r0 = *(const f32x4*)(res + off), r1 = *(const f32x4*)(res + off + 4);
                    *(f32x4*)(out + off) = r0 + acc[ai][bj][m][0]; *(f32x4*)(out + off + 4) = r1 + acc[ai][bj][m][1];
                    __builtin_amdgcn_sched_barrier(0);
                }
    }
};
struct EpiRelu2 {
    static constexpr bool PERM = true, AFTER_DRAIN = false;
    bf16_t* O; int ldc;
    __device__ __forceinline__ void operator()(const f32x4 (&acc)[2][2][4][2], const Unit& u, int wr, int wc, int fr, int fq) const {
        const int row0 = u.pm * BM + wr * 64 + fr, col0 = u.pn * BM + wc * 32 + 8 * fq;
#pragma unroll
        for (int ai = 0; ai < 2; ++ai)
#pragma unroll
            for (int m = 0; m < 4; ++m)
#pragma unroll
                for (int bj = 0; bj < 2; ++bj) {
                    f32x4 v0 = acc[ai][bj][m][0], v1 = acc[ai][bj][m][1];
#pragma unroll
                    for (int e = 0; e < 4; ++e) { const float a = fmaxf(v0[e], 0.f), b = fmaxf(v1[e], 0.f); v0[e] = a * a; v1[e] = b * b; }
                    u32x4 w; w.x = cvt_pk_bf16(v0[0], v0[1]); w.y = cvt_pk_bf16(v0[2], v0[3]); w.z = cvt_pk_bf16(v1[0], v1[1]); w.w = cvt_pk_bf16(v1[2], v1[3]);
                    *(u32x4*)(O + (size_t)(row0 + ai * HALF + m * 16) * ldc + col0 + bj * HALF) = w;
                    __builtin_amdgcn_sched_barrier(0);
                }
    }
};

template <class Epi, class Sched, bool ALIGN_EPI = false, bool SP2 = false>
__device__ __forceinline__ void gemm_phase(PG8_LAS unsigned char* lds, const Gemm g, const Sched& S, const Epi& E) {
    int tid_ = threadIdx.x; asm volatile("" : "+v"(tid_));
    const int tid = tid_, wid = __builtin_amdgcn_readfirstlane(tid >> 6), lane = tid & 63, wr = wid >> 2, wc = wid & 3, fr = lane & 15, fq = lane >> 4;
    const int K = g.K, nt = K / BK;
    unsigned voffA[2], voffB[2];
#pragma unroll
    for (int i = 0; i < 2; ++i) { int R, C; stage_rc(tid * 16 + i * 8192, R, C); const int Rb = Epi::PERM ? ((R & ~31) + perm32(R & 31)) : R;
        voffA[i] = (unsigned)(R * K + C) * 2u; voffB[i] = (unsigned)(Rb * K + C) * 2u; }
    const size_t kstep = (size_t)(BK * 2);
    const size_t hstep = (size_t)HALF * K * 2;
    const size_t tstep = 2 * hstep;
    const unsigned ldsw = (unsigned)wid * 1024u;
    const int aoff = lds_byte(wr * 64 + fr, fq * 8), boff = lds_byte(wc * 32 + fr, fq * 8);
#define PG8_SA(b, h) (((b) * 2 + (h)) * HTB)
#define PG8_SB(b, h) ((4 + (b) * 2 + (h)) * HTB)
#define PG8_STAGE(bufoff, gbase, voff) do { _Pragma("unroll") for (int _i = 0; _i < 2; ++_i) \
        __builtin_amdgcn_global_load_lds((const unsigned*)((const char*)(gbase) + (voff)[_i]), (PG8_LAS unsigned*)(lds + (bufoff) + ldsw + _i * 8192), 16, 0, 0); } while (0)
#define PG8_LDA(dst, b, h) do { _Pragma("unroll") for (int m = 0; m < 4; ++m) _Pragma("unroll") for (int k = 0; k < 2; ++k) dst[m][k] = *(const PG8_LAS bf16x8*)(lds + PG8_SA(b, h) + aoff + m * 2048 + k * 1024); } while (0)
#define PG8_LDB(dst, b, h) do { _Pragma("unroll") for (int n = 0; n < 2; ++n) _Pragma("unroll") for (int k = 0; k < 2; ++k) dst[n][k] = *(const PG8_LAS bf16x8*)(lds + PG8_SB(b, h) + boff + n * 2048 + k * 1024); } while (0)
#define PG8_MMA(ai, bj, At, Bt) do { __builtin_amdgcn_s_setprio(1); _Pragma("unroll") for (int m = 0; m < 4; ++m) _Pragma("unroll") for (int n = 0; n < 2; ++n) _Pragma("unroll") for (int k = 0; k < 2; ++k) \
        acc[ai][bj][m][n] = __builtin_amdgcn_mfma_f32_16x16x32_bf16(Bt[n][k], At[m][k], acc[ai][bj][m][n], 0, 0, 0); __builtin_amdgcn_s_setprio(0); } while (0)
#define PG8_WAIT_V(n) asm volatile("s_waitcnt vmcnt(" #n ")" ::: "memory")
#define PG8_WAIT_L(n) asm volatile("s_waitcnt lgkmcnt(" #n ")" ::: "memory")
#define PG8_BAR __builtin_amdgcn_s_barrier()
#define PG8_SCHED __builtin_amdgcn_sched_barrier(0)
    Unit cur, nxt; int ui = 0;
    if (!S.next(0, cur)) return;
    f32x4 acc[2][2][4][2];
#pragma unroll
    for (int a = 0; a < 2; ++a)
#pragma unroll
        for (int b = 0; b < 2; ++b)
#pragma unroll
            for (int m = 0; m < 4; ++m)
#pragma unroll
                for (int n = 0; n < 2; ++n) acc[a][b][m][n] = (f32x4){0.f, 0.f, 0.f, 0.f};
    bf16x8 At[4][2], B0[2][2], B1[2][2];
    const char* cA = (const char*)g.A + (size_t)cur.pm * tstep; const char* cB = (const char*)g.Bt + (size_t)cur.pn * tstep;
    S.a_ready(cur);
    if constexpr (SP2) {
        PG8_STAGE(PG8_SB(0, 0), cB, voffB); PG8_STAGE(PG8_SB(0, 1), cB + hstep, voffB); PG8_STAGE(PG8_SA(0, 0), cA, voffA); PG8_STAGE(PG8_SA(0, 1), cA + hstep, voffA);
        if (wr == 1) PG8_BAR;
        PG8_WAIT_V(2); PG8_BAR;
        PG8_STAGE(PG8_SB(1, 0), cB + kstep, voffB); PG8_STAGE(PG8_SA(1, 0), cA + kstep, voffA); PG8_STAGE(PG8_SB(1, 1), cB + hstep + kstep, voffB);
        PG8_WAIT_V(6); PG8_BAR;
    } else {
        PG8_STAGE(PG8_SB(0, 0), cB, voffB); PG8_STAGE(PG8_SA(0, 0), cA, voffA); PG8_STAGE(PG8_SB(0, 1), cB + hstep, voffB); PG8_STAGE(PG8_SA(0, 1), cA + hstep, voffA);
        if (wr == 1) PG8_BAR;
        PG8_WAIT_V(4); PG8_BAR;
        PG8_STAGE(PG8_SB(1, 0), cB + kstep, voffB); PG8_STAGE(PG8_SA(1, 0), cA + kstep, voffA); PG8_STAGE(PG8_SB(1, 1), cB + hstep + kstep, voffB);
        PG8_WAIT_V(6); PG8_BAR;
    }
    for (;;) {
        const bool has_next = S.next(ui + 1, nxt);
        const char* nA = has_next ? (const char*)g.A + (size_t)nxt.pm * tstep : cA; const char* nB = has_next ? (const char*)g.Bt + (size_t)nxt.pn * tstep : cB;
        for (int t = 0; t < nt; t += 2) {
            const bool last = (t == nt - 2);
            const char* a1 = cA + (size_t)(t + 1) * kstep;
            const char* a2 = last ? nA : cA + (size_t)(t + 2) * kstep; const char* b2 = last ? nB : cB + (size_t)(t + 2) * kstep;
            const char* a3 = a2 + kstep; const char* b3 = b2 + kstep;
            if (last && has_next) S.a_ready(nxt);
            if constexpr (SP2) {
            PG8_LDB(B0, 0, 0); PG8_LDB(B1, 0, 1); PG8_SCHED; PG8_LDA(At, 0, 0); PG8_STAGE(PG8_SA(1, 1), a1 + hstep, voffA);
            PG8_WAIT_V(8); PG8_WAIT_L(0); PG8_BAR; PG8_MMA(0, 0, At, B0); PG8_MMA(0, 1, At, B1); PG8_BAR; PG8_SCHED;
            PG8_LDA(At, 0, 1); PG8_STAGE(PG8_SB(0, 0), b2, voffB); PG8_STAGE(PG8_SB(0, 1), b2 + hstep, voffB); PG8_STAGE(PG8_SA(0, 0), a2, voffA);
            PG8_WAIT_V(8); PG8_WAIT_L(0); PG8_BAR; PG8_MMA(1, 0, At, B0); PG8_MMA(1, 1, At, B1); PG8_BAR; PG8_SCHED;
            PG8_LDB(B0, 1, 0); PG8_LDB(B1, 1, 1); PG8_SCHED; PG8_LDA(At, 1, 0); PG8_STAGE(PG8_SA(0, 1), a2 + hstep, voffA);
            PG8_WAIT_V(8); PG8_WAIT_L(0); PG8_BAR; PG8_MMA(0, 0, At, B0); PG8_MMA(0, 1, At, B1); PG8_BAR; PG8_SCHED;
            PG8_LDA(At, 1, 1); PG8_STAGE(PG8_SB(1, 0), b3, voffB); PG8_STAGE(PG8_SB(1, 1), b3 + hstep, voffB); PG8_STAGE(PG8_SA(1, 0), a3, voffA);
            PG8_WAIT_V(8); PG8_WAIT_L(0); PG8_BAR; PG8_MMA(1, 0, At, B0); PG8_MMA(1, 1, At, B1); PG8_BAR; PG8_SCHED;
            } else {
            PG8_LDB(B0, 0, 0); PG8_SCHED; PG8_LDA(At, 0, 0); PG8_STAGE(PG8_SA(1, 1), a1 + hstep, voffA);
            PG8_WAIT_L(8); PG8_BAR; PG8_WAIT_L(0); PG8_MMA(0, 0, At, B0); PG8_BAR; PG8_SCHED;
            PG8_LDB(B1, 0, 1); PG8_STAGE(PG8_SB(0, 0), b2, voffB);
            PG8_BAR; PG8_WAIT_L(0); PG8_MMA(0, 1, At, B1); PG8_BAR;
            PG8_LDA(At, 0, 1); PG8_STAGE(PG8_SA(0, 0), a2, voffA);
            PG8_BAR; PG8_WAIT_L(0); PG8_MMA(1, 0, At, B0); PG8_BAR; PG8_SCHED;
            PG8_STAGE(PG8_SB(0, 1), b2 + hstep, voffB);
            PG8_WAIT_V(6); PG8_BAR; PG8_MMA(1, 1, At, B1); PG8_BAR;
            PG8_LDB(B0, 1, 0); PG8_SCHED; PG8_LDA(At, 1, 0); PG8_STAGE(PG8_SA(0, 1), a2 + hstep, voffA);
            PG8_WAIT_L(8); PG8_BAR; PG8_WAIT_L(0); PG8_MMA(0, 0, At, B0); PG8_BAR; PG8_SCHED;
            PG8_LDB(B1, 1, 1); PG8_STAGE(PG8_SB(1, 0), b3, voffB);
            PG8_BAR; PG8_WAIT_L(0); PG8_MMA(0, 1, At, B1); PG8_BAR;
            PG8_LDA(At, 1, 1); PG8_STAGE(PG8_SA(1, 0), a3, voffA);
            PG8_BAR; PG8_WAIT_L(0); PG8_MMA(1, 0, At, B0); PG8_BAR; PG8_SCHED;
            PG8_STAGE(PG8_SB(1, 1), b3 + hstep, voffB);
            PG8_WAIT_V(6); PG8_BAR; PG8_MMA(1, 1, At, B1); PG8_BAR;
            }
        }
        if constexpr (ALIGN_EPI) { if (wr == 0) PG8_BAR; }
        if constexpr (!Epi::AFTER_DRAIN) { E(acc, cur, wr, wc, fr, fq); S.done(cur); }
        if (!has_next) break;
#pragma unroll
        for (int a = 0; a < 2; ++a)
#pragma unroll
            for (int b = 0; b < 2; ++b)
#pragma unroll
                for (int m = 0; m < 4; ++m)
#pragma unroll
                    for (int n = 0; n < 2; ++n) acc[a][b][m][n] = (f32x4){0.f, 0.f, 0.f, 0.f};
        cur = nxt; cA = nA; cB = nB; ++ui;
        if constexpr (ALIGN_EPI) { if (wr == 1) PG8_BAR; }
    }
    PG8_WAIT_V(0);
    if constexpr (!ALIGN_EPI) { if (wr == 0) PG8_BAR; }
    PG8_BAR;
    if constexpr (Epi::AFTER_DRAIN) { E.fused(acc, cur, wr, wc, fr, fq, lds, wid, lane); S.done(cur); }
#undef PG8_SA
#undef PG8_SB
#undef PG8_STAGE
#undef PG8_LDA
#undef PG8_LDB
#undef PG8_MMA
#undef PG8_WAIT_V
#undef PG8_WAIT_L
#undef PG8_BAR
#undef PG8_SCHED
}
}

#define DI __device__ __forceinline__
#define LAS __attribute__((address_space(3)))
typedef unsigned short bf16;
typedef short bf16x8 __attribute__((ext_vector_type(8)));
typedef short s16x4 __attribute__((ext_vector_type(4)));
typedef float f32x4 __attribute__((ext_vector_type(4)));
typedef float f32x16 __attribute__((ext_vector_type(16)));
typedef unsigned u32x4 __attribute__((ext_vector_type(4)));
typedef unsigned u32x2 __attribute__((ext_vector_type(2)));
#define MFMA32(a, b, c) __builtin_amdgcn_mfma_f32_32x32x16_bf16((a), (b), (c), 0, 0, 0)
#define LDS_WAIT() asm volatile("s_waitcnt lgkmcnt(0)" ::: "memory")

constexpr int SEQ = 8192, TOK = 16384, DM = 1024, FF = 4096, NIN = 8192, NTHR = 512;
constexpr size_t MiB = 1u << 20;
constexpr size_t WS_WIN = 1 * MiB, WS_WA = 17 * MiB, WS_WB = 18 * MiB, WS_WO = 19 * MiB, WS_W1K = 21 * MiB, WS_W1V = 22 * MiB, WS_SMALL = 23 * MiB,
                 WS_KC = 24 * MiB, WS_LSE = 25 * MiB, WS_GB = 27 * MiB, WS_QB = 28 * MiB, WS_KVB = 44 * MiB, WS_R2 = 68 * MiB, WS_R1 = 100 * MiB,
                 WS_WUP = 228 * MiB, WS_WDN = 236 * MiB, WS_END = 244 * MiB;
constexpr int LDS_BYTES = 147456;
constexpr int KVROW = 144, KVT = 64 * KVROW;
constexpr float SC_LOG2E = 0.125f * 1.4426950408889634f;

struct Args { const float* in[16]; float* out; unsigned char* ws; };

struct Frame {
    LAS unsigned char* lds; int tid, lane, wave, G, bid;
    const float *x, *g_mix, *w_in, *pos_k, *w1_k, *w2_k, *pos_v, *w1_v, *w2_v, *w_a, *w_b, *w_out, *g_mlp, *w_up, *w_down, *g_fin;
    float* out; unsigned char* ws;
    DI bf16* WIN() const { return (bf16*)(ws + (WS_WIN)); }
    DI bf16* WA() const { return (bf16*)(ws + (WS_WA)); }
    DI bf16* WB() const { return (bf16*)(ws + (WS_WB)); }
    DI bf16* WO() const { return (bf16*)(ws + (WS_WO)); }
    DI bf16* W1K() const { return (bf16*)(ws + (WS_W1K)); }
    DI bf16* W1V() const { return (bf16*)(ws + (WS_W1V)); }
    DI bf16* W2K() const { return (bf16*)(ws + (WS_SMALL)); }
    DI bf16* W2V() const { return (bf16*)(ws + (WS_SMALL + 32768)); }
    DI bf16* KC() const { return (bf16*)(ws + (WS_KC)); }
    DI bf16* VC() const { return (bf16*)(ws + (WS_KC + 262144)); }
    DI bf16* GB() const { return (bf16*)(ws + (WS_GB)); }
    DI bf16* QB() const { return (bf16*)(ws + (WS_QB)); }
    DI bf16* KVB() const { return (bf16*)(ws + (WS_KVB)); }
    DI bf16* U() const { return (bf16*)(ws + (WS_R2)); }
    DI bf16* OG0() const { return (bf16*)(ws + (WS_R2)); }
    DI bf16* OG1() const { return (bf16*)(ws + (WS_R2 + 16 * MiB)); }
    DI bf16* OG2() const { return (bf16*)(ws + (WS_WIN)); }
    DI bf16* QKVA() const { return (bf16*)(ws + (WS_R1)); }
    DI bf16* YA() const { return (bf16*)(ws + (WS_R1)); }
    DI bf16* YB() const { return (bf16*)(ws + (WS_R1 + 16 * MiB)); }
    DI bf16* MERGED() const { return (bf16*)(ws + (WS_R1 + 96 * MiB)); }
    DI bf16* H() const { return (bf16*)(ws + (WS_R1)); }
    DI bf16* WUP() const { return (bf16*)(ws + (WS_WUP)); }
    DI bf16* WDN() const { return (bf16*)(ws + (WS_WDN)); }
    DI float* BIASK() const { return (float*)(ws + (WS_SMALL + 65536)); }
    DI float* BIASV() const { return (float*)(ws + (WS_SMALL + 81920)); }
    DI float* CS() const { return (float*)(ws + (WS_SMALL + 131072)); }
    DI float* LSE() const { return (float*)(ws + (WS_LSE)); }
    DI float* TMP() const { return (float*)(ws + (WS_R1 + 32 * MiB)); }
    DI bf16* GM() const { return (bf16*)out; }
};

DI float wave_sum(float v) {
#pragma unroll
    for (int o = 1; o < 64; o <<= 1) v += __shfl_xor(v, o);
    return v;
}
DI unsigned f2bf(float f) { unsigned u = __builtin_bit_cast(unsigned, f); return (u + 0x7fffu + ((u >> 16) & 1u)) >> 16; }
DI unsigned pk2(float lo, float hi) { return f2bf(lo) | (f2bf(hi) << 16); }
DI float bf2f(bf16 v) { return __builtin_bit_cast(float, (unsigned)v << 16); }
DI float sigm(float x) { return 1.f / (1.f + __expf(-x)); }
DI f32x16 zero16() { f32x16 z;
#pragma unroll
    for (int i = 0; i < 16; ++i) z[i] = 0.f;
    return z; }

DI void transpose_item(const float* W, int ldw, int col0, int ncols, int k0, bf16* WT, int K, int drow0, LAS float* scr, int lane) {
    const int cl = lane & 31;
#pragma unroll 8
    for (int i = 0; i < 32; ++i) { const int kk = 2 * i + (lane >> 5); scr[kk * 33 + cl] = (cl < ncols) ? W[(size_t)(k0 + kk) * ldw + col0 + cl] : 0.f; }
    LDS_WAIT();
    const int c = lane & 7;
#pragma unroll
    for (int j = 0; j < 4; ++j) { const int n = (lane >> 3) + 8 * j; const LAS float* s = scr + (8 * c) * 33 + n;
        u32x4 o; o.x = pk2(s[0 * 33], s[1 * 33]); o.y = pk2(s[2 * 33], s[3 * 33]); o.z = pk2(s[4 * 33], s[5 * 33]); o.w = pk2(s[6 * 33], s[7 * 33]);
        if (n < ncols) *(u32x4*)(WT + (size_t)(drow0 + n) * K + k0 + 8 * c) = o; }
    LDS_WAIT();
}
DI bool transpose_job(int& item, const float* W, int ldw, int scol0, int ncols, int K, bf16* WT, int drow0, LAS float* scr, int lane) {
    const int nblk = (ncols + 31) >> 5, nitems = (K >> 6) * nblk;
    if (item >= nitems) { item -= nitems; return false; }
    const int kb = item / nblk, nb = item - kb * nblk;
    const int rem = ncols - 32 * nb;
    transpose_item(W, ldw, scol0 + 32 * nb, rem < 32 ? rem : 32, 64 * kb, WT, K, drow0 + 32 * nb, scr, lane);
    return true;
}
DI void rms_row_bf16(const float* xrow, const float* g, bf16* orow, int lane) {
    const f32x4* xr = (const f32x4*)xrow + lane; const f32x4* gr = (const f32x4*)g + lane;
    f32x4 v[4]; float s = 0.f;
#pragma unroll
    for (int j = 0; j < 4; ++j) { v[j] = xr[64 * j]; s += (v[j].x * v[j].x + v[j].y * v[j].y) + (v[j].z * v[j].z + v[j].w * v[j].w); }
    const float rstd = 1.f / sqrtf(wave_sum(s) * (1.f / DM) + 1e-6f);
    unsigned long long* o8 = (unsigned long long*)orow + lane;
#pragma unroll
    for (int j = 0; j < 4; ++j) { const f32x4 gg = gr[64 * j];
        o8[64 * j] = (unsigned long long)pk2(v[j].x * rstd * gg.x, v[j].y * rstd * gg.y) | ((unsigned long long)pk2(v[j].z * rstd * gg.z, v[j].w * rstd * gg.w) << 32); }
}
DI void rms_row_f32_inplace(float* xrow, const float* g, int lane) {
    f32x4* xr = (f32x4*)xrow + lane; const f32x4* gr = (const f32x4*)g + lane;
    f32x4 v[4]; float s = 0.f;
#pragma unroll
    for (int j = 0; j < 4; ++j) { v[j] = xr[64 * j]; s += (v[j].x * v[j].x + v[j].y * v[j].y) + (v[j].z * v[j].z + v[j].w * v[j].w); }
    const float rstd = 1.f / sqrtf(wave_sum(s) * (1.f / DM) + 1e-6f);
#pragma unroll
    for (int j = 0; j < 4; ++j) xr[64 * j] = v[j] * rstd * gr[64 * j];
}

DI void p0_prologue(const Frame& F) {
    LAS float* scr = (LAS float*)(F.lds + F.wave * 16384);
    const int gw = F.bid * 8 + F.wave, NGW = F.G * 8;
    constexpr int NITEMS = 16 * 184 + 16 * 64 + 16 + 256 + 256 + 512 + 256 + 256 + 8 + 8;
    for (int it = gw; it < NITEMS; it += NGW) {
        int r = it;
        if (transpose_job(r, F.w_in, 7960, 0, 5888, DM, F.WIN(), 0, scr, F.lane)) continue;
        if (transpose_job(r, F.w_in, 7960, 5912, 2048, DM, F.WIN(), 5888, scr, F.lane)) continue;
        if (transpose_job(r, F.w_in, 7960, 5888, 24, DM, F.WIN(), 7936, scr, F.lane)) continue;
        if (transpose_job(r, F.w_a, 1024, 0, 1024, 512, F.WA(), 0, scr, F.lane)) continue;
        if (transpose_job(r, F.w_b, 1024, 0, 1024, 512, F.WB(), 0, scr, F.lane)) continue;
        if (transpose_job(r, F.w_out, 1024, 0, 1024, 1024, F.WO(), 0, scr, F.lane)) continue;
        if (transpose_job(r, F.w1_k, 256, 0, 256, 2048, F.W1K(), 0, scr, F.lane)) continue;
        if (transpose_job(r, F.w1_v, 256, 0, 256, 2048, F.W1V(), 0, scr, F.lane)) continue;
        if (transpose_job(r, F.w2_k, 64, 0, 64, 256, F.W2K(), 0, scr, F.lane)) continue;
        transpose_job(r, F.w2_v, 64, 0, 64, 256, F.W2V(), 0, scr, F.lane);
    }
    const int gt = F.bid * NTHR + F.tid, NGT = F.G * NTHR;
    for (int i = gt; i < 232 * 1024 / 8; i += NGT) *(u32x4*)(F.WIN() + (size_t)7960 * 1024 + (size_t)i * 8) = (u32x4){0u, 0u, 0u, 0u};
    for (int i = gt; i < SEQ * 8; i += NGT) {
        const int s = i >> 3, k = i & 7;
        const double inv[8] = {1.0, 0.19392274474868576, 0.03760603093086393, 0.007292664737217109, 0.001414213562373095, 0.0002742481756762073, 5.318295896944988e-05, 1.031338537721246e-05};
        double iv = inv[0];
#pragma unroll
        for (int q = 1; q < 8; ++q) iv = (k == q) ? inv[q] : iv;
        const double rev = (double)s * iv * 0.15915494309189535;
        const float fr = (float)(rev - __builtin_rint(rev));
        F.CS()[s * 16 + k] = __builtin_amdgcn_cosf(fr); F.CS()[s * 16 + 8 + k] = __builtin_amdgcn_sinf(fr);
    }
    for (int m = gw; m < TOK; m += NGW) rms_row_bf16(F.x + (size_t)m * DM, F.g_mix, F.U() + (size_t)m * DM, F.lane);
    if (F.bid < 32) {
        const int mat = F.bid >> 4, part = F.bid & 15, col = F.tid & 255, kh = F.tid >> 8;
        const float* pe = mat ? F.pos_v : F.pos_k; const float* W1 = mat ? F.w1_v : F.w1_k; float acc = 0.f;
        const int kb = part * 128 + kh * 64;
#pragma unroll 8
        for (int k = 0; k < 64; ++k) acc += pe[kb + k] * W1[(size_t)(kb + k) * 256 + col];
        LAS float* red = (LAS float*)F.lds;
        __syncthreads();
        if (kh) red[col] = acc;
        __syncthreads();
        if (!kh) (mat ? F.BIASV() : F.BIASK())[part * 256 + col] = acc + red[col];
        __syncthreads();
    }
    if (F.bid == 2) { const int kv = F.tid >> 8, bg = (F.tid >> 6) & 3, d = F.tid & 63; (kv ? F.VC() : F.KC())[((bg * 512 + 511) << 6) + d] = 0; }
}

struct Stg { u32x4 k, v; };
DI void stage_load(Stg& s, const bf16* Kg, const bf16* Vg, int row0, int tid) {
    s.k = *(const u32x4*)(Kg + ((size_t)row0 << 6) + tid * 8); s.v = *(const u32x4*)(Vg + ((size_t)row0 << 6) + tid * 8);
}
DI void stage_store(const Stg& s, LAS unsigned char* lds, int buf, int tid) {
    const int off = (tid >> 3) * KVROW + (tid & 7) * 16;
    *(LAS u32x4*)(lds + buf * 2 * KVT + off) = s.k; *(LAS u32x4*)(lds + buf * 2 * KVT + KVT + off) = s.v;
}
DI unsigned pkbf(float a, float b) {
    typedef __bf16 bf2 __attribute__((ext_vector_type(2))); typedef float f2 __attribute__((ext_vector_type(2)));
    f2 v = {a, b}; bf2 r = __builtin_convertvector(v, bf2); return __builtin_bit_cast(unsigned, r);
}
DI void qk_tile(LAS const unsigned char* kt, const bf16x8 (&qf)[4], f32x16 (&s)[2], int lane) {
    const int r = lane & 31, h = lane >> 5;
    const int sr = (r & 19) | ((r & 4) << 1) | ((r & 8) >> 1);
#pragma unroll
    for (int kh = 0; kh < 2; ++kh) { s[kh] = zero16(); LAS const unsigned char* kp = kt + (kh * 32 + sr) * KVROW + h * 16;
#pragma unroll
        for (int ks = 0; ks < 4; ++ks) { const bf16x8 a = *(LAS const bf16x8*)(kp + ks * 32); s[kh] = MFMA32(a, qf[ks], s[kh]); } }
}
DI float xhalf_max(float v) { auto rr = __builtin_amdgcn_permlane32_swap(__float_as_uint(v), __float_as_uint(v), false, false); return fmaxf(__uint_as_float(rr[0]), __uint_as_float(rr[1])); }
DI float xhalf_sum(float v) { auto rr = __builtin_amdgcn_permlane32_swap(__float_as_uint(v), __float_as_uint(v), false, false); return __uint_as_float(rr[0]) + __uint_as_float(rr[1]); }
typedef float f32x2 __attribute__((ext_vector_type(2)));
DI void flash_tile(LAS const unsigned char* kt, LAS const unsigned char* vt, const bf16x8 (&qf)[4], f32x16 (&o)[2], float& m, float& l, int dq, unsigned maxoff, bool sel, int lane) {
    const int h = lane >> 5;
    f32x16 s[2];
    qk_tile(kt, qf, s, lane);
    const bool lane_full = (dq >= 55) && ((unsigned)dq <= maxoff);
    if (__ballot(!lane_full) != 0ull) {
#pragma unroll
        for (int kh = 0; kh < 2; ++kh)
#pragma unroll
            for (int i = 0; i < 16; ++i) { const int kk = 32 * kh + 16 * (i >> 3) + (i & 7); s[kh][i] = ((unsigned)(dq - kk) <= maxoff) ? s[kh][i] : -1e30f; }
    }
    float mx = -1e30f;
#pragma unroll
    for (int kh = 0; kh < 2; ++kh)
#pragma unroll
        for (int i = 0; i < 16; ++i) mx = fmaxf(mx, s[kh][i]);
    mx = xhalf_max(mx);
    mx = sel ? mx : -1e30f;
    const bool need = mx > m + 40.f;
    if (__ballot(need) != 0ull) {
        const float mn = need ? mx : m;
        const float alpha = need ? __builtin_amdgcn_exp2f((m - mn) * SC_LOG2E) : 1.f;
        m = mn; l *= alpha; o[0] *= alpha; o[1] *= alpha;
    }
    const float mb = sel ? fmaxf(m, -1e20f) * SC_LOG2E : 1e30f;
    f32x2 ps2 = {0.f, 0.f};
#pragma unroll
    for (int kh = 0; kh < 2; ++kh)
#pragma unroll
        for (int i = 0; i < 16; i += 2) {
            f32x2 x = {s[kh][i], s[kh][i + 1]};
            x = x * SC_LOG2E - mb;
            f32x2 p; p.x = __builtin_amdgcn_exp2f(x.x); p.y = __builtin_amdgcn_exp2f(x.y);
            ps2 += p; s[kh][i] = p.x; s[kh][i + 1] = p.y; }
    l += ps2.x + ps2.y;
    const int q4 = (lane & 15) >> 2, p4 = lane & 3, blk = (lane >> 4) & 1;
    LAS const unsigned char* vb = vt + (8 * h + q4) * KVROW + 8 * (4 * blk + p4);
#pragma unroll
    for (int kh = 0; kh < 2; ++kh)
#pragma unroll
        for (int s2 = 0; s2 < 2; ++s2) {
            u32x4 pw; pw.x = pkbf(s[kh][8 * s2 + 0], s[kh][8 * s2 + 1]); pw.y = pkbf(s[kh][8 * s2 + 2], s[kh][8 * s2 + 3]);
            pw.z = pkbf(s[kh][8 * s2 + 4], s[kh][8 * s2 + 5]); pw.w = pkbf(s[kh][8 * s2 + 6], s[kh][8 * s2 + 7]);
            const bf16x8 pf = __builtin_bit_cast(bf16x8, pw);
#pragma unroll
            for (int db = 0; db < 2; ++db) {
                LAS const unsigned char* vp = vb + (32 * kh + 16 * s2) * KVROW + db * 64;
                const s16x4 lo = __builtin_amdgcn_ds_read_tr16_b64_v4i16((LAS s16x4*)(vp));
                const s16x4 hi = __builtin_amdgcn_ds_read_tr16_b64_v4i16((LAS s16x4*)(vp + 4 * KVROW));
                const bf16x8 vf = __builtin_shufflevector(lo, hi, 0, 1, 2, 3, 4, 5, 6, 7);
                o[db] = MFMA32(vf, pf, o[db]);
            }
        }
}
DI void write_o_row(bf16* dst, const f32x16 (&o)[2], float scale, int h) {
#pragma unroll
    for (int db = 0; db < 2; ++db)
#pragma unroll
        for (int i4 = 0; i4 < 4; ++i4) {
            u32x2 w; w.x = pkbf(o[db][4 * i4] * scale, o[db][4 * i4 + 1] * scale); w.y = pkbf(o[db][4 * i4 + 2] * scale, o[db][4 * i4 + 3] * scale);
            *(u32x2*)(dst + 32 * db + 8 * i4 + 4 * h) = w;
        }
}

DI void mixa_task(const Frame& F, int task) {
    const int tile32 = task & 31, hb = task >> 5, b = hb & 1, head = hb >> 1;
    const int g = head >> 3, slot = head & 7, lg = 2 * g;
    const int prow0 = tile32 * 256, L = SEQ >> lg, res = prow0 >> (13 - lg), p0 = prow0 & (L - 1);
    const bf16* Q = F.QKVA() + ((size_t)((head) * 2 + b) << 19);
    const bf16* K = F.QKVA() + ((size_t)((24 + head) * 2 + b) << 19);
    const bf16* V = F.QKVA() + ((size_t)((48 + head) * 2 + b) << 19);
    const int w = F.wave, lane = F.lane, r = lane & 31, h = lane >> 5;
    bf16x8 qf[4];
    { const bf16* qr = Q + ((size_t)(prow0 + 32 * w + r) << 6) + 8 * h;
#pragma unroll
      for (int ks = 0; ks < 4; ++ks) qf[ks] = *(const bf16x8*)(qr + 16 * ks); }
    f32x16 o[2] = {zero16(), zero16()}; float m = -1e30f, l = 0.f;
    const int kt0 = (p0 == 0) ? 2 : 0;
    Stg st; stage_load(st, K, V, prow0 - 128 + 64 * kt0, F.tid);
    for (int kt = kt0; kt < 6; ++kt) {
        const int buf = kt & 1;
        stage_store(st, F.lds, buf, F.tid);
        __syncthreads();
        if (kt + 1 < 6) stage_load(st, K, V, prow0 - 128 + 64 * (kt + 1), F.tid);
        if (kt >= (w >> 1) && kt <= (w >> 1) + 2)
            flash_tile(F.lds + buf * 2 * KVT, F.lds + buf * 2 * KVT + KVT, qf, o, m, l, 128 + 32 * w + r - 64 * kt - 8 * h, 128u, true, lane);
    }
    __syncthreads();
    const float lt = xhalf_sum(l);
    const float inv = 1.f / lt;
    const int s = ((p0 + 32 * w + r) << lg) | res;
    const size_t row = (size_t)b * SEQ + s;
    bf16* og = (bf16*)(F.ws + ((g == 0) ? WS_R2 : (g == 1) ? (WS_R2 + 16 * MiB) : WS_WIN));
    write_o_row(og + row * 512 + slot * 64, o, inv, h);
    if (h == 0) F.LSE()[((size_t)g * TOK + row) * 8 + slot] = m * 0.125f + __logf(lt);
}

DI float gelu_tanh(float x) { const float u = 0.7978845608028654f * (x + 0.044715f * x * x * x); const float e = __expf(2.f * u); const float t = 1.f - 2.f / (e + 1.f); return 0.5f * x * (1.f + t); }
DI void compress_task(const Frame& F, int task) {
    const int kv = task >> 5, bg = (task >> 3) & 3, it = task & 7;
    const bf16* A = F.KVB() + ((size_t)(kv * 4 + bg) << 19);
    const bf16* W1T = kv ? F.W1V() : F.W1K(); const bf16* W2T = kv ? F.W2V() : F.W2K(); const float* bias = kv ? F.BIASV() : F.BIASK();
    bf16* OUT = (kv ? F.VC() : F.KC()) + ((size_t)bg << 15);
    const int w = F.wave, lane = F.lane, r = lane & 31, h = lane >> 5;
    LAS unsigned char* hid = F.lds;
    f32x16 acc[2] = {zero16(), zero16()};
    int i0 = 64 * it + r, i1 = i0 + 32; i0 = i0 > 510 ? 510 : i0; i1 = i1 > 510 ? 510 : i1;
    const bf16* a0p = A + (size_t)i0 * 1024 + 8 * h; const bf16* a1p = A + (size_t)i1 * 1024 + 8 * h;
    const bf16* bp = W1T + (size_t)(32 * w + r) * 2048 + 8 * h;
#pragma unroll 4
    for (int k0 = 0; k0 < 2048; k0 += 16) {
        const bf16x8 bfr = *(const bf16x8*)(bp + k0), a0 = *(const bf16x8*)(a0p + k0), a1 = *(const bf16x8*)(a1p + k0);
        acc[0] = MFMA32(a0, bfr, acc[0]); acc[1] = MFMA32(a1, bfr, acc[1]);
    }
    float bs = 0.f;
#pragma unroll
    for (int j = 0; j < 16; ++j) bs += bias[j * 256 + 32 * w + r];
#pragma unroll
    for (int rb = 0; rb < 2; ++rb)
#pragma unroll
        for (int i = 0; i < 16; ++i) { const int row = 32 * rb + (i & 3) + 8 * (i >> 2) + 4 * h;
            *(LAS bf16*)(hid + row * 528 + (32 * w + r) * 2) = (bf16)f2bf(gelu_tanh(acc[rb][i] + bs)); }
    __syncthreads();
    if (w < 4) {
        const int rb = w & 1, cb = w >> 1; f32x16 c = zero16();
        const bf16* b2 = W2T + (size_t)(32 * cb + r) * 256 + 8 * h;
#pragma unroll
        for (int k0 = 0; k0 < 256; k0 += 16) { const bf16x8 a = *(LAS const bf16x8*)(hid + (32 * rb + r) * 528 + (k0 + 8 * h) * 2); const bf16x8 bb = *(const bf16x8*)(b2 + k0); c = MFMA32(a, bb, c); }
#pragma unroll
        for (int i = 0; i < 16; ++i) { const int row = 64 * it + 32 * rb + (i & 3) + 8 * (i >> 2) + 4 * h;
            if (row < 511) OUT[((size_t)row << 6) + 32 * cb + r] = (bf16)f2bf(c[i]); }
    }
    __syncthreads();
}

DI float dpp_quad_sum(float p) {
    p += __builtin_bit_cast(float, __builtin_amdgcn_update_dpp(0, __builtin_bit_cast(int, p), 0xB1, 0xF, 0xF, true));
    p += __builtin_bit_cast(float, __builtin_amdgcn_update_dpp(0, __builtin_bit_cast(int, p), 0x4E, 0xF, 0xF, true));
    return p;
}
DI void nsa_task(const Frame& F, int b, int g, int tt) {
    const int w = F.wave, lane = F.lane, r = lane & 31, h = lane >> 5, tid = F.tid;
    const int t0 = tt * 64, tok = 8 * w + (r >> 2), t = t0 + tok, head = 4 * g + (r & 3);
    const size_t row = (size_t)b * SEQ + t;
    const int bg = b * 2 + g;
    bf16x8 qf[4];
    { const bf16* qr = F.QB() + row * 512 + head * 64 + 8 * h;
#pragma unroll
      for (int ks = 0; ks < 4; ++ks) qf[ks] = *(const bf16x8*)(qr + 16 * ks); }
    float g0, g1, g2;
    { const bf16* gp = F.GB() + row * 32 + head * 3; g0 = sigm(bf2f(gp[0])); g1 = sigm(bf2f(gp[1])); g2 = sigm(bf2f(gp[2])); }
    LAS float* imp = (LAS float*)(F.lds + 4 * KVT);
    for (int i = tid; i < 64 * 132; i += NTHR) imp[i] = 0.f;
    f32x16 yacc[2];
    const int nvis = (4 * tt + 3) < 511 ? (4 * tt + 3) : 511, nct = (nvis + 63) >> 6;
    const bf16* Kc = F.KC() + ((size_t)bg << 15); const bf16* Vc = F.VC() + ((size_t)bg << 15);
    const int lim = (t - 31) >> 4;
    float mc, invc;
    {
        f32x16 o[2] = {zero16(), zero16()}; float m = -1e30f, l = 0.f;
        Stg st; stage_load(st, Kc, Vc, 0, tid);
        for (int ct = 0; ct < nct; ++ct) {
            const int buf = ct & 1;
            stage_store(st, F.lds, buf, tid);
            __syncthreads();
            if (ct + 1 < nct) stage_load(st, Kc, Vc, 64 * (ct + 1), tid);
            flash_tile(F.lds + buf * 2 * KVT, F.lds + buf * 2 * KVT + KVT, qf, o, m, l, lim - 64 * ct - 8 * h, 0x7fffffffu, true, lane);
        }
        __syncthreads();
        const float lt = xhalf_sum(l);
        invc = lt > 0.f ? 1.f / lt : 0.f; mc = m;
        yacc[0] = o[0] * (g0 * invc); yacc[1] = o[1] * (g0 * invc);
    }
    {
        const float mb = mc * SC_LOG2E;
        Stg st; stage_load(st, Kc, Vc, 0, tid);
        for (int ct = 0; ct < nct; ++ct) {
            const int buf = ct & 1;
            stage_store(st, F.lds, buf, tid);
            __syncthreads();
            if (ct + 1 < nct) stage_load(st, Kc, Vc, 64 * (ct + 1), tid);
            f32x16 s[2];
            qk_tile(F.lds + buf * 2 * KVT, qf, s, lane);
            const int dq = lim - 64 * ct - 8 * h;
#pragma unroll
            for (int kh = 0; kh < 2; ++kh)
#pragma unroll
                for (int s2 = 0; s2 < 2; ++s2) {
                    float ps[8];
#pragma unroll
                    for (int j = 0; j < 8; ++j) { const int kk = 32 * kh + 16 * s2 + j; const bool v = (dq - kk) >= 0;
                        const float p = v ? __builtin_amdgcn_exp2f(s[kh][8 * s2 + j] * SC_LOG2E - mb) * invc : 0.f; ps[j] = dpp_quad_sum(p); }
                    const float sa = (ps[0] + ps[1]) + (ps[2] + ps[3]), sb = (ps[4] + ps[5]) + (ps[6] + ps[7]);
                    LAS float* ip = imp + tok * 132 + 16 * ct + 8 * kh + 4 * s2 + 2 * h;
                    if ((r & 3) == 0) {
                        __hip_atomic_fetch_add(ip, sa, __ATOMIC_RELAXED, __HIP_MEMORY_SCOPE_WORKGROUP);
                        __hip_atomic_fetch_add(ip + 1, sb + ps[3], __ATOMIC_RELAXED, __HIP_MEMORY_SCOPE_WORKGROUP);
                        __hip_atomic_fetch_add(ip + 2, ps[7], __ATOMIC_RELAXED, __HIP_MEMORY_SCOPE_WORKGROUP);
                    }
                }
        }
        LDS_WAIT();
        __syncthreads();
    }
    unsigned long long mlo = 0ull, mhi = 0ull;
    if (tt <= 15) { mlo = (2ull << tt) - 1ull; }
    else {
        for (int tk = 0; tk < 8; ++tk) {
            LAS float* rowp = imp + (8 * w + tk) * 132;
            const int ma = lane, mb2 = lane + 64;
            const bool ca = (ma >= 1 && ma <= tt - 2), cb = (mb2 <= tt - 2);
            const float va = ca ? rowp[ma] : -1.f, vb = cb ? rowp[mb2] : -1.f;
            LDS_WAIT();
            rowp[ma] = va; rowp[mb2] = vb;
            LDS_WAIT();
            int cnta = 0, cntb = 0;
            for (int j = 0; j < 128; j += 4) { const f32x4 v = *(LAS const f32x4*)(rowp + j);
#pragma unroll
                for (int e = 0; e < 4; ++e) { const float xv = v[e]; const int jj = j + e;
                    cnta += ((xv > va) || (xv == va && jj < ma)) ? 1 : 0; cntb += ((xv > vb) || (xv == vb && jj < mb2)) ? 1 : 0; } }
            const bool sa = ca && cnta < 13, sb = cb && cntb < 13;
            unsigned long long ba = __ballot(sa), bb = __ballot(sb);
            ba |= 1ull;
            if (tt < 64) ba |= 1ull << tt; else bb |= 1ull << (tt - 64);
            if (tt - 1 < 64) ba |= 1ull << (tt - 1); else bb |= 1ull << (tt - 1 - 64);
            if ((r >> 2) == tk) { mlo = ba; mhi = bb; }
        }
    }
    {
        const bf16* Ks = F.KVB() + ((size_t)(2 * 4 + bg) << 19); const bf16* Vs = F.KVB() + ((size_t)(3 * 4 + bg) << 19);
        f32x16 o[2] = {zero16(), zero16()}; float m = -1e30f, l = 0.f;
        Stg st; stage_load(st, Ks, Vs, 0, tid);
        for (int ct = 0; ct <= tt; ++ct) {
            const int buf = ct & 1;
            stage_store(st, F.lds, buf, tid);
            __syncthreads();
            if (ct + 1 <= tt) stage_load(st, Ks, Vs, 64 * (ct + 1), tid);
            const bool sel = ((ct < 64 ? (mlo >> ct) : (mhi >> (ct - 64))) & 1ull) != 0ull;
            if (__ballot(sel) != 0ull)
                flash_tile(F.lds + buf * 2 * KVT, F.lds + buf * 2 * KVT + KVT, qf, o, m, l, t - 64 * ct - 8 * h, 0x7fffffffu, sel, lane);
        }
        __syncthreads();
        const float lt = xhalf_sum(l); const float sc = g1 / lt;
        yacc[0] += o[0] * sc; yacc[1] += o[1] * sc;
    }
    {
        const bf16* Kw = F.KVB() + ((size_t)(4 * 4 + bg) << 19); const bf16* Vw = F.KVB() + ((size_t)(5 * 4 + bg) << 19);
        f32x16 o[2] = {zero16(), zero16()}; float m = -1e30f, l = 0.f;
        const int c0 = tt > 8 ? tt - 8 : 0;
        Stg st; stage_load(st, Kw, Vw, 64 * c0, tid);
        for (int ct = c0; ct <= tt; ++ct) {
            const int buf = ct & 1;
            stage_store(st, F.lds, buf, tid);
            __syncthreads();
            if (ct + 1 <= tt) stage_load(st, Kw, Vw, 64 * (ct + 1), tid);
            flash_tile(F.lds + buf * 2 * KVT, F.lds + buf * 2 * KVT + KVT, qf, o, m, l, t - 64 * ct - 8 * h, 511u, true, lane);
        }
        __syncthreads();
        const float lt = xhalf_sum(l); const float sc = g2 / lt;
        yacc[0] += o[0] * sc; yacc[1] += o[1] * sc;
    }
    write_o_row(F.YB() + row * 512 + head * 64, yacc, 1.f, h);
}

DI void combine_ya(const Frame& F) {
    const int gt = F.bid * NTHR + F.tid, NGT = F.G * NTHR;
    for (int i = gt; i < TOK * 64; i += NGT) {
        const int row = i >> 6, ch = i & 63, slot = ch >> 3;
        const float l0 = F.LSE()[((size_t)0 * TOK + row) * 8 + slot], l1 = F.LSE()[((size_t)1 * TOK + row) * 8 + slot], l2 = F.LSE()[((size_t)2 * TOK + row) * 8 + slot];
        const float mx = fmaxf(l0, fmaxf(l1, l2)); float w0 = __expf(l0 - mx), w1 = __expf(l1 - mx), w2 = __expf(l2 - mx);
        const float inv = 1.f / (w0 + w1 + w2); w0 *= inv; w1 *= inv; w2 *= inv;
        const size_t off = (size_t)row * 512 + ch * 8;
        const u32x4 a = *(const u32x4*)(F.OG0() + off), bb = *(const u32x4*)(F.OG1() + off), c = *(const u32x4*)(F.OG2() + off);
        u32x4 o;
#pragma unroll
        for (int e = 0; e < 4; ++e) {
            const float lo = w0 * pg8::bf_lo(a[e]) + w1 * pg8::bf_lo(bb[e]) + w2 * pg8::bf_lo(c[e]);
            const float hi = w0 * pg8::bf_hi(a[e]) + w1 * pg8::bf_hi(bb[e]) + w2 * pg8::bf_hi(c[e]);
            o[e] = pk2(lo, hi);
        }
        *(u32x4*)(F.YA() + off) = o;
    }
}

#define XB_TMO      128
#define XB_XCNT(j)  (256  + 64 * (j))
#define XB_XSUB(j)  (1280 + 64 * (j))
#define XB_XGEN(j)  (2304 + 64 * (j))
#define XB_TOP      3328
#define XB_TOPGEN   3392
#define XCD_BAR_WORDS 3456
#define XB_SPIN_CAP (1u << 18)

__device__ __forceinline__ unsigned xb_ld(unsigned* p)              { return __hip_atomic_load(p, __ATOMIC_RELAXED, __HIP_MEMORY_SCOPE_AGENT); }
__device__ __forceinline__ unsigned xb_add(unsigned* p, unsigned v) { return __hip_atomic_fetch_add(p, v, __ATOMIC_RELAXED, __HIP_MEMORY_SCOPE_AGENT); }
__device__ __forceinline__ unsigned xb_xcc_id() { return (unsigned)__builtin_amdgcn_s_getreg((3 << 11) | 20) & 0xFu; }
#define XB_SPIN(cond, bar) do { unsigned _sp = 0; while (cond) { __builtin_amdgcn_s_sleep(1); \
    if ((++_sp & 255u) == 0u) { if (xb_ld(&(bar)[XB_TMO])) break; if (_sp > XB_SPIN_CAP) { atomicAdd(&(bar)[XB_TMO], 1u); break; } } } } while (0)
struct XcdBarrier {
    unsigned* bar; unsigned x;
    volatile LAS unsigned* st;
};

__device__ __forceinline__ XcdBarrier xcd_barrier_post(unsigned* bar, volatile LAS unsigned* st) {
    XcdBarrier b; b.bar = bar; b.x = xb_xcc_id(); b.st = st;
    if (threadIdx.x == 0) (void)xb_add(&bar[XB_XCNT(b.x)], 1u);
    return b;
}
__device__ __forceinline__ void xcd_barrier_complete(unsigned* bar, unsigned x, unsigned& nloc, unsigned& nx) {
    const unsigned G = gridDim.x * gridDim.y * gridDim.z;
    unsigned sum, cnt, mine, sp = 0u;
    for (;;) {
        sum = 0u; cnt = 0u; mine = 0u;
#pragma unroll
        for (unsigned j = 0; j < 16; ++j) { const unsigned c = xb_ld(&bar[XB_XCNT(j)]); sum += c; cnt += (c > 0u) ? 1u : 0u; mine = (j == x) ? c : mine; }
        if (sum == G) break;
        __builtin_amdgcn_s_sleep(1);
        if ((++sp & 255u) == 0u) { if (xb_ld(&bar[XB_TMO])) break; if (sp > XB_SPIN_CAP) { atomicAdd(&bar[XB_TMO], 1u); break; } }
    }
    nloc = mine > 0u ? mine : 1u; nx = cnt > 0u ? cnt : 1u;
}

__device__ __forceinline__ void xcd_barrier(const XcdBarrier& b) {
    asm volatile("s_waitcnt vmcnt(0)" ::: "memory");
    __syncthreads();
    if (threadIdx.x == 0) {
        unsigned* bar = b.bar;
        __builtin_amdgcn_s_waitcnt(0);
        unsigned nloc = b.st[0], nx = b.st[1];
        if (nloc == 0u) { xcd_barrier_complete(bar, b.x, nloc, nx); b.st[0] = nloc; b.st[1] = nx; }
        const unsigned old = xb_add(&bar[XB_XSUB(b.x)], 1u);
        const unsigned gen = old / nloc;
        if (old + 1u == (gen + 1u) * nloc) {
            __builtin_amdgcn_fence(__ATOMIC_RELEASE, "agent");
            asm volatile("s_waitcnt vmcnt(0)" ::: "memory");
            const unsigned og = xb_add(&bar[XB_TOP], 1u);
            const unsigned tg = og / nx;
            if (og + 1u == (tg + 1u) * nx) xb_add(&bar[XB_TOPGEN], 1u);
            else XB_SPIN(xb_ld(&bar[XB_TOPGEN]) == tg, bar);
            __builtin_amdgcn_fence(__ATOMIC_ACQUIRE, "agent");
            xb_add(&bar[XB_XGEN(b.x)], 1u);
            asm volatile("s_waitcnt vmcnt(0)" ::: "memory");
        } else {
            XB_SPIN(xb_ld(&bar[XB_XGEN(b.x)]) == gen, bar);
            __builtin_amdgcn_fence(__ATOMIC_ACQUIRE, "agent");
            asm volatile("s_waitcnt vmcnt(0)" ::: "memory");
        }
    }
    __syncthreads();
}

#ifndef PH_MAX
#define PH_MAX 99
#endif
#ifndef REPEAT_PH
#define REPEAT_PH 0
#endif
#define REP(k) for (int rep_ = 0; rep_ < ((REPEAT_PH == (k)) ? 2 : 1); ++rep_)
__global__ void __launch_bounds__(NTHR) fwd_mega(Args args) {
    extern __shared__ __attribute__((aligned(16))) unsigned char lds_raw[];
    cg::grid_group grid = cg::this_grid();
    Frame F;
    F.lds = (LAS unsigned char*)lds_raw; F.tid = threadIdx.x; F.lane = F.tid & 63; F.wave = __builtin_amdgcn_readfirstlane(F.tid >> 6); F.G = gridDim.x; F.bid = blockIdx.x;
    F.x = args.in[0]; F.g_mix = args.in[1]; F.w_in = args.in[2]; F.pos_k = args.in[3]; F.w1_k = args.in[4]; F.w2_k = args.in[5]; F.pos_v = args.in[6]; F.w1_v = args.in[7]; F.w2_v = args.in[8];
    F.w_a = args.in[9]; F.w_b = args.in[10]; F.w_out = args.in[11]; F.g_mlp = args.in[12]; F.w_up = args.in[13]; F.w_down = args.in[14]; F.g_fin = args.in[15];
    F.out = args.out; F.ws = args.ws;
    unsigned char* ws = args.ws;
    PG8_LAS unsigned char* glds = (PG8_LAS unsigned char*)lds_raw;
    volatile LAS unsigned* xst = (volatile LAS unsigned*)(F.lds + 131072);
    if (F.tid < 4) xst[F.tid] = 0u;
    __syncthreads();
    XcdBarrier xbar = xcd_barrier_post((unsigned*)ws, xst);
    grid.sync();
    const int gw = F.bid * 8 + F.wave, NGW = F.G * 8;

    REP(9) p0_prologue(F);
#if REPEAT_PH == 10
    for (int q_ = 0; q_ < 10; ++q_) grid.sync();
#endif
    xcd_barrier(xbar);
    asm volatile("" : "+v"(F.tid), "+v"(F.lane));
    if (PH_MAX >= 1) REP(1) {
        pg8::Gemm gm{F.U(), F.WIN(), TOK, NIN, DM}; pg8::StaticOrder S; S.init(TOK, NIN, F.G, F.bid);
        pg8::EpiInProj E{F.QKVA(), F.QB(), F.KVB(), F.GM(), F.GB(), F.CS()};
        pg8::gemm_phase<pg8::EpiInProj, pg8::StaticOrder, true, true>(glds, gm, S, E);
    }
    xcd_barrier(xbar);
    asm volatile("" : "+v"(F.tid), "+v"(F.lane));
    if (PH_MAX >= 2) REP(2) {
        for (int task = F.bid; task < 1536; task += F.G) mixa_task(F, task);
        for (int task = F.G - 1 - F.bid; task < 64; task += F.G) compress_task(F, task);
    }
    xcd_barrier(xbar);
    asm volatile("" : "+v"(F.tid), "+v"(F.lane));
    if (PH_MAX >= 3) REP(3) {
        combine_ya(F);
        for (int st = F.bid; st < 256; st += F.G) { const int bg = st >> 6, i = st & 63; nsa_task(F, bg >> 1, bg & 1, 127 - i); nsa_task(F, bg >> 1, bg & 1, i); }
    }
    xcd_barrier(xbar);
    asm volatile("" : "+v"(F.tid), "+v"(F.lane));
    if (PH_MAX >= 4) REP(4) {
        pg8::StaticOrder S; S.init(TOK, DM, F.G, F.bid);
        { pg8::Gemm gm{F.YA(), F.WA(), TOK, DM, 512}; pg8::EpiMerge<1> E{F.GM(), F.TMP(), F.MERGED()}; pg8::gemm_phase<pg8::EpiMerge<1>, pg8::StaticOrder, true, true>(glds, gm, S, E); }
        { pg8::Gemm gm{F.YB(), F.WB(), TOK, DM, 512}; pg8::EpiMerge<2> E{F.GM(), F.TMP(), F.MERGED()}; pg8::gemm_phase<pg8::EpiMerge<2>, pg8::StaticOrder, true, true>(glds, gm, S, E); }
    }
    xcd_barrier(xbar);
    asm volatile("" : "+v"(F.tid), "+v"(F.lane));
    if (PH_MAX >= 5) REP(5) {
        pg8::StaticOrder S; S.init(TOK, DM, F.G, F.bid);
        pg8::Gemm gm{F.MERGED(), F.WO(), TOK, DM, DM}; pg8::EpiResF32 E{F.x, F.out, DM}; pg8::gemm_phase<pg8::EpiResF32, pg8::StaticOrder, true, true>(glds, gm, S, E);
    }
    xcd_barrier(xbar);
    asm volatile("" : "+v"(F.tid), "+v"(F.lane));
    if (PH_MAX >= 6) REP(6) {
        LAS float* scr = (LAS float*)(F.lds + F.wave * 16384);
        for (int it = gw; it < 4096; it += NGW) { int r = it;
            if (transpose_job(r, F.w_up, 4096, 0, 4096, DM, F.WUP(), 0, scr, F.lane)) continue;
            transpose_job(r, F.w_down, 1024, 0, 1024, FF, F.WDN(), 0, scr, F.lane); }
        for (int m = gw; m < TOK; m += NGW) rms_row_bf16(F.out + (size_t)m * DM, F.g_mlp, F.U() + (size_t)m * DM, F.lane);
    }
    xcd_barrier(xbar);
    asm volatile("" : "+v"(F.tid), "+v"(F.lane));
    if (PH_MAX >= 7) REP(7) {
        pg8::StaticOrder S; S.init(TOK, FF, F.G, F.bid);
        pg8::Gemm gm{F.U(), F.WUP(), TOK, FF, DM}; pg8::EpiRelu2 E{F.H(), FF}; pg8::gemm_phase<pg8::EpiRelu2, pg8::StaticOrder, true, true>(glds, gm, S, E);
    }
    xcd_barrier(xbar);
    asm volatile("" : "+v"(F.tid), "+v"(F.lane));
    if (PH_MAX >= 8) REP(8) {
        pg8::StaticOrder S; S.init(TOK, DM, F.G, F.bid);
        pg8::Gemm gm{F.H(), F.WDN(), TOK, DM, FF}; pg8::EpiResF32 E{F.out, F.out, DM}; pg8::gemm_phase<pg8::EpiResF32, pg8::StaticOrder, true, true>(glds, gm, S, E);
    }
    xcd_barrier(xbar);
    asm volatile("" : "+v"(F.tid), "+v"(F.lane));
    for (int m = gw; m < TOK; m += NGW) rms_row_f32_inplace(F.out + (size_t)m * DM, F.g_fin, F.lane);
}

extern "C" void kernel_launch(void* const* d_in, const int* in_sizes, int n_in, void* d_out, int out_size, void* d_ws, size_t ws_size, hipStream_t stream) {
    static int grid = 0;
    if (grid == 0) {
        if (n_in != 16 || out_size != TOK * DM || ws_size < WS_END) { fprintf(stderr, "kernel_launch: unexpected shapes (n_in %d out %d ws %zu)\n", n_in, out_size, ws_size); grid = -1; return; }
        int dev = 0, cus = 0, per_cu = 0;
        hipGetDevice(&dev); hipDeviceGetAttribute(&cus, hipDeviceAttributeMultiprocessorCount, dev);
        hipFuncSetAttribute((const void*)fwd_mega, hipFuncAttributeMaxDynamicSharedMemorySize, LDS_BYTES);
        if (hipOccupancyMaxActiveBlocksPerMultiprocessor(&per_cu, (const void*)fwd_mega, NTHR, LDS_BYTES) != hipSuccess || per_cu < 1) { fprintf(stderr, "kernel_launch: occupancy query gave %d\n", per_cu); per_cu = 1; }
        (void)hipGetLastError();
        grid = cus * 1;
    }
    if (grid < 0) return;
    if (hipMemsetAsync(d_ws, 0, 16384, stream) != hipSuccess) { fprintf(stderr, "kernel_launch: memset of barrier words failed\n"); return; }
    Args a{};
    for (int i = 0; i < 16; ++i) a.in[i] = (const float*)d_in[i];
    a.out = (float*)d_out; a.ws = (unsigned char*)d_ws;
    void* kargs[] = {&a};
    hipError_t e = hipLaunchCooperativeKernel((const void*)fwd_mega, dim3(grid), dim3(NTHR), kargs, LDS_BYTES, stream);
    if (e != hipSuccess) fprintf(stderr, "cooperative launch failed: %s (grid %d)\n", hipGetErrorString(e), grid);
}
```

```cpp
#include <hip/hip_runtime.h>
#include <hip/hip_cooperative_groups.h>
#include <cstdio>
#include <cstdint>
namespace cg = cooperative_groups;

namespace pg8 {
#define PG8_LAS __attribute__((address_space(3)))
typedef unsigned short bf16_t;
typedef short bf16x8 __attribute__((ext_vector_type(8)));
typedef float f32x4 __attribute__((ext_vector_type(4)));
typedef unsigned u32x4 __attribute__((ext_vector_type(4)));
constexpr int BM = 256, BK = 64, HALF = 128, HTB = HALF * BK * 2  , STAGE_BYTES = 8 * HTB, NXCD = 8, WGM = 8;

__host__ __device__ __forceinline__ int lds_byte(int r, int c) { const int st = (r >> 4) * 2 + (c >> 5), rr = r & 15, cc = c & 31, ob = rr * 64 + cc * 2; return st * 1024 + (ob ^ (((ob >> 9) & 1) << 5)); }
__host__ __device__ __forceinline__ void stage_rc(int b, int& R, int& C) { const int st = b / 1024, sb = b % 1024, swz = sb ^ (((sb >> 9) & 1) << 5); R = (st >> 1) * 16 + swz / 64; C = (st & 1) * 32 + (swz % 64) / 2; }
__host__ __device__ __forceinline__ int perm32(int rho) { const int n = rho >> 4, i = rho & 15; return 8 * (i >> 2) + 4 * n + (i & 3); }

struct Unit { int pm, pn; };
struct Gemm { const bf16_t* A; const bf16_t* Bt; int M, N, K; };

struct StaticOrder {
    int nM, nN, nwg, G, c;
    __host__ __device__ void init(int M, int N, int G_, int c_) { nM = M / BM; nN = N / BM; nwg = nM * nN; G = G_; c = c_; }
    __host__ __device__ bool next(int i, Unit& u) const {
        const long L = (long)i * G + c; if (L >= nwg) return false;
        int wgid = (int)L; { const int q = nwg / NXCD, r = nwg % NXCD, xcd = wgid % NXCD, off = wgid / NXCD; wgid = (xcd < r ? xcd * (q + 1) : r * (q + 1) + (xcd - r) * q) + off; }
        const int nig = WGM * nN, gid = wgid / nig, fm = gid * WGM, gsz = (nM - fm) < WGM ? (nM - fm) : WGM;
        u.pm = fm + ((wgid % nig) % gsz); u.pn = (wgid % nig) / gsz; return true;
    }
    __device__ __forceinline__ void a_ready(const Unit&) const {}
    __device__ __forceinline__ void done(const Unit&) const {}
};

__device__ __forceinline__ unsigned cvt_pk_bf16(float lo, float hi) { unsigned r; asm volatile("v_cvt_pk_bf16_f32 %0, %1, %2" : "=v"(r) : "v"(lo), "v"(hi)); return r; }
__device__ __forceinline__ float bf_lo(unsigned w) { return __builtin_bit_cast(float, w << 16); }
__device__ __forceinline__ float bf_hi(unsigned w) { return __builtin_bit_cast(float, w & 0xffff0000u); }
__device__ __forceinline__ float sigmoidf_(float x) { return __builtin_amdgcn_rcpf(1.f + __expf(-x)); }

struct EpiInProj {
    static constexpr bool PERM = true, AFTER_DRAIN = false;
    bf16_t* qkva; bf16_t* qb; bf16_t* kvb; bf16_t* gm; bf16_t* gb; const float* cs;
    __device__ __forceinline__ void operator()(const f32x4 (&acc)[2][2][4][2], const Unit& u, int wr, int wc, int fr, int fq) const {
        const int pn = u.pn;
        const int row0 = u.pm * BM + wr * 64 + fr;
        const bool rope_wave = !(wc & 1);
#pragma unroll
        for (int ai = 0; ai < 2; ++ai)
#pragma unroll
            for (int m = 0; m < 4; ++m) {
                const int row = row0 + ai * HALF + m * 16; const int b = row >> 13, s = row & 8191;
                f32x4 c0, c1, s0, s1;
                { const f32x4* t = (const f32x4*)(cs + (size_t)s * 16); c0 = t[0]; c1 = t[1]; s0 = t[2]; s1 = t[3]; }
#pragma unroll
                for (int bj = 0; bj < 2; ++bj) {
                    const int c = pn * BM + bj * HALF + wc * 32 + 8 * fq;
                    f32x4 v0 = acc[ai][bj][m][0], v1 = acc[ai][bj][m][1];
                    bool rope; bf16_t* dst;
                    if (pn < 18) { const int which = c / 1536, hc = c - which * 1536, head = hc >> 6, d0 = hc & 63, lg = (head >> 3) * 2;
                        const int prow = ((s & ((1 << lg) - 1)) << (13 - lg)) | (s >> lg);
                        dst = qkva + ((size_t)((((which * 24 + head) * 2 + b) << 13) + prow) << 6) + d0; rope = (pn < 12); }
                    else if (pn < 20) { dst = qb + (size_t)row * 512 + (c - 4608); rope = true; }
                    else if (pn < 23) { const int cc = c - 5120, j = cc >> 7, g = (cc >> 6) & 1, d0 = cc & 63;
                        dst = kvb + ((size_t)((((j * 4 + b * 2 + g)) << 13) + s) << 6) + d0; rope = (bj == 0); }
                    else if (pn < 31) { dst = gm + (size_t)row * 2048 + (c - 5888); rope = false; }
                    else { dst = gb + (size_t)row * 32 + (c - 7936); rope = false; }
                    if (rope && rope_wave) {
                        f32x4 p0, p1;
#pragma unroll
                        for (int e = 0; e < 4; ++e) { p0[e] = __shfl_xor(v0[e], 16); p1[e] = __shfl_xor(v1[e], 16); }
                        if (fq == 0) { v0 = v0 * c0 - p0 * s0; v1 = v1 * c1 - p1 * s1; }
                        else if (fq == 1) { v0 = v0 * c0 + p0 * s0; v1 = v1 * c1 + p1 * s1; }
                    }
                    if (pn < 31 || (bj == 0 && wc == 0)) {
                        u32x4 w; w.x = cvt_pk_bf16(v0[0], v0[1]); w.y = cvt_pk_bf16(v0[2], v0[3]); w.z = cvt_pk_bf16(v1[0], v1[1]); w.w = cvt_pk_bf16(v1[2], v1[3]);
                        *(u32x4*)dst = w; }
                }
            }
    }
};
template <int STEP> struct EpiMerge {
    static constexpr bool PERM = true, AFTER_DRAIN = false;
    const bf16_t* gm; float* tmp; bf16_t* merged;
    __device__ __forceinline__ void operator()(const f32x4 (&acc)[2][2][4][2], const Unit& u, int wr, int wc, int fr, int fq) const {
        const int row0 = u.pm * BM + wr * 64 + fr, col0 = u.pn * BM + wc * 32 + 8 * fq;
#pragma unroll
        for (int ai = 0; ai < 2; ++ai)
#pragma unroll
            for (int m = 0; m < 4; ++m)
#pragma unroll
                for (int bj = 0; bj < 2; ++bj) {
                    const int row = row0 + ai * HALF + m * 16, c = col0 + bj * HALF;
                    const u32x4 g = *(const u32x4*)(gm + (size_t)row * 2048 + (STEP - 1) * 1024 + c);
                    f32x4 v0 = acc[ai][bj][m][0], v1 = acc[ai][bj][m][1];
                    v0[0] *= sigmoidf_(bf_lo(g.x)); v0[1] *= sigmoidf_(bf_hi(g.x)); v0[2] *= sigmoidf_(bf_lo(g.y)); v0[3] *= sigmoidf_(bf_hi(g.y));
                    v1[0] *= sigmoidf_(bf_lo(g.z)); v1[1] *= sigmoidf_(bf_hi(g.z)); v1[2] *= sigmoidf_(bf_lo(g.w)); v1[3] *= sigmoidf_(bf_hi(g.w));
                    float* tp = tmp + (size_t)row * 1024 + c;
                    if (STEP == 1) { *(f32x4*)tp = v0; *(f32x4*)(tp + 4) = v1; }
                    else { v0 += *(const f32x4*)tp; v1 += *(const f32x4*)(tp + 4);
                        u32x4 w; w.x = cvt_pk_bf16(v0[0], v0[1]); w.y = cvt_pk_bf16(v0[2], v0[3]); w.z = cvt_pk_bf16(v1[0], v1[1]); w.w = cvt_pk_bf16(v1[2], v1[3]);
                        *(u32x4*)(merged + (size_t)row * 1024 + c) = w; }
                    __builtin_amdgcn_sched_barrier(0);
                }
    }
};
struct EpiResF32 {
    static constexpr bool PERM = true, AFTER_DRAIN = false;
    const float* res; float* out; int ldc;
    __device__ __forceinline__ void operator()(const f32x4 (&acc)[2][2][4][2], const Unit& u, int wr, int wc, int fr, int fq) const {
        const int row0 = u.pm * BM + wr * 64 + fr, col0 = u.pn * BM + wc * 32 + 8 * fq;
#pragma unroll
        for (int ai = 0; ai < 2; ++ai)
#pragma unroll
            for (int m = 0; m < 4; ++m)
#pragma unroll
                for (int bj = 0; bj < 2; ++bj) {
                    const size_t off = (size_t)(row0 + ai * HALF + m * 16) * ldc + col0 + bj * HALF;
                    const f32x4 r0 = *(const f32x4*)(res + off), r1 = *(const f32x4*)(res + off + 4);
                    *(f32x4*)(out + off) = r0 + acc[ai][bj][m][0]; *(f32x4*)(out + off + 4) = r1 + acc[ai][bj][m][1];
                    __builtin_amdgcn_sched_barrier(0);
                }
    }
};
struct EpiRelu2 {
    static constexpr bool PERM = true, AFTER_DRAIN = false;
    bf16_t* O; int ldc;
    __device__ __forceinline__ void operator()(const f32x4 (&acc)[2][2][4][2], const Unit& u, int wr, int wc, int fr, int fq) const {
        const int row0 = u.pm * BM + wr * 64 + fr, col0 = u.pn * BM + wc * 32 + 8 * fq;
#pragma unroll
        for (int ai = 0; ai < 2; ++ai)
#pragma unroll
            for (int m = 0; m < 4; ++m)
#pragma unroll
                for (int bj = 0; bj < 2; ++bj) {
                    f32x4 v0 = acc[ai][bj][m][0], v1 = acc[ai][bj][m][1];
#pragma unroll
                    for (int e = 0; e < 4; ++e) { const float a = fmaxf(v0[e], 0.f), b = fmaxf(v1[e], 0.f); v0[e] = a * a; v1[e] = b * b; }
                    u32x4 w; w.x = cvt_pk_bf16(v0[0], v0[1]); w.y = cvt_pk_bf16(v0[2], v0[3]); w.z = cvt_pk_bf16(v1[0], v1[1]); w.w = cvt_pk_bf16(v1[2], v1[3]);
                    *(u32x4*)(O + (size_t)(row0 + ai * HALF + m * 16) * ldc + col0 + bj * HALF) = w;
                    __builtin_amdgcn_sched_barrier(0);
                }
    }
};

template <class Epi, class Sched, bool ALIGN_EPI = false, bool SP2 = false>
__device__ __forceinline__ void gemm_phase(PG8_LAS unsigned char* lds, const Gemm g, const Sched& S, const Epi& E) {
    int tid_ = threadIdx.x; asm volatile("" : "+v"(tid_));
    const int tid = tid_, wid = __builtin_amdgcn_readfirstlane(tid >> 6), lane = tid & 63, wr = wid >> 2, wc = wid & 3, fr = lane & 15, fq = lane >> 4;
    const int K = g.K, nt = K / BK;
    unsigned voffA[2], voffB[2];
#pragma unroll
    for (int i = 0; i < 2; ++i) { int R, C; stage_rc(tid * 16 + i * 8192, R, C); const int Rb = Epi::PERM ? ((R & ~31) + perm32(R & 31)) : R;
        voffA[i] = (unsigned)(R * K + C) * 2u; voffB[i] = (unsigned)(Rb * K + C) * 2u; }
    const size_t kstep = (size_t)(BK * 2);
    const size_t hstep = (size_t)HALF * K * 2;
    const size_t tstep = 2 * hstep;
    const unsigned ldsw = (unsigned)wid * 1024u;
    const int aoff = lds_byte(wr * 64 + fr, fq * 8), boff = lds_byte(wc * 32 + fr, fq * 8);
#define PG8_SA(b, h) (((b) * 2 + (h)) * HTB)
#define PG8_SB(b, h) ((4 + (b) * 2 + (h)) * HTB)
#define PG8_STAGE(bufoff, gbase, voff) do { _Pragma("unroll") for (int _i = 0; _i < 2; ++_i) \
        __builtin_amdgcn_global_load_lds((const unsigned*)((const char*)(gbase) + (voff)[_i]), (PG8_LAS unsigned*)(lds + (bufoff) + ldsw + _i * 8192), 16, 0, 0); } while (0)
#define PG8_LDA(dst, b, h) do { _Pragma("unroll") for (int m = 0; m < 4; ++m) _Pragma("unroll") for (int k = 0; k < 2; ++k) dst[m][k] = *(const PG8_LAS bf16x8*)(lds + PG8_SA(b, h) + aoff + m * 2048 + k * 1024); } while (0)
#define PG8_LDB(dst, b, h) do { _Pragma("unroll") for (int n = 0; n < 2; ++n) _Pragma("unroll") for (int k = 0; k < 2; ++k) dst[n][k] = *(const PG8_LAS bf16x8*)(lds + PG8_SB(b, h) + boff + n * 2048 + k * 1024); } while (0)
#define PG8_MMA(ai, bj, At, Bt) do { __builtin_amdgcn_s_setprio(1); _Pragma("unroll") for (int m = 0; m < 4; ++m) _Pragma("unroll") for (int n = 0; n < 2; ++n) _Pragma("unroll") for (int k = 0; k < 2; ++k) \
        acc[ai][bj][m][n] = __builtin_amdgcn_mfma_f32_16x16x32_bf16(Bt[n][k], At[m][k], acc[ai][bj][m][n], 0, 0, 0); __builtin_amdgcn_s_setprio(0); } while (0)
#define PG8_WAIT_V(n) asm volatile("s_waitcnt vmcnt(" #n ")" ::: "memory")
#define PG8_WAIT_L(n) asm volatile("s_waitcnt lgkmcnt(" #n ")" ::: "memory")
#define PG8_BAR __builtin_amdgcn_s_barrier()
#define PG8_SCHED __builtin_amdgcn_sched_barrier(0)
    Unit cur, nxt; int ui = 0;
    if (!S.next(0, cur)) return;
    f32x4 acc[2][2][4][2];
#pragma unroll
    for (int a = 0; a < 2; ++a)
#pragma unroll
        for (int b = 0; b < 2; ++b)
#pragma unroll
            for (int m = 0; m < 4; ++m)
#pragma unroll
                for (int n = 0; n < 2; ++n) acc[a][b][m][n] = (f32x4){0.f, 0.f, 0.f, 0.f};
    bf16x8 At[4][2], B0[2][2], B1[2][2];
    const char* cA = (const char*)g.A + (size_t)cur.pm * tstep; const char* cB = (const char*)g.Bt + (size_t)cur.pn * tstep;
    S.a_ready(cur);
    if constexpr (SP2) {
        PG8_STAGE(PG8_SB(0, 0), cB, voffB); PG8_STAGE(PG8_SB(0, 1), cB + hstep, voffB); PG8_STAGE(PG8_SA(0, 0), cA, voffA); PG8_STAGE(PG8_SA(0, 1), cA + hstep, voffA);
        if (wr == 1) PG8_BAR;
        PG8_WAIT_V(2); PG8_BAR;
        PG8_STAGE(PG8_SB(1, 0), cB + kstep, voffB); PG8_STAGE(PG8_SA(1, 0), cA + kstep, voffA); PG8_STAGE(PG8_SB(1, 1), cB + hstep + kstep, voffB);
        PG8_WAIT_V(6); PG8_BAR;
    } else {
        PG8_STAGE(PG8_SB(0, 0), cB, voffB); PG8_STAGE(PG8_SA(0, 0), cA, voffA); PG8_STAGE(PG8_SB(0, 1), cB + hstep, voffB); PG8_STAGE(PG8_SA(0, 1), cA + hstep, voffA);
        if (wr == 1) PG8_BAR;
        PG8_WAIT_V(4); PG8_BAR;
        PG8_STAGE(PG8_SB(1, 0), cB + kstep, voffB); PG8_STAGE(PG8_SA(1, 0), cA + kstep, voffA); PG8_STAGE(PG8_SB(1, 1), cB + hstep + kstep, voffB);
        PG8_WAIT_V(6); PG8_BAR;
    }
    for (;;) {
        const bool has_next = S.next(ui + 1, nxt);
        const char* nA = has_next ? (const char*)g.A + (size_t)nxt.pm * tstep : cA; const char* nB = has_next ? (const char*)g.Bt + (size_t)nxt.pn * tstep : cB;
        for (int t = 0; t < nt; t += 2) {
            const bool last = (t == nt - 2);
            const char* a1 = cA + (size_t)(t + 1) * kstep;
            const char* a2 = last ? nA : cA + (size_t)(t + 2) * kstep; const char* b2 = last ? nB : cB + (size_t)(t + 2) * kstep;
            const char* a3 = a2 + kstep; const char* b3 = b2 + kstep;
            if (last && has_next) S.a_ready(nxt);
            if constexpr (SP2) {
            PG8_LDB(B0, 0, 0); PG8_LDB(B1, 0, 1); PG8_SCHED; PG8_LDA(At, 0, 0); PG8_STAGE(PG8_SA(1, 1), a1 + hstep, voffA);
            PG8_WAIT_V(8); PG8_WAIT_L(0); PG8_BAR; PG8_MMA(0, 0, At, B0); PG8_MMA(0, 1, At, B1); PG8_BAR; PG8_SCHED;
            PG8_LDA(At, 0, 1); PG8_STAGE(PG8_SB(0, 0), b2, voffB); PG8_STAGE(PG8_SB(0, 1), b2 + hstep, voffB); PG8_STAGE(PG8_SA(0, 0), a2, voffA);
            PG8_WAIT_V(8); PG8_WAIT_L(0); PG8_BAR; PG8_MMA(1, 0, At, B0); PG8_MMA(1, 1, At, B1); PG8_BAR; PG8_SCHED;
            PG8_LDB(B0, 1, 0); PG8_LDB(B1, 1, 1); PG8_SCHED; PG8_LDA(At, 1, 0); PG8_STAGE(PG8_SA(0, 1), a2 + hstep, voffA);
            PG8_WAIT_V(8); PG8_WAIT_L(0); PG8_BAR; PG8_MMA(0, 0, At, B0); PG8_MMA(0, 1, At, B1); PG8_BAR; PG8_SCHED;
            PG8_LDA(At, 1, 1); PG8_STAGE(PG8_SB(1, 0), b3, voffB); PG8_STAGE(PG8_SB(1, 1), b3 + hstep, voffB); PG8_STAGE(PG8_SA(1, 0), a3, voffA);
            PG8_WAIT_V(8); PG8_WAIT_L(0); PG8_BAR; PG8_MMA(1, 0, At, B0); PG8_MMA(1, 1, At, B1); PG8_BAR; PG8_SCHED;
            } else {
            PG8_LDB(B0, 0, 0); PG8_SCHED; PG8_LDA(At, 0, 0); PG8_STAGE(PG8_SA(1, 1), a1 + hstep, voffA);
            PG8_WAIT_L(8); PG8_BAR; PG8_WAIT_L(0); PG8_MMA(0, 0, At, B0); PG8_BAR; PG8_SCHED;
            PG8_LDB(B1, 0, 1); PG8_STAGE(PG8_SB(0, 0), b2, voffB);
            PG8_BAR; PG8_WAIT_L(0); PG8_MMA(0, 1, At, B1); PG8_BAR;
            PG8_LDA(At, 0, 1); PG8_STAGE(PG8_SA(0, 0), a2, voffA);
            PG8_BAR; PG8_WAIT_L(0); PG8_MMA(1, 0, At, B0); PG8_BAR; PG8_SCHED;
            PG8_STAGE(PG8_SB(0, 1), b2 + hstep, voffB);
            PG8_WAIT_V(6); PG8_BAR; PG8_MMA(1, 1, At, B1); PG8_BAR;
            PG8_LDB(B0, 1, 0); PG8_SCHED; PG8_LDA(At, 1, 0); PG8_STAGE(PG8_SA(0, 1), a2 + hstep, voffA);
            PG8_WAIT_L(8); PG8_BAR; PG8_WAIT_L(0); PG8_MMA(0, 0, At, B0); PG8_BAR; PG8_SCHED;
            PG8_LDB(B1, 1, 1); PG8_STAGE(PG8_SB(1, 0), b3, voffB);
            PG8_BAR; PG8_WAIT_L(0); PG8_MMA(0, 1, At, B1); PG8_BAR;
            PG8_LDA(At, 1, 1); PG8_STAGE(PG8_SA(1, 0), a3, voffA);
            PG8_BAR; PG8_WAIT_L(0); PG8_MMA(1, 0, At, B0); PG8_BAR; PG8_SCHED;
            PG8_STAGE(PG8_SB(1, 1), b3 + hstep, voffB);
            PG8_WAIT_V(6); PG8_BAR; PG8_MMA(1, 1, At, B1); PG8_BAR;
            }
        }
        if constexpr (ALIGN_EPI) { if (wr == 0) PG8_BAR; }
        if constexpr (!Epi::AFTER_DRAIN) { E(acc, cur, wr, wc, fr, fq); S.done(cur); }
        if (!has_next) break;
#pragma unroll
        for (int a = 0; a < 2; ++a)
#pragma unroll
            for (int b = 0; b < 2; ++b)
#pragma unroll
                for (int m = 0; m < 4; ++m)
#pragma unroll
                    for (int n = 0; n < 2; ++n) acc[a][b][m][n] = (f32x4){0.f, 0.f, 0.f, 0.f};
        cur = nxt; cA = nA; cB = nB; ++ui;
        if constexpr (ALIGN_EPI) { if (wr == 1) PG8_BAR; }
    }
    PG8_WAIT_V(0);
    if constexpr (!ALIGN_EPI) { if (wr == 0) PG8_BAR; }
    PG8_BAR;
    if constexpr (Epi::AFTER_DRAIN) { E.fused(acc, cur, wr, wc, fr, fq, lds, wid, lane); S.done(cur); }
#undef PG8_SA
#undef PG8_SB
#undef PG8_STAGE
#undef PG8_LDA
#undef PG8_LDB
#undef PG8_MMA
#undef PG8_WAIT_V
#undef PG8_WAIT_L
#undef PG8_BAR
#undef PG8_SCHED
}
}

#define DI __device__ __forceinline__
#define LAS __attribute__((address_space(3)))
typedef unsigned short bf16;
typedef short bf16x8 __attribute__((ext_vector_type(8)));
typedef short s16x4 __attribute__((ext_vector_type(4)));
typedef float f32x4 __attribute__((ext_vector_type(4)));
typedef float f32x16 __attribute__((ext_vector_type(16)));
typedef unsigned u32x4 __attribute__((ext_vector_type(4)));
typedef unsigned u32x2 __attribute__((ext_vector_type(2)));
#define MFMA32(a, b, c) __builtin_amdgcn_mfma_f32_32x32x16_bf16((a), (b), (c), 0, 0, 0)
#define LDS_WAIT() asm volatile("s_waitcnt lgkmcnt(0)" ::: "memory")

constexpr int SEQ = 8192, TOK = 16384, DM = 1024, FF = 4096, NIN = 8192, NTHR = 512;
constexpr size_t MiB = 1u << 20;
constexpr size_t WS_WIN = 1 * MiB, WS_WA = 17 * MiB, WS_WB = 18 * MiB, WS_WO = 19 * MiB, WS_W1K = 21 * MiB, WS_W1V = 22 * MiB, WS_SMALL = 23 * MiB,
                 WS_KC = 24 * MiB, WS_LSE = 25 * MiB, WS_GB = 27 * MiB, WS_QB = 28 * MiB, WS_KVB = 44 * MiB, WS_R2 = 68 * MiB, WS_R1 = 100 * MiB,
                 WS_WUP = 228 * MiB, WS_WDN = 236 * MiB, WS_END = 244 * MiB;
constexpr int LDS_BYTES = 147456;
constexpr int KVROW = 144, KVT = 64 * KVROW;
constexpr int VROW = 192, VT = 64 * VROW, BUFB = KVT + VT;
constexpr float SC_LOG2E = 0.125f * 1.4426950408889634f;

struct Args { const float* in[16]; float* out; unsigned char* ws; };

struct Frame {
    LAS unsigned char* lds; int tid, lane, wave, G, bid;
    const float *x, *g_mix, *w_in, *pos_k, *w1_k, *w2_k, *pos_v, *w1_v, *w2_v, *w_a, *w_b, *w_out, *g_mlp, *w_up, *w_down, *g_fin;
    float* out; unsigned char* ws;
    DI bf16* WIN() const { return (bf16*)(ws + (WS_WIN)); }
    DI bf16* WA() const { return (bf16*)(ws + (WS_WA)); }
    DI bf16* WB() const { return (bf16*)(ws + (WS_WB)); }
    DI bf16* WO() const { return (bf16*)(ws + (WS_WO)); }
    DI bf16* W1K() const { return (bf16*)(ws + (WS_W1K)); }
    DI bf16* W1V() const { return (bf16*)(ws + (WS_W1V)); }
    DI bf16* W2K() const { return (bf16*)(ws + (WS_SMALL)); }
    DI bf16* W2V() const { return (bf16*)(ws + (WS_SMALL + 32768)); }
    DI bf16* KC() const { return (bf16*)(ws + (WS_KC)); }
    DI bf16* VC() const { return (bf16*)(ws + (WS_KC + 262144)); }
    DI bf16* GB() const { return (bf16*)(ws + (WS_GB)); }
    DI bf16* QB() const { return (bf16*)(ws + (WS_QB)); }
    DI bf16* KVB() const { return (bf16*)(ws + (WS_KVB)); }
    DI bf16* U() const { return (bf16*)(ws + (WS_R2)); }
    DI bf16* OG0() const { return (bf16*)(ws + (WS_R2)); }
    DI bf16* OG1() const { return (bf16*)(ws + (WS_R2 + 16 * MiB)); }
    DI bf16* OG2() const { return (bf16*)(ws + (WS_WIN)); }
    DI bf16* QKVA() const { return (bf16*)(ws + (WS_R1)); }
    DI bf16* YA() const { return (bf16*)(ws + (WS_R1)); }
    DI bf16* YB() const { return (bf16*)(ws + (WS_R1 + 16 * MiB)); }
    DI bf16* MERGED() const { return (bf16*)(ws + (WS_R1 + 96 * MiB)); }
    DI bf16* H() const { return (bf16*)(ws + (WS_R1)); }
    DI bf16* WUP() const { return (bf16*)(ws + (WS_WUP)); }
    DI bf16* WDN() const { return (bf16*)(ws + (WS_WDN)); }
    DI float* BIASK() const { return (float*)(ws + (WS_SMALL + 65536)); }
    DI float* BIASV() const { return (float*)(ws + (WS_SMALL + 81920)); }
    DI float* CS() const { return (float*)(ws + (WS_SMALL + 131072)); }
    DI float* LSE() const { return (float*)(ws + (WS_LSE)); }
    DI float* TMP() const { return (float*)(ws + (WS_R1 + 32 * MiB)); }
    DI bf16* GM() const { return (bf16*)out; }
};

DI float wave_sum(float v) {
#pragma unroll
    for (int o = 1; o < 64; o <<= 1) v += __shfl_xor(v, o);
    return v;
}
DI unsigned f2bf(float f) { unsigned u = __builtin_bit_cast(unsigned, f); return (u + 0x7fffu + ((u >> 16) & 1u)) >> 16; }
DI unsigned pk2(float lo, float hi) { return f2bf(lo) | (f2bf(hi) << 16); }
DI float bf2f(bf16 v) { return __builtin_bit_cast(float, (unsigned)v << 16); }
DI float sigm(float x) { return 1.f / (1.f + __expf(-x)); }
DI f32x16 zero16() { f32x16 z;
#pragma unroll
    for (int i = 0; i < 16; ++i) z[i] = 0.f;
    return z; }

DI void transpose_item(const float* W, int ldw, int col0, int ncols, int k0, bf16* WT, int K, int drow0, LAS float* scr, int lane) {
    const int cl = lane & 31;
#pragma unroll 8
    for (int i = 0; i < 32; ++i) { const int kk = 2 * i + (lane >> 5); scr[kk * 33 + cl] = (cl < ncols) ? W[(size_t)(k0 + kk) * ldw + col0 + cl] : 0.f; }
    LDS_WAIT();
    const int c = lane & 7;
#pragma unroll
    for (int j = 0; j < 4; ++j) { const int n = (lane >> 3) + 8 * j; const LAS float* s = scr + (8 * c) * 33 + n;
        u32x4 o; o.x = pk2(s[0 * 33], s[1 * 33]); o.y = pk2(s[2 * 33], s[3 * 33]); o.z = pk2(s[4 * 33], s[5 * 33]); o.w = pk2(s[6 * 33], s[7 * 33]);
        if (n < ncols) *(u32x4*)(WT + (size_t)(drow0 + n) * K + k0 + 8 * c) = o; }
    LDS_WAIT();
}
DI bool transpose_job(int& item, const float* W, int ldw, int scol0, int ncols, int K, bf16* WT, int drow0, LAS float* scr, int lane) {
    const int nblk = (ncols + 31) >> 5, nitems = (K >> 6) * nblk;
    if (item >= nitems) { item -= nitems; return false; }
    const int kb = item / nblk, nb = item - kb * nblk;
    const int rem = ncols - 32 * nb;
    transpose_item(W, ldw, scol0 + 32 * nb, rem < 32 ? rem : 32, 64 * kb, WT, K, drow0 + 32 * nb, scr, lane);
    return true;
}
DI void rms_row_bf16(const float* xrow, const float* g, bf16* orow, int lane) {
    const f32x4* xr = (const f32x4*)xrow + lane; const f32x4* gr = (const f32x4*)g + lane;
    f32x4 v[4]; float s = 0.f;
#pragma unroll
    for (int j = 0; j < 4; ++j) { v[j] = xr[64 * j]; s += (v[j].x * v[j].x + v[j].y * v[j].y) + (v[j].z * v[j].z + v[j].w * v[j].w); }
    const float rstd = 1.f / sqrtf(wave_sum(s) * (1.f / DM) + 1e-6f);
    unsigned long long* o8 = (unsigned long long*)orow + lane;
#pragma unroll
    for (int j = 0; j < 4; ++j) { const f32x4 gg = gr[64 * j];
        o8[64 * j] = (unsigned long long)pk2(v[j].x * rstd * gg.x, v[j].y * rstd * gg.y) | ((unsigned long long)pk2(v[j].z * rstd * gg.z, v[j].w * rstd * gg.w) << 32); }
}
DI void rms_row_f32_inplace(float* xrow, const float* g, int lane) {
    f32x4* xr = (f32x4*)xrow + lane; const f32x4* gr = (const f32x4*)g + lane;
    f32x4 v[4]; float s = 0.f;
#pragma unroll
    for (int j = 0; j < 4; ++j) { v[j] = xr[64 * j]; s += (v[j].x * v[j].x + v[j].y * v[j].y) + (v[j].z * v[j].z + v[j].w * v[j].w); }
    const float rstd = 1.f / sqrtf(wave_sum(s) * (1.f / DM) + 1e-6f);
#pragma unroll
    for (int j = 0; j < 4; ++j) xr[64 * j] = v[j] * rstd * gr[64 * j];
}

DI void p0_prologue(const Frame& F) {
    LAS float* scr = (LAS float*)(F.lds + F.wave * 16384);
    const int gw = F.bid * 8 + F.wave, NGW = F.G * 8;
    constexpr int NITEMS = 16 * 184 + 16 * 64 + 16 + 256 + 256 + 512 + 256 + 256 + 8 + 8;
    for (int it = gw; it < NITEMS; it += NGW) {
        int r = it;
        if (transpose_job(r, F.w_in, 7960, 0, 5888, DM, F.WIN(), 0, scr, F.lane)) continue;
        if (transpose_job(r, F.w_in, 7960, 5912, 2048, DM, F.WIN(), 5888, scr, F.lane)) continue;
        if (transpose_job(r, F.w_in, 7960, 5888, 24, DM, F.WIN(), 7936, scr, F.lane)) continue;
        if (transpose_job(r, F.w_a, 1024, 0, 1024, 512, F.WA(), 0, scr, F.lane)) continue;
        if (transpose_job(r, F.w_b, 1024, 0, 1024, 512, F.WB(), 0, scr, F.lane)) continue;
        if (transpose_job(r, F.w_out, 1024, 0, 1024, 1024, F.WO(), 0, scr, F.lane)) continue;
        if (transpose_job(r, F.w1_k, 256, 0, 256, 2048, F.W1K(), 0, scr, F.lane)) continue;
        if (transpose_job(r, F.w1_v, 256, 0, 256, 2048, F.W1V(), 0, scr, F.lane)) continue;
        if (transpose_job(r, F.w2_k, 64, 0, 64, 256, F.W2K(), 0, scr, F.lane)) continue;
        transpose_job(r, F.w2_v, 64, 0, 64, 256, F.W2V(), 0, scr, F.lane);
    }
    const int gt = F.bid * NTHR + F.tid, NGT = F.G * NTHR;
    for (int i = gt; i < 232 * 1024 / 8; i += NGT) *(u32x4*)(F.WIN() + (size_t)7960 * 1024 + (size_t)i * 8) = (u32x4){0u, 0u, 0u, 0u};
    for (int i = gt; i < SEQ * 8; i += NGT) {
        const int s = i >> 3, k = i & 7;
        const double inv[8] = {1.0, 0.19392274474868576, 0.03760603093086393, 0.007292664737217109, 0.001414213562373095, 0.0002742481756762073, 5.318295896944988e-05, 1.031338537721246e-05};
        double iv = inv[0];
#pragma unroll
        for (int q = 1; q < 8; ++q) iv = (k == q) ? inv[q] : iv;
        const double rev = (double)s * iv * 0.15915494309189535;
        const float fr = (float)(rev - __builtin_rint(rev));
        F.CS()[s * 16 + k] = __builtin_amdgcn_cosf(fr); F.CS()[s * 16 + 8 + k] = __builtin_amdgcn_sinf(fr);
    }
    for (int m = gw; m < TOK; m += NGW) rms_row_bf16(F.x + (size_t)m * DM, F.g_mix, F.U() + (size_t)m * DM, F.lane);
    if (F.bid < 32) {
        const int mat = F.bid >> 4, part = F.bid & 15, col = F.tid & 255, kh = F.tid >> 8;
        const float* pe = mat ? F.pos_v : F.pos_k; const float* W1 = mat ? F.w1_v : F.w1_k; float acc = 0.f;
        const int kb = part * 128 + kh * 64;
#pragma unroll 8
        for (int k = 0; k < 64; ++k) acc += pe[kb + k] * W1[(size_t)(kb + k) * 256 + col];
        LAS float* red = (LAS float*)F.lds;
        __syncthreads();
        if (kh) red[col] = acc;
        __syncthreads();
        if (!kh) (mat ? F.BIASV() : F.BIASK())[part * 256 + col] = acc + red[col];
        __syncthreads();
    }
    if (F.bid == 2) { const int kv = F.tid >> 8, bg = (F.tid >> 6) & 3, d = F.tid & 63; (kv ? F.VC() : F.KC())[((bg * 512 + 511) << 6) + d] = 0; }
}

struct Stg { u32x4 k, v; };
DI void stage_load(Stg& s, const bf16* Kg, const bf16* Vg, int row0, int tid) {
    s.k = *(const u32x4*)(Kg + ((size_t)row0 << 6) + tid * 8); s.v = *(const u32x4*)(Vg + ((size_t)row0 << 6) + tid * 8);
}
DI void stage_store(const Stg& s, LAS unsigned char* lds, int buf, int tid) {
    *(LAS u32x4*)(lds + buf * BUFB + (tid >> 3) * KVROW + (tid & 7) * 16) = s.k; *(LAS u32x4*)(lds + buf * BUFB + KVT + (tid >> 3) * VROW + (tid & 7) * 16) = s.v;
}
DI unsigned pkbf(float a, float b) {
    typedef __bf16 bf2 __attribute__((ext_vector_type(2))); typedef float f2 __attribute__((ext_vector_type(2)));
    f2 v = {a, b}; bf2 r = __builtin_convertvector(v, bf2); return __builtin_bit_cast(unsigned, r);
}
DI void qk_tile(LAS const unsigned char* kt, const bf16x8 (&qf)[4], f32x16 (&s)[2], int lane) {
    const int r = lane & 31, h = lane >> 5;
    const int sr = (r & 19) | ((r & 4) << 1) | ((r & 8) >> 1);
    LAS const unsigned char* kp = kt + sr * KVROW + h * 16;
    bf16x8 ka[8];
#pragma unroll
    for (int kh = 0; kh < 2; ++kh)
#pragma unroll
        for (int ks = 0; ks < 4; ++ks) ka[kh * 4 + ks] = *(LAS const bf16x8*)(kp + kh * 32 * KVROW + ks * 32);
    s[0] = zero16(); s[1] = zero16();
#pragma unroll
    for (int ks = 0; ks < 4; ++ks) { s[0] = MFMA32(ka[ks], qf[ks], s[0]); s[1] = MFMA32(ka[4 + ks], qf[ks], s[1]); }
}
DI float xhalf_max(float v) { auto rr = __builtin_amdgcn_permlane32_swap(__float_as_uint(v), __float_as_uint(v), false, false); return fmaxf(__uint_as_float(rr[0]), __uint_as_float(rr[1])); }
DI float xhalf_sum(float v) { auto rr = __builtin_amdgcn_permlane32_swap(__float_as_uint(v), __float_as_uint(v), false, false); return __uint_as_float(rr[0]) + __uint_as_float(rr[1]); }
typedef float f32x2 __attribute__((ext_vector_type(2)));
DI void flash_tile(LAS const unsigned char* kt, LAS const unsigned char* vt, const bf16x8 (&qf)[4], f32x16 (&o)[2], float& m, float& l, int dq, unsigned maxoff, bool sel, int lane) {
    const int h = lane >> 5;
    f32x16 s[2];
    qk_tile(kt, qf, s, lane);
    bf16x8 vf[2][2][2];
    {
        const int q4 = (lane & 15) >> 2, p4 = lane & 3, blk = (lane >> 4) & 1;
        LAS const unsigned char* vb = vt + (8 * h + q4) * VROW + 8 * (4 * blk + p4);
#pragma unroll
        for (int kh = 0; kh < 2; ++kh)
#pragma unroll
            for (int s2 = 0; s2 < 2; ++s2)
#pragma unroll
                for (int db = 0; db < 2; ++db) {
                    LAS const unsigned char* vp = vb + (32 * kh + 16 * s2) * VROW + db * 64;
                    const s16x4 lo = __builtin_amdgcn_ds_read_tr16_b64_v4i16((LAS s16x4*)(vp));
                    const s16x4 hi = __builtin_amdgcn_ds_read_tr16_b64_v4i16((LAS s16x4*)(vp + 4 * VROW));
                    vf[kh][s2][db] = __builtin_shufflevector(lo, hi, 0, 1, 2, 3, 4, 5, 6, 7);
                }
    }
    const bool lane_full = (dq >= 55) && ((unsigned)dq <= maxoff);
    if (__ballot(!lane_full) != 0ull) {
#pragma unroll
        for (int kh = 0; kh < 2; ++kh)
#pragma unroll
            for (int i = 0; i < 16; ++i) { const int kk = 32 * kh + 16 * (i >> 3) + (i & 7); s[kh][i] = ((unsigned)(dq - kk) <= maxoff) ? s[kh][i] : -1e30f; }
    }
    float mt[4];
#pragma unroll
    for (int i = 0; i < 4; ++i) mt[i] = fmaxf(fmaxf(s[0][i], s[1][i]), fmaxf(s[0][i + 4], s[1][i + 4]));
#pragma unroll
    for (int i = 0; i < 4; ++i) mt[i] = fmaxf(mt[i], fmaxf(fmaxf(s[0][i + 8], s[1][i + 8]), fmaxf(s[0][i + 12], s[1][i + 12])));
    float mx = fmaxf(fmaxf(mt[0], mt[1]), fmaxf(mt[2], mt[3]));
    mx = xhalf_max(mx);
    mx = sel ? mx : -1e30f;
    const bool need = mx > m + 40.f;
    if (__ballot(need) != 0ull) {
        const float mn = need ? mx : m;
        const float alpha = need ? __builtin_amdgcn_exp2f((m - mn) * SC_LOG2E) : 1.f;
        m = mn; l *= alpha; o[0] *= alpha; o[1] *= alpha;
    }
    const float mb = sel ? fmaxf(m, -1e20f) * SC_LOG2E : 1e30f;
    f32x2 psa[2] = {{0.f, 0.f}, {0.f, 0.f}};
#pragma unroll
    for (int kh = 0; kh < 2; ++kh)
#pragma unroll
        for (int i = 0; i < 16; i += 2) {
            f32x2 x = {s[kh][i], s[kh][i + 1]};
            x = x * SC_LOG2E - mb;
            f32x2 p; p.x = __builtin_amdgcn_exp2f(x.x); p.y = __builtin_amdgcn_exp2f(x.y);
            psa[kh] += p; s[kh][i] = p.x; s[kh][i + 1] = p.y; }
    l += (psa[0].x + psa[0].y) + (psa[1].x + psa[1].y);
#pragma unroll
    for (int kh = 0; kh < 2; ++kh)
#pragma unroll
        for (int s2 = 0; s2 < 2; ++s2) {
            u32x4 pw; pw.x = pkbf(s[kh][8 * s2 + 0], s[kh][8 * s2 + 1]); pw.y = pkbf(s[kh][8 * s2 + 2], s[kh][8 * s2 + 3]);
            pw.z = pkbf(s[kh][8 * s2 + 4], s[kh][8 * s2 + 5]); pw.w = pkbf(s[kh][8 * s2 + 6], s[kh][8 * s2 + 7]);
            const bf16x8 pf = __builtin_bit_cast(bf16x8, pw);
            o[0] = MFMA32(vf[kh][s2][0], pf, o[0]); o[1] = MFMA32(vf[kh][s2][1], pf, o[1]);
        }
}
#define TILE_LOOP(T0, T1, ROWOF, KPTR, VPTR, BODY) do { \
    Stg sA_, sB_; const int t1_ = (T1); int t_ = (T0); \
    if (t_ < t1_) stage_load(sA_, KPTR, VPTR, ROWOF(t_), tid); \
    if (t_ + 1 < t1_) stage_load(sB_, KPTR, VPTR, ROWOF(t_ + 1), tid); \
    for (; t_ < t1_; t_ += 2) { \
        { const int ct = t_; const int buf = 0; stage_store(sA_, F.lds, 0, tid); __syncthreads(); if (ct + 2 < t1_) stage_load(sA_, KPTR, VPTR, ROWOF(ct + 2), tid); BODY } \
        if (t_ + 1 < t1_) { const int ct = t_ + 1; const int buf = 1; stage_store(sB_, F.lds, 1, tid); __syncthreads(); if (ct + 2 < t1_) stage_load(sB_, KPTR, VPTR, ROWOF(ct + 2), tid); BODY } \
    } \
    __syncthreads(); } while (0)
DI void write_o_row(bf16* dst, const f32x16 (&o)[2], float scale, int h) {
#pragma unroll
    for (int db = 0; db < 2; ++db)
#pragma unroll
        for (int i4 = 0; i4 < 4; ++i4) {
            u32x2 w; w.x = pkbf(o[db][4 * i4] * scale, o[db][4 * i4 + 1] * scale); w.y = pkbf(o[db][4 * i4 + 2] * scale, o[db][4 * i4 + 3] * scale);
            *(u32x2*)(dst + 32 * db + 8 * i4 + 4 * h) = w;
        }
}

DI void mixa_task(const Frame& F, int task) {
    const int tile32 = task & 31, hb = task >> 5, b = hb & 1, head = hb >> 1;
    const int g = head >> 3, slot = head & 7, lg = 2 * g;
    const int prow0 = tile32 * 256, L = SEQ >> lg, res = prow0 >> (13 - lg), p0 = prow0 & (L - 1);
    const bf16* Q = F.QKVA() + ((size_t)((head) * 2 + b) << 19);
    const bf16* K = F.QKVA() + ((size_t)((24 + head) * 2 + b) << 19);
    const bf16* V = F.QKVA() + ((size_t)((48 + head) * 2 + b) << 19);
    const int w = F.wave, lane = F.lane, r = lane & 31, h = lane >> 5;
    bf16x8 qf[4];
    { const bf16* qr = Q + ((size_t)(prow0 + 32 * w + r) << 6) + 8 * h;
#pragma unroll
      for (int ks = 0; ks < 4; ++ks) qf[ks] = *(const bf16x8*)(qr + 16 * ks); }
    f32x16 o[2] = {zero16(), zero16()}; float m = -1e30f, l = 0.f;
    const int kt0 = (p0 == 0) ? 2 : 0;
    const int tid = F.tid;
#define ROWOF_A(kt) (prow0 - 128 + 64 * (kt))
    TILE_LOOP(kt0, 6, ROWOF_A, K, V, {
        if (ct >= (w >> 1) && ct <= (w >> 1) + 2)
            flash_tile(F.lds + buf * BUFB, F.lds + buf * BUFB + KVT, qf, o, m, l, 128 + 32 * w + r - 64 * ct - 8 * h, 128u, true, lane);
    });
#undef ROWOF_A
    const float lt = xhalf_sum(l);
    const float inv = 1.f / lt;
    const int s = ((p0 + 32 * w + r) << lg) | res;
    const size_t row = (size_t)b * SEQ + s;
    bf16* og = (bf16*)(F.ws + ((g == 0) ? WS_R2 : (g == 1) ? (WS_R2 + 16 * MiB) : WS_WIN));
    write_o_row(og + row * 512 + slot * 64, o, inv, h);
    if (h == 0) F.LSE()[((size_t)g * TOK + row) * 8 + slot] = m * 0.125f + __logf(lt);
}

DI float gelu_tanh(float x) { const float u = 0.7978845608028654f * (x + 0.044715f * x * x * x); const float e = __expf(2.f * u); const float t = 1.f - 2.f / (e + 1.f); return 0.5f * x * (1.f + t); }
DI void compress_task(const Frame& F, int task) {
    const int kv = task >> 5, bg = (task >> 3) & 3, it = task & 7;
    const bf16* A = F.KVB() + ((size_t)(kv * 4 + bg) << 19);
    const bf16* W1T = kv ? F.W1V() : F.W1K(); const bf16* W2T = kv ? F.W2V() : F.W2K(); const float* bias = kv ? F.BIASV() : F.BIASK();
    bf16* OUT = (kv ? F.VC() : F.KC()) + ((size_t)bg << 15);
    const int w = F.wave, lane = F.lane, r = lane & 31, h = lane >> 5;
    LAS unsigned char* hid = F.lds;
    f32x16 acc[2] = {zero16(), zero16()};
    int i0 = 64 * it + r, i1 = i0 + 32; i0 = i0 > 510 ? 510 : i0; i1 = i1 > 510 ? 510 : i1;
    const bf16* a0p = A + (size_t)i0 * 1024 + 8 * h; const bf16* a1p = A + (size_t)i1 * 1024 + 8 * h;
    const bf16* bp = W1T + (size_t)(32 * w + r) * 2048 + 8 * h;
#pragma unroll 4
    for (int k0 = 0; k0 < 2048; k0 += 16) {
        const bf16x8 bfr = *(const bf16x8*)(bp + k0), a0 = *(const bf16x8*)(a0p + k0), a1 = *(const bf16x8*)(a1p + k0);
        acc[0] = MFMA32(a0, bfr, acc[0]); acc[1] = MFMA32(a1, bfr, acc[1]);
    }
    float bs = 0.f;
#pragma unroll
    for (int j = 0; j < 16; ++j) bs += bias[j * 256 + 32 * w + r];
#pragma unroll
    for (int rb = 0; rb < 2; ++rb)
#pragma unroll
        for (int i = 0; i < 16; ++i) { const int row = 32 * rb + (i & 3) + 8 * (i >> 2) + 4 * h;
            *(LAS bf16*)(hid + row * 528 + (32 * w + r) * 2) = (bf16)f2bf(gelu_tanh(acc[rb][i] + bs)); }
    __syncthreads();
    if (w < 4) {
        const int rb = w & 1, cb = w >> 1; f32x16 c = zero16();
        const bf16* b2 = W2T + (size_t)(32 * cb + r) * 256 + 8 * h;
#pragma unroll
        for (int k0 = 0; k0 < 256; k0 += 16) { const bf16x8 a = *(LAS const bf16x8*)(hid + (32 * rb + r) * 528 + (k0 + 8 * h) * 2); const bf16x8 bb = *(const bf16x8*)(b2 + k0); c = MFMA32(a, bb, c); }
#pragma unroll
        for (int i = 0; i < 16; ++i) { const int row = 64 * it + 32 * rb + (i & 3) + 8 * (i >> 2) + 4 * h;
            if (row < 511) OUT[((size_t)row << 6) + 32 * cb + r] = (bf16)f2bf(c[i]); }
    }
    __syncthreads();
}

DI float dpp_quad_sum(float p) {
    p += __builtin_bit_cast(float, __builtin_amdgcn_update_dpp(0, __builtin_bit_cast(int, p), 0xB1, 0xF, 0xF, true));
    p += __builtin_bit_cast(float, __builtin_amdgcn_update_dpp(0, __builtin_bit_cast(int, p), 0x4E, 0xF, 0xF, true));
    return p;
}
DI void imp_tile(LAS const unsigned char* kt, const bf16x8 (&qf)[4], LAS float* ipb, int dq, float mb, float invc, int lane) {
    f32x16 s[2];
    qk_tile(kt, qf, s, lane);
#pragma unroll
    for (int kh = 0; kh < 2; ++kh)
#pragma unroll
        for (int s2 = 0; s2 < 2; ++s2) {
            float ps[8];
#pragma unroll
            for (int j = 0; j < 8; ++j) { const int kk = 32 * kh + 16 * s2 + j; const bool v = (dq - kk) >= 0;
                const float p = v ? __builtin_amdgcn_exp2f(s[kh][8 * s2 + j] * SC_LOG2E - mb) * invc : 0.f; ps[j] = dpp_quad_sum(p); }
            const float sa = (ps[0] + ps[1]) + (ps[2] + ps[3]), sb = (ps[4] + ps[5]) + (ps[6] + ps[7]);
            LAS float* ip = ipb + 8 * kh + 4 * s2;
            if ((lane & 3) == 0) {
                __hip_atomic_fetch_add(ip, sa, __ATOMIC_RELAXED, __HIP_MEMORY_SCOPE_WORKGROUP);
                __hip_atomic_fetch_add(ip + 1, sb + ps[3], __ATOMIC_RELAXED, __HIP_MEMORY_SCOPE_WORKGROUP);
                __hip_atomic_fetch_add(ip + 2, ps[7], __ATOMIC_RELAXED, __HIP_MEMORY_SCOPE_WORKGROUP);
            }
        }
}
DI void stash_put(LAS f32x4* st, const f32x16 (&y)[2], int tid) {
#pragma unroll
    for (int i = 0; i < 8; ++i) { const f32x16& v = y[i >> 2]; const int q = (i & 3) * 4; st[i * 512 + tid] = (f32x4){v[q], v[q + 1], v[q + 2], v[q + 3]}; }
}
DI void stash_add(LAS const f32x4* st, f32x16 (&y)[2], int tid) {
#pragma unroll
    for (int i = 0; i < 8; ++i) { const f32x4 a = st[i * 512 + tid]; const int q = (i & 3) * 4; f32x16& v = y[i >> 2]; v[q] += a[0]; v[q + 1] += a[1]; v[q + 2] += a[2]; v[q + 3] += a[3]; }
}
DI void nsa_task(const Frame& F, int b, int g, int tt) {
    const int w = F.wave, lane = F.lane, r = lane & 31, h = lane >> 5, tid = F.tid;
    const int t0 = tt * 64, tok = 8 * w + (r >> 2), t = t0 + tok, head = 4 * g + (r & 3);
    const size_t row = (size_t)b * SEQ + t;
    const int bg = b * 2 + g;
    bf16x8 qf[4];
    { const bf16* qr = F.QB() + row * 512 + head * 64 + 8 * h;
#pragma unroll
      for (int ks = 0; ks < 4; ++ks) qf[ks] = *(const bf16x8*)(qr + 16 * ks); }
    float g0, g1, g2;
    { const bf16* gp = F.GB() + row * 32 + head * 3; g0 = sigm(bf2f(gp[0])); g1 = sigm(bf2f(gp[1])); g2 = sigm(bf2f(gp[2])); }
    LAS float* imp = (LAS float*)(F.lds + 2 * BUFB);
    for (int i = tid; i < 64 * 132; i += NTHR) imp[i] = 0.f;
    LAS f32x4* ystash = (LAS f32x4*)(F.lds + 2 * BUFB + 64 * 132 * 4);
    const int nvis = (4 * tt + 3) < 511 ? (4 * tt + 3) : 511, nct = (nvis + 63) >> 6;
    const bf16* Kc = F.KC() + ((size_t)bg << 15); const bf16* Vc = F.VC() + ((size_t)bg << 15);
    const int lim = (t - 31) >> 4;
    float mc, invc;
    {
        f32x16 o[2] = {zero16(), zero16()}; float m = -1e30f, l = 0.f;
#define ROWOF_T(ct_) (64 * (ct_))
        TILE_LOOP(0, nct, ROWOF_T, Kc, Vc, {
            flash_tile(F.lds + buf * BUFB, F.lds + buf * BUFB + KVT, qf, o, m, l, lim - 64 * ct - 8 * h, 0x7fffffffu, true, lane);
        });
        const float lt = xhalf_sum(l);
        invc = lt > 0.f ? 1.f / lt : 0.f; mc = m;
        o[0] *= (g0 * invc); o[1] *= (g0 * invc); stash_put(ystash, o, tid);
    }
    {
        const float mb = mc * SC_LOG2E;
        TILE_LOOP(0, nct, ROWOF_T, Kc, Vc, { imp_tile(F.lds + buf * BUFB, qf, imp + tok * 132 + 16 * ct + 2 * h, lim - 64 * ct - 8 * h, mb, invc, lane); });
        LDS_WAIT();
        __syncthreads();
    }
    unsigned long long mlo = 0ull, mhi = 0ull;
    if (tt <= 15) { mlo = (2ull << tt) - 1ull; }
    else {
        const int jmax = (tt + 2) & ~3;
        for (int tk = 0; tk < 8; ++tk) {
            LAS float* rowp = imp + (8 * w + tk) * 132;
            const int ma = lane, mb2 = lane + 64;
            const bool ca = (ma >= 1 && ma <= tt - 2), cb = (mb2 <= tt - 2);
            const float va = ca ? rowp[ma] : -1.f, vb = cb ? rowp[mb2] : -1.f;
            LDS_WAIT();
            rowp[ma] = va; rowp[mb2] = vb;
            LDS_WAIT();
            const unsigned long long ka = ((unsigned long long)__float_as_uint(fmaxf(va, 0.f)) << 32) | (unsigned)(255 - ma);
            const unsigned long long kb = ((unsigned long long)__float_as_uint(fmaxf(vb, 0.f)) << 32) | (unsigned)(255 - mb2);
            int cnta = 0, cntb = 0;
            for (int j = 0; j < jmax; j += 4) { const f32x4 v = *(LAS const f32x4*)(rowp + j);
#pragma unroll
                for (int e = 0; e < 4; ++e) { const float xv = v[e];
                    const unsigned long long kj = (xv >= 0.f) ? (((unsigned long long)__float_as_uint(xv) << 32) | (unsigned)(255 - (j + e))) : 0ull;
                    cnta += (kj > ka) ? 1 : 0; cntb += (kj > kb) ? 1 : 0; } }
            const bool sa = ca && cnta < 13, sb = cb && cntb < 13;
            unsigned long long ba = __ballot(sa), bb = __ballot(sb);
            ba |= 1ull;
            if (tt < 64) ba |= 1ull << tt; else bb |= 1ull << (tt - 64);
            if (tt - 1 < 64) ba |= 1ull << (tt - 1); else bb |= 1ull << (tt - 1 - 64);
            if ((r >> 2) == tk) { mlo = ba; mhi = bb; }
        }
    }
    {
        const bf16* Ks = F.KVB() + ((size_t)(2 * 4 + bg) << 19); const bf16* Vs = F.KVB() + ((size_t)(3 * 4 + bg) << 19);
        f32x16 o[2] = {zero16(), zero16()}; float m = -1e30f, l = 0.f;
        TILE_LOOP(0, tt + 1, ROWOF_T, Ks, Vs, {
            const bool sel = ((ct < 64 ? (mlo >> ct) : (mhi >> (ct - 64))) & 1ull) != 0ull;
            if (__ballot(sel) != 0ull)
                flash_tile(F.lds + buf * BUFB, F.lds + buf * BUFB + KVT, qf, o, m, l, t - 64 * ct - 8 * h, 0x7fffffffu, sel, lane);
        });
        const float lt = xhalf_sum(l); const float sc = g1 / lt;
        o[0] *= sc; o[1] *= sc; stash_add(ystash, o, tid); stash_put(ystash, o, tid);
    }
    {
        const bf16* Kw = F.KVB() + ((size_t)(4 * 4 + bg) << 19); const bf16* Vw = F.KVB() + ((size_t)(5 * 4 + bg) << 19);
        f32x16 o[2] = {zero16(), zero16()}; float m = -1e30f, l = 0.f;
        const int c0 = tt > 8 ? tt - 8 : 0;
        TILE_LOOP(c0, tt + 1, ROWOF_T, Kw, Vw, {
            flash_tile(F.lds + buf * BUFB, F.lds + buf * BUFB + KVT, qf, o, m, l, t - 64 * ct - 8 * h, 511u, true, lane);
        });
#undef ROWOF_T
        const float lt = xhalf_sum(l); const float sc = g2 / lt;
        o[0] *= sc; o[1] *= sc; stash_add(ystash, o, tid);
        write_o_row(F.YB() + row * 512 + head * 64, o, 1.f, h);
    }
}

DI void combine_ya(const Frame& F) {
    const int gt = F.bid * NTHR + F.tid, NGT = F.G * NTHR;
    for (int i = gt; i < TOK * 64; i += NGT) {
        const int row = i >> 6, ch = i & 63, slot = ch >> 3;
        const float l0 = F.LSE()[((size_t)0 * TOK + row) * 8 + slot], l1 = F.LSE()[((size_t)1 * TOK + row) * 8 + slot], l2 = F.LSE()[((size_t)2 * TOK + row) * 8 + slot];
        const float mx = fmaxf(l0, fmaxf(l1, l2)); float w0 = __expf(l0 - mx), w1 = __expf(l1 - mx), w2 = __expf(l2 - mx);
        const float inv = 1.f / (w0 + w1 + w2); w0 *= inv; w1 *= inv; w2 *= inv;
        const size_t off = (size_t)row * 512 + ch * 8;
        const u32x4 a = *(const u32x4*)(F.OG0() + off), bb = *(const u32x4*)(F.OG1() + off), c = *(const u32x4*)(F.OG2() + off);
        u32x4 o;
#pragma unroll
        for (int e = 0; e < 4; ++e) {
            const float lo = w0 * pg8::bf_lo(a[e]) + w1 * pg8::bf_lo(bb[e]) + w2 * pg8::bf_lo(c[e]);
            const float hi = w0 * pg8::bf_hi(a[e]) + w1 * pg8::bf_hi(bb[e]) + w2 * pg8::bf_hi(c[e]);
            o[e] = pk2(lo, hi);
        }
        *(u32x4*)(F.YA() + off) = o;
    }
}

#define XB_TMO      128
#define XB_XCNT(j)  (256  + 64 * (j))
#define XB_XSUB(j)  (1280 + 64 * (j))
#define XB_XGEN(j)  (2304 + 64 * (j))
#define XB_TOP      3328
#define XB_TOPGEN   3392
#define XCD_BAR_WORDS 3456
#define XB_SPIN_CAP (1u << 18)

__device__ __forceinline__ unsigned xb_ld(unsigned* p)              { return __hip_atomic_load(p, __ATOMIC_RELAXED, __HIP_MEMORY_SCOPE_AGENT); }
__device__ __forceinline__ unsigned xb_add(unsigned* p, unsigned v) { return __hip_atomic_fetch_add(p, v, __ATOMIC_RELAXED, __HIP_MEMORY_SCOPE_AGENT); }
__device__ __forceinline__ unsigned xb_xcc_id() { return (unsigned)__builtin_amdgcn_s_getreg((3 << 11) | 20) & 0xFu; }
#define XB_SPIN(cond, bar) do { unsigned _sp = 0; while (cond) { __builtin_amdgcn_s_sleep(1); \
    if ((++_sp & 255u) == 0u) { if (xb_ld(&(bar)[XB_TMO])) break; if (_sp > XB_SPIN_CAP) { atomicAdd(&(bar)[XB_TMO], 1u); break; } } } } while (0)
struct XcdBarrier {
    unsigned* bar; unsigned x;
    volatile LAS unsigned* st;
};

__device__ __forceinline__ XcdBarrier xcd_barrier_post(unsigned* bar, volatile LAS unsigned* st) {
    XcdBarrier b; b.bar = bar; b.x = xb_xcc_id(); b.st = st;
    if (threadIdx.x == 0) (void)xb_add(&bar[XB_XCNT(b.x)], 1u);
    return b;
}
__device__ __forceinline__ void xcd_barrier_complete(unsigned* bar, unsigned x, unsigned& nloc, unsigned& nx) {
    const unsigned G = gridDim.x * gridDim.y * gridDim.z;
    unsigned sum, cnt, mine, sp = 0u;
    for (;;) {
        sum = 0u; cnt = 0u; mine = 0u;
#pragma unroll
        for (unsigned j = 0; j < 16; ++j) { const unsigned c = xb_ld(&bar[XB_XCNT(j)]); sum += c; cnt += (c > 0u) ? 1u : 0u; mine = (j == x) ? c : mine; }
        if (sum == G) break;
        __builtin_amdgcn_s_sleep(1);
        if ((++sp & 255u) == 0u) { if (xb_ld(&bar[XB_TMO])) break; if (sp > XB_SPIN_CAP) { atomicAdd(&bar[XB_TMO], 1u); break; } }
    }
    nloc = mine > 0u ? mine : 1u; nx = cnt > 0u ? cnt : 1u;
}

__device__ __forceinline__ void xcd_barrier(const XcdBarrier& b) {
    asm volatile("s_waitcnt vmcnt(0)" ::: "memory");
    __syncthreads();
    if (threadIdx.x == 0) {
        unsigned* bar = b.bar;
        __builtin_amdgcn_s_waitcnt(0);
        unsigned nloc = b.st[0], nx = b.st[1];
        if (nloc == 0u) { xcd_barrier_complete(bar, b.x, nloc, nx); b.st[0] = nloc; b.st[1] = nx; }
        const unsigned old = xb_add(&bar[XB_XSUB(b.x)], 1u);
        const unsigned gen = old / nloc;
        if (old + 1u == (gen + 1u) * nloc) {
            __builtin_amdgcn_fence(__ATOMIC_RELEASE, "agent");
            asm volatile("s_waitcnt vmcnt(0)" ::: "memory");
            const unsigned og = xb_add(&bar[XB_TOP], 1u);
            const unsigned tg = og / nx;
            if (og + 1u == (tg + 1u) * nx) xb_add(&bar[XB_TOPGEN], 1u);
            else XB_SPIN(xb_ld(&bar[XB_TOPGEN]) == tg, bar);
            __builtin_amdgcn_fence(__ATOMIC_ACQUIRE, "agent");
            xb_add(&bar[XB_XGEN(b.x)], 1u);
            asm volatile("s_waitcnt vmcnt(0)" ::: "memory");
        } else {
            XB_SPIN(xb_ld(&bar[XB_XGEN(b.x)]) == gen, bar);
            __builtin_amdgcn_fence(__ATOMIC_ACQUIRE, "agent");
            asm volatile("s_waitcnt vmcnt(0)" ::: "memory");
        }
    }
    __syncthreads();
}

#ifndef PH_MAX
#define PH_MAX 99
#endif
#ifndef REPEAT_PH
#define REPEAT_PH 0
#endif
#define REP(k) for (int rep_ = 0; rep_ < ((REPEAT_PH == (k)) ? 2 : 1); ++rep_)
__global__ void __launch_bounds__(NTHR) fwd_mega(Args args) {
    extern __shared__ __attribute__((aligned(16))) unsigned char lds_raw[];
    cg::grid_group grid = cg::this_grid();
    Frame F;
    F.lds = (LAS unsigned char*)lds_raw; F.tid = threadIdx.x; F.lane = F.tid & 63; F.wave = __builtin_amdgcn_readfirstlane(F.tid >> 6); F.G = gridDim.x; F.bid = blockIdx.x;
    F.x = args.in[0]; F.g_mix = args.in[1]; F.w_in = args.in[2]; F.pos_k = args.in[3]; F.w1_k = args.in[4]; F.w2_k = args.in[5]; F.pos_v = args.in[6]; F.w1_v = args.in[7]; F.w2_v = args.in[8];
    F.w_a = args.in[9]; F.w_b = args.in[10]; F.w_out = args.in[11]; F.g_mlp = args.in[12]; F.w_up = args.in[13]; F.w_down = args.in[14]; F.g_fin = args.in[15];
    F.out = args.out; F.ws = args.ws;
    unsigned char* ws = args.ws;
    PG8_LAS unsigned char* glds = (PG8_LAS unsigned char*)lds_raw;
    volatile LAS unsigned* xst = (volatile LAS unsigned*)(F.lds + LDS_BYTES - 16);
    if (F.tid < 4) xst[F.tid] = 0u;
    __syncthreads();
    XcdBarrier xbar = xcd_barrier_post((unsigned*)ws, xst);
    grid.sync();
    const int gw = F.bid * 8 + F.wave, NGW = F.G * 8;

    REP(9) p0_prologue(F);
#if REPEAT_PH == 10
    for (int q_ = 0; q_ < 10; ++q_) grid.sync();
#endif
    xcd_barrier(xbar);
    asm volatile("" : "+v"(F.tid), "+v"(F.lane));
    if (PH_MAX >= 1) REP(1) {
        pg8::Gemm gm{F.U(), F.WIN(), TOK, NIN, DM}; pg8::StaticOrder S; S.init(TOK, NIN, F.G, F.bid);
        pg8::EpiInProj E{F.QKVA(), F.QB(), F.KVB(), F.GM(), F.GB(), F.CS()};
        pg8::gemm_phase<pg8::EpiInProj, pg8::StaticOrder, true, true>(glds, gm, S, E);
    }
    xcd_barrier(xbar);
    asm volatile("" : "+v"(F.tid), "+v"(F.lane));
    if (PH_MAX >= 2) REP(2) {
        unsigned* qctr = (unsigned*)ws + 3520 + 64 * rep_;
        volatile LAS int* qslot = (volatile LAS int*)(F.lds + LDS_BYTES - 8);
        for (;;) {
            if (F.tid == 0) *qslot = (int)__hip_atomic_fetch_add(qctr, 1u, __ATOMIC_RELAXED, __HIP_MEMORY_SCOPE_AGENT);
            __syncthreads();
            const int task = *qslot;
            __syncthreads();
            if (task >= 1600) break;
            if (task < 64) compress_task(F, task); else mixa_task(F, task - 64);
        }
    }
    xcd_barrier(xbar);
    asm volatile("" : "+v"(F.tid), "+v"(F.lane));
    if (PH_MAX >= 3) REP(3) {
        combine_ya(F);
        for (int st = F.bid; st < 256; st += F.G) { const int bg = st >> 6, i = st & 63; nsa_task(F, bg >> 1, bg & 1, 127 - i); nsa_task(F, bg >> 1, bg & 1, i); }
    }
    xcd_barrier(xbar);
    asm volatile("" : "+v"(F.tid), "+v"(F.lane));
    if (PH_MAX >= 4) REP(4) {
        pg8::StaticOrder S; S.init(TOK, DM, F.G, F.bid);
        { pg8::Gemm gm{F.YA(), F.WA(), TOK, DM, 512}; pg8::EpiMerge<1> E{F.GM(), F.TMP(), F.MERGED()}; pg8::gemm_phase<pg8::EpiMerge<1>, pg8::StaticOrder, true, true>(glds, gm, S, E); }
        { pg8::Gemm gm{F.YB(), F.WB(), TOK, DM, 512}; pg8::EpiMerge<2> E{F.GM(), F.TMP(), F.MERGED()}; pg8::gemm_phase<pg8::EpiMerge<2>, pg8::StaticOrder, true, true>(glds, gm, S, E); }
    }
    xcd_barrier(xbar);
    asm volatile("" : "+v"(F.tid), "+v"(F.lane));
    if (PH_MAX >= 5) REP(5) {
        pg8::StaticOrder S; S.init(TOK, DM, F.G, F.bid);
        pg8::Gemm gm{F.MERGED(), F.WO(), TOK, DM, DM}; pg8::EpiResF32 E{F.x, F.out, DM}; pg8::gemm_phase<pg8::EpiResF32, pg8::StaticOrder, true, true>(glds, gm, S, E);
    }
    xcd_barrier(xbar);
    asm volatile("" : "+v"(F.tid), "+v"(F.lane));
    if (PH_MAX >= 6) REP(6) {
        LAS float* scr = (LAS float*)(F.lds + F.wave * 16384);
        for (int it = gw; it < 4096; it += NGW) { int r = it;
            if (transpose_job(r, F.w_up, 4096, 0, 4096, DM, F.WUP(), 0, scr, F.lane)) continue;
            transpose_job(r, F.w_down, 1024, 0, 1024, FF, F.WDN(), 0, scr, F.lane); }
        for (int m = gw; m < TOK; m += NGW) rms_row_bf16(F.out + (size_t)m * DM, F.g_mlp, F.U() + (size_t)m * DM, F.lane);
    }
    xcd_barrier(xbar);
    asm volatile("" : "+v"(F.tid), "+v"(F.lane));
    if (PH_MAX >= 7) REP(7) {
        pg8::StaticOrder S; S.init(TOK, FF, F.G, F.bid);
        pg8::Gemm gm{F.U(), F.WUP(), TOK, FF, DM}; pg8::EpiRelu2 E{F.H(), FF}; pg8::gemm_phase<pg8::EpiRelu2, pg8::StaticOrder, true, true>(glds, gm, S, E);
    }
    xcd_barrier(xbar);
    asm volatile("" : "+v"(F.tid), "+v"(F.lane));
    if (PH_MAX >= 8) REP(8) {
        pg8::StaticOrder S; S.init(TOK, DM, F.G, F.bid);
        pg8::Gemm gm{F.H(), F.WDN(), TOK, DM, FF}; pg8::EpiResF32 E{F.out, F.out, DM}; pg8::gemm_phase<pg8::EpiResF32, pg8::StaticOrder, true, true>(glds, gm, S, E);
    }
    xcd_barrier(xbar);
    asm volatile("" : "+v"(F.tid), "+v"(F.lane));
    for (int m = gw; m < TOK; m += NGW) rms_row_f32_inplace(F.out + (size_t)m * DM, F.g_fin, F.lane);
}

extern "C" void kernel_launch(void* const* d_in, const int* in_sizes, int n_in, void* d_out, int out_size, void* d_ws, size_t ws_size, hipStream_t stream) {
    static int grid = 0;
    if (grid == 0) {
        if (n_in != 16 || out_size != TOK * DM || ws_size < WS_END) { fprintf(stderr, "kernel_launch: unexpected shapes (n_in %d out %d ws %zu)\n", n_in, out_size, ws_size); grid = -1; return; }
        int dev = 0, cus = 0, per_cu = 0;
        hipGetDevice(&dev); hipDeviceGetAttribute(&cus, hipDeviceAttributeMultiprocessorCount, dev);
        hipFuncSetAttribute((const void*)fwd_mega, hipFuncAttributeMaxDynamicSharedMemorySize, LDS_BYTES);
        if (hipOccupancyMaxActiveBlocksPerMultiprocessor(&per_cu, (const void*)fwd_mega, NTHR, LDS_BYTES) != hipSuccess || per_cu < 1) { fprintf(stderr, "kernel_launch: occupancy query gave %d\n", per_cu); per_cu = 1; }
        (void)hipGetLastError();
        grid = cus * 1;
    }
    if (grid < 0) return;
    if (hipMemsetAsync(d_ws, 0, 16384, stream) != hipSuccess) { fprintf(stderr, "kernel_launch: memset of barrier words failed\n"); return; }
    Args a{};
    for (int i = 0; i < 16; ++i) a.in[i] = (const float*)d_in[i];
    a.out = (float*)d_out; a.ws = (unsigned char*)d_ws;
    void* kargs[] = {&a};
    hipError_t e = hipLaunchCooperativeKernel((const void*)fwd_mega, dim3(grid), dim3(NTHR), kargs, LDS_BYTES, stream);
    if (e != hipSuccess) fprintf(stderr, "cooperative launch failed: %s (grid %d)\n", hipGetErrorString(e), grid);
}
```

```cpp
#include <hip/hip_runtime.h>
#include <hip/hip_cooperative_groups.h>
#include <cstdio>
#include <cstdint>
namespace cg = cooperative_groups;

namespace pg8 {
#define PG8_LAS __attribute__((address_space(3)))
typedef unsigned short bf16_t;
typedef short bf16x8 __attribute__((ext_vector_type(8)));
typedef float f32x4 __attribute__((ext_vector_type(4)));
typedef unsigned u32x4 __attribute__((ext_vector_type(4)));
constexpr int BM = 256, BK = 64, HALF = 128, HTB = HALF * BK * 2  , STAGE_BYTES = 8 * HTB, NXCD = 8, WGM = 8;

__host__ __device__ __forceinline__ int lds_byte(int r, int c) { const int st = (r >> 4) * 2 + (c >> 5), rr = r & 15, cc = c & 31, ob = rr * 64 + cc * 2; return st * 1024 + (ob ^ (((ob >> 9) & 1) << 5)); }
__host__ __device__ __forceinline__ void stage_rc(int b, int& R, int& C) { const int st = b / 1024, sb = b % 1024, swz = sb ^ (((sb >> 9) & 1) << 5); R = (st >> 1) * 16 + swz / 64; C = (st & 1) * 32 + (swz % 64) / 2; }
__host__ __device__ __forceinline__ int perm32(int rho) { const int n = rho >> 4, i = rho & 15; return 8 * (i >> 2) + 4 * n + (i & 3); }

struct Unit { int pm, pn; };
struct Gemm { const bf16_t* A; const bf16_t* Bt; int M, N, K; };

struct StaticOrder {
    int nM, nN, nwg, G, c;
    __host__ __device__ void init(int M, int N, int G_, int c_) { nM = M / BM; nN = N / BM; nwg = nM * nN; G = G_; c = c_; }
    __host__ __device__ bool next(int i, Unit& u) const {
        const long L = (long)i * G + c; if (L >= nwg) return false;
        int wgid = (int)L; { const int q = nwg / NXCD, r = nwg % NXCD, xcd = wgid % NXCD, off = wgid / NXCD; wgid = (xcd < r ? xcd * (q + 1) : r * (q + 1) + (xcd - r) * q) + off; }
        const int nig = WGM * nN, gid = wgid / nig, fm = gid * WGM, gsz = (nM - fm) < WGM ? (nM - fm) : WGM;
        u.pm = fm + ((wgid % nig) % gsz); u.pn = (wgid % nig) / gsz; return true;
    }
    __device__ __forceinline__ void a_ready(const Unit&) const {}
    __device__ __forceinline__ void done(const Unit&) const {}
};

__device__ __forceinline__ unsigned cvt_pk_bf16(float lo, float hi) { unsigned r; asm volatile("v_cvt_pk_bf16_f32 %0, %1, %2" : "=v"(r) : "v"(lo), "v"(hi)); return r; }
__device__ __forceinline__ float bf_lo(unsigned w) { return __builtin_bit_cast(float, w << 16); }
__device__ __forceinline__ float bf_hi(unsigned w) { return __builtin_bit_cast(float, w & 0xffff0000u); }
__device__ __forceinline__ float sigmoidf_(float x) { return __builtin_amdgcn_rcpf(1.f + __expf(-x)); }

struct EpiInProj {
    static constexpr bool PERM = true, AFTER_DRAIN = false;
    bf16_t* qkva; bf16_t* qb; bf16_t* kvb; bf16_t* gm; bf16_t* gb; const float* cs;
    __device__ __forceinline__ void operator()(const f32x4 (&acc)[2][2][4][2], const Unit& u, int wr, int wc, int fr, int fq) const {
        const int pn = u.pn;
        const int row0 = u.pm * BM + wr * 64 + fr;
        const bool rope_wave = !(wc & 1);
#pragma unroll
        for (int ai = 0; ai < 2; ++ai)
#pragma unroll
            for (int m = 0; m < 4; ++m) {
                const int row = row0 + ai * HALF + m * 16; const int b = row >> 13, s = row & 8191;
                f32x4 c0, c1, s0, s1;
                { const f32x4* t = (const f32x4*)(cs + (size_t)s * 16); c0 = t[0]; c1 = t[1]; s0 = t[2]; s1 = t[3]; }
#pragma unroll
                for (int bj = 0; bj < 2; ++bj) {
                    const int c = pn * BM + bj * HALF + wc * 32 + 8 * fq;
                    f32x4 v0 = acc[ai][bj][m][0], v1 = acc[ai][bj][m][1];
                    bool rope; bf16_t* dst;
                    if (pn < 18) { const int which = c / 1536, hc = c - which * 1536, head = hc >> 6, d0 = hc & 63, lg = (head >> 3) * 2;
                        const int prow = ((s & ((1 << lg) - 1)) << (13 - lg)) | (s >> lg);
                        dst = qkva + ((size_t)((((which * 24 + head) * 2 + b) << 13) + prow) << 6) + d0; rope = (pn < 12); }
                    else if (pn < 20) { dst = qb + (size_t)row * 512 + (c - 4608); rope = true; }
                    else if (pn < 23) { const int cc = c - 5120, j = cc >> 7, g = (cc >> 6) & 1, d0 = cc & 63;
                        dst = kvb + ((size_t)((((j * 4 + b * 2 + g)) << 13) + s) << 6) + d0; rope = (bj == 0); }
                    else if (pn < 31) { dst = gm + (size_t)row * 2048 + (c - 5888); rope = false; }
                    else { dst = gb + (size_t)row * 32 + (c - 7936); rope = false; }
                    if (rope && rope_wave) {
                        f32x4 p0, p1;
#pragma unroll
                        for (int e = 0; e < 4; ++e) { p0[e] = __shfl_xor(v0[e], 16); p1[e] = __shfl_xor(v1[e], 16); }
                        if (fq == 0) { v0 = v0 * c0 - p0 * s0; v1 = v1 * c1 - p1 * s1; }
                        else if (fq == 1) { v0 = v0 * c0 + p0 * s0; v1 = v1 * c1 + p1 * s1; }
                    }
                    if (pn < 31 || (bj == 0 && wc == 0)) {
                        u32x4 w; w.x = cvt_pk_bf16(v0[0], v0[1]); w.y = cvt_pk_bf16(v0[2], v0[3]); w.z = cvt_pk_bf16(v1[0], v1[1]); w.w = cvt_pk_bf16(v1[2], v1[3]);
                        *(u32x4*)dst = w; }
                }
            }
    }
};
template <int STEP> struct EpiMerge {
    static constexpr bool PERM = true, AFTER_DRAIN = false;
    const bf16_t* gm; float* tmp; bf16_t* merged;
    __device__ __forceinline__ void operator()(const f32x4 (&acc)[2][2][4][2], const Unit& u, int wr, int wc, int fr, int fq) const {
        const int row0 = u.pm * BM + wr * 64 + fr, col0 = u.pn * BM + wc * 32 + 8 * fq;
#pragma unroll
        for (int ai = 0; ai < 2; ++ai)
#pragma unroll
            for (int m = 0; m < 4; ++m)
#pragma unroll
                for (int bj = 0; bj < 2; ++bj) {
                    const int row = row0 + ai * HALF + m * 16, c = col0 + bj * HALF;
                    const u32x4 g = *(const u32x4*)(gm + (size_t)row * 2048 + (STEP - 1) * 1024 + c);
                    f32x4 v0 = acc[ai][bj][m][0], v1 = acc[ai][bj][m][1];
                    v0[0] *= sigmoidf_(bf_lo(g.x)); v0[1] *= sigmoidf_(bf_hi(g.x)); v0[2] *= sigmoidf_(bf_lo(g.y)); v0[3] *= sigmoidf_(bf_hi(g.y));
                    v1[0] *= sigmoidf_(bf_lo(g.z)); v1[1] *= sigmoidf_(bf_hi(g.z)); v1[2] *= sigmoidf_(bf_lo(g.w)); v1[3] *= sigmoidf_(bf_hi(g.w));
                    bf16_t* tp = (bf16_t*)tmp + (size_t)row * 1024 + c;
                    if (STEP == 1) { u32x4 w; w.x = cvt_pk_bf16(v0[0], v0[1]); w.y = cvt_pk_bf16(v0[2], v0[3]); w.z = cvt_pk_bf16(v1[0], v1[1]); w.w = cvt_pk_bf16(v1[2], v1[3]); *(u32x4*)tp = w; }
                    else { const u32x4 t = *(const u32x4*)tp; v0[0] += bf_lo(t.x); v0[1] += bf_hi(t.x); v0[2] += bf_lo(t.y); v0[3] += bf_hi(t.y); v1[0] += bf_lo(t.z); v1[1] += bf_hi(t.z); v1[2] += bf_lo(t.w); v1[3] += bf_hi(t.w);
                        u32x4 w; w.x = cvt_pk_bf16(v0[0], v0[1]); w.y = cvt_pk_bf16(v0[2], v0[3]); w.z = cvt_pk_bf16(v1[0], v1[1]); w.w = cvt_pk_bf16(v1[2], v1[3]);
                        *(u32x4*)(merged + (size_t)row * 1024 + c) = w; }
                    __builtin_amdgcn_sched_barrier(0);
                }
    }
};
struct EpiResF32 {
    static constexpr bool PERM = true, AFTER_DRAIN = false;
    const float* res; float* out; int ldc;
    __device__ __forceinline__ void operator()(const f32x4 (&acc)[2][2][4][2], const Unit& u, int wr, int wc, int fr, int fq) const {
        const int row0 = u.pm * BM + wr * 64 + fr, col0 = u.pn * BM + wc * 32 + 8 * fq;
#pragma unroll
        for (int ai = 0; ai < 2; ++ai)
#pragma unroll
            for (int m = 0; m < 4; ++m)
#pragma unroll
                for (int bj = 0; bj < 2; ++bj) {
                    const size_t off = (size_t)(row0 + ai * HALF + m * 16) * ldc + col0 + bj * HALF;
                    const f32x4 r0 = *(const f32x4*)(res + off), r1 = *(const f32x4*)(res + off + 4);
                    *(f32x4*)(out + off) = r0 + acc[ai][bj][m][0]; *(f32x4*)(out + off + 4) = r1 + acc[ai][bj][m][1];
                    __builtin_amdgcn_sched_barrier(0);
                }
    }
};
struct EpiRelu2 {
    static constexpr bool PERM = true, AFTER_DRAIN = false;
    bf16_t* O; int ldc;
    __device__ __forceinline__ void operator()(const f32x4 (&acc)[2][2][4][2], const Unit& u, int wr, int wc, int fr, int fq) const {
        const int row0 = u.pm * BM + wr * 64 + fr, col0 = u.pn * BM + wc * 32 + 8 * fq;
#pragma unroll
        for (int ai = 0; ai < 2; ++ai)
#pragma unroll
            for (int m = 0; m < 4; ++m)
#pragma unroll
                for (int bj = 0; bj < 2; ++bj) {
                    f32x4 v0 = acc[ai][bj][m][0], v1 = acc[ai][bj][m][1];
#pragma unroll
                    for (int e = 0; e < 4; ++e) { const float a = fmaxf(v0[e], 0.f), b = fmaxf(v1[e], 0.f); v0[e] = a * a; v1[e] = b * b; }
                    u32x4 w; w.x = cvt_pk_bf16(v0[0], v0[1]); w.y = cvt_pk_bf16(v0[2], v0[3]); w.z = cvt_pk_bf16(v1[0], v1[1]); w.w = cvt_pk_bf16(v1[2], v1[3]);
                    *(u32x4*)(O + (size_t)(row0 + ai * HALF + m * 16) * ldc + col0 + bj * HALF) = w;
                    __builtin_amdgcn_sched_barrier(0);
                }
    }
};

template <class Epi, class Sched, bool ALIGN_EPI = false, bool SP2 = false>
__device__ __forceinline__ void gemm_phase(PG8_LAS unsigned char* lds, const Gemm g, const Sched& S, const Epi& E) {
    int tid_ = threadIdx.x; asm volatile("" : "+v"(tid_));
    const int tid = tid_, wid = __builtin_amdgcn_readfirstlane(tid >> 6), lane = tid & 63, wr = wid >> 2, wc = wid & 3, fr = lane & 15, fq = lane >> 4;
    const int K = g.K, nt = K / BK;
    unsigned voffA[2], voffB[2];
#pragma unroll
    for (int i = 0; i < 2; ++i) { int R, C; stage_rc(tid * 16 + i * 8192, R, C); const int Rb = Epi::PERM ? ((R & ~31) + perm32(R & 31)) : R;
        voffA[i] = (unsigned)(R * K + C) * 2u; voffB[i] = (unsigned)(Rb * K + C) * 2u; }
    const size_t kstep = (size_t)(BK * 2);
    const size_t hstep = (size_t)HALF * K * 2;
    const size_t tstep = 2 * hstep;
    const unsigned ldsw = (unsigned)wid * 1024u;
    const int aoff = lds_byte(wr * 64 + fr, fq * 8), boff = lds_byte(wc * 32 + fr, fq * 8);
#define PG8_SA(b, h) (((b) * 2 + (h)) * HTB)
#define PG8_SB(b, h) ((4 + (b) * 2 + (h)) * HTB)
#define PG8_STAGE(bufoff, gbase, voff) do { _Pragma("unroll") for (int _i = 0; _i < 2; ++_i) \
        __builtin_amdgcn_global_load_lds((const unsigned*)((const char*)(gbase) + (voff)[_i]), (PG8_LAS unsigned*)(lds + (bufoff) + ldsw + _i * 8192), 16, 0, 0); } while (0)
#define PG8_LDA(dst, b, h) do { _Pragma("unroll") for (int m = 0; m < 4; ++m) _Pragma("unroll") for (int k = 0; k < 2; ++k) dst[m][k] = *(const PG8_LAS bf16x8*)(lds + PG8_SA(b, h) + aoff + m * 2048 + k * 1024); } while (0)
#define PG8_LDB(dst, b, h) do { _Pragma("unroll") for (int n = 0; n < 2; ++n) _Pragma("unroll") for (int k = 0; k < 2; ++k) dst[n][k] = *(const PG8_LAS bf16x8*)(lds + PG8_SB(b, h) + boff + n * 2048 + k * 1024); } while (0)
#define PG8_MMA(ai, bj, At, Bt) do { __builtin_amdgcn_s_setprio(1); _Pragma("unroll") for (int m = 0; m < 4; ++m) _Pragma("unroll") for (int n = 0; n < 2; ++n) _Pragma("unroll") for (int k = 0; k < 2; ++k) \
        acc[ai][bj][m][n] = __builtin_amdgcn_mfma_f32_16x16x32_bf16(Bt[n][k], At[m][k], acc[ai][bj][m][n], 0, 0, 0); __builtin_amdgcn_s_setprio(0); } while (0)
#define PG8_WAIT_V(n) asm volatile("s_waitcnt vmcnt(" #n ")" ::: "memory")
#define PG8_WAIT_L(n) asm volatile("s_waitcnt lgkmcnt(" #n ")" ::: "memory")
#define PG8_BAR __builtin_amdgcn_s_barrier()
#define PG8_SCHED __builtin_amdgcn_sched_barrier(0)
    Unit cur, nxt; int ui = 0;
    if (!S.next(0, cur)) return;
    f32x4 acc[2][2][4][2];
#pragma unroll
    for (int a = 0; a < 2; ++a)
#pragma unroll
        for (int b = 0; b < 2; ++b)
#pragma unroll
            for (int m = 0; m < 4; ++m)
#pragma unroll
                for (int n = 0; n < 2; ++n) acc[a][b][m][n] = (f32x4){0.f, 0.f, 0.f, 0.f};
    bf16x8 At[4][2], B0[2][2], B1[2][2];
    const char* cA = (const char*)g.A + (size_t)cur.pm * tstep; const char* cB = (const char*)g.Bt + (size_t)cur.pn * tstep;
    S.a_ready(cur);
    if constexpr (SP2) {
        PG8_STAGE(PG8_SB(0, 0), cB, voffB); PG8_STAGE(PG8_SB(0, 1), cB + hstep, voffB); PG8_STAGE(PG8_SA(0, 0), cA, voffA); PG8_STAGE(PG8_SA(0, 1), cA + hstep, voffA);
        if (wr == 1) PG8_BAR;
        PG8_WAIT_V(2); PG8_BAR;
        PG8_STAGE(PG8_SB(1, 0), cB + kstep, voffB); PG8_STAGE(PG8_SA(1, 0), cA + kstep, voffA); PG8_STAGE(PG8_SB(1, 1), cB + hstep + kstep, voffB);
        PG8_WAIT_V(6); PG8_BAR;
    } else {
        PG8_STAGE(PG8_SB(0, 0), cB, voffB); PG8_STAGE(PG8_SA(0, 0), cA, voffA); PG8_STAGE(PG8_SB(0, 1), cB + hstep, voffB); PG8_STAGE(PG8_SA(0, 1), cA + hstep, voffA);
        if (wr == 1) PG8_BAR;
        PG8_WAIT_V(4); PG8_BAR;
        PG8_STAGE(PG8_SB(1, 0), cB + kstep, voffB); PG8_STAGE(PG8_SA(1, 0), cA + kstep, voffA); PG8_STAGE(PG8_SB(1, 1), cB + hstep + kstep, voffB);
        PG8_WAIT_V(6); PG8_BAR;
    }
    for (;;) {
        const bool has_next = S.next(ui + 1, nxt);
        const char* nA = has_next ? (const char*)g.A + (size_t)nxt.pm * tstep : cA; const char* nB = has_next ? (const char*)g.Bt + (size_t)nxt.pn * tstep : cB;
        for (int t = 0; t < nt; t += 2) {
            const bool last = (t == nt - 2);
            const char* a1 = cA + (size_t)(t + 1) * kstep;
            const char* a2 = last ? nA : cA + (size_t)(t + 2) * kstep; const char* b2 = last ? nB : cB + (size_t)(t + 2) * kstep;
            const char* a3 = a2 + kstep; const char* b3 = b2 + kstep;
            if (last && has_next) S.a_ready(nxt);
            if constexpr (SP2) {
            PG8_LDB(B0, 0, 0); PG8_LDB(B1, 0, 1); PG8_SCHED; PG8_LDA(At, 0, 0); PG8_STAGE(PG8_SA(1, 1), a1 + hstep, voffA);
            PG8_WAIT_V(8); PG8_WAIT_L(0); PG8_BAR; PG8_MMA(0, 0, At, B0); PG8_MMA(0, 1, At, B1); PG8_BAR; PG8_SCHED;
            PG8_LDA(At, 0, 1); PG8_STAGE(PG8_SB(0, 0), b2, voffB); PG8_STAGE(PG8_SB(0, 1), b2 + hstep, voffB); PG8_STAGE(PG8_SA(0, 0), a2, voffA);
            PG8_WAIT_V(8); PG8_WAIT_L(0); PG8_BAR; PG8_MMA(1, 0, At, B0); PG8_MMA(1, 1, At, B1); PG8_BAR; PG8_SCHED;
            PG8_LDB(B0, 1, 0); PG8_LDB(B1, 1, 1); PG8_SCHED; PG8_LDA(At, 1, 0); PG8_STAGE(PG8_SA(0, 1), a2 + hstep, voffA);
            PG8_WAIT_V(8); PG8_WAIT_L(0); PG8_BAR; PG8_MMA(0, 0, At, B0); PG8_MMA(0, 1, At, B1); PG8_BAR; PG8_SCHED;
            PG8_LDA(At, 1, 1); PG8_STAGE(PG8_SB(1, 0), b3, voffB); PG8_STAGE(PG8_SB(1, 1), b3 + hstep, voffB); PG8_STAGE(PG8_SA(1, 0), a3, voffA);
            PG8_WAIT_V(8); PG8_WAIT_L(0); PG8_BAR; PG8_MMA(1, 0, At, B0); PG8_MMA(1, 1, At, B1); PG8_BAR; PG8_SCHED;
            } else {
            PG8_LDB(B0, 0, 0); PG8_SCHED; PG8_LDA(At, 0, 0); PG8_STAGE(PG8_SA(1, 1), a1 + hstep, voffA);
            PG8_WAIT_L(8); PG8_BAR; PG8_WAIT_L(0); PG8_MMA(0, 0, At, B0); PG8_BAR; PG8_SCHED;
            PG8_LDB(B1, 0, 1); PG8_STAGE(PG8_SB(0, 0), b2, voffB);
            PG8_BAR; PG8_WAIT_L(0); PG8_MMA(0, 1, At, B1); PG8_BAR;
            PG8_LDA(At, 0, 1); PG8_STAGE(PG8_SA(0, 0), a2, voffA);
            PG8_BAR; PG8_WAIT_L(0); PG8_MMA(1, 0, At, B0); PG8_BAR; PG8_SCHED;
            PG8_STAGE(PG8_SB(0, 1), b2 + hstep, voffB);
            PG8_WAIT_V(6); PG8_BAR; PG8_MMA(1, 1, At, B1); PG8_BAR;
            PG8_LDB(B0, 1, 0); PG8_SCHED; PG8_LDA(At, 1, 0); PG8_STAGE(PG8_SA(0, 1), a2 + hstep, voffA);
            PG8_WAIT_L(8); PG8_BAR; PG8_WAIT_L(0); PG8_MMA(0, 0, At, B0); PG8_BAR; PG8_SCHED;
            PG8_LDB(B1, 1, 1); PG8_STAGE(PG8_SB(1, 0), b3, voffB);
            PG8_BAR; PG8_WAIT_L(0); PG8_MMA(0, 1, At, B1); PG8_BAR;
            PG8_LDA(At, 1, 1); PG8_STAGE(PG8_SA(1, 0), a3, voffA);
            PG8_BAR; PG8_WAIT_L(0); PG8_MMA(1, 0, At, B0); PG8_BAR; PG8_SCHED;
            PG8_STAGE(PG8_SB(1, 1), b3 + hstep, voffB);
            PG8_WAIT_V(6); PG8_BAR; PG8_MMA(1, 1, At, B1); PG8_BAR;
            }
        }
        if constexpr (ALIGN_EPI) { if (wr == 0) PG8_BAR; }
        if constexpr (!Epi::AFTER_DRAIN) { E(acc, cur, wr, wc, fr, fq); S.done(cur); }
        if (!has_next) break;
#pragma unroll
        for (int a = 0; a < 2; ++a)
#pragma unroll
            for (int b = 0; b < 2; ++b)
#pragma unroll
                for (int m = 0; m < 4; ++m)
#pragma unroll
                    for (int n = 0; n < 2; ++n) acc[a][b][m][n] = (f32x4){0.f, 0.f, 0.f, 0.f};
        cur = nxt; cA = nA; cB = nB; ++ui;
        if constexpr (ALIGN_EPI) { if (wr == 1) PG8_BAR; }
    }
    PG8_WAIT_V(0);
    if constexpr (!ALIGN_EPI) { if (wr == 0) PG8_BAR; }
    PG8_BAR;
    if constexpr (Epi::AFTER_DRAIN) { E.fused(acc, cur, wr, wc, fr, fq, lds, wid, lane); S.done(cur); }
#undef PG8_SA
#undef PG8_SB
#undef PG8_STAGE
#undef PG8_LDA
#undef PG8_LDB
#undef PG8_MMA
#undef PG8_WAIT_V
#undef PG8_WAIT_L
#undef PG8_BAR
#undef PG8_SCHED
}
}

#define DI __device__ __forceinline__
#define LAS __attribute__((address_space(3)))
typedef unsigned short bf16;
typedef short bf16x8 __attribute__((ext_vector_type(8)));
typedef short s16x4 __attribute__((ext_vector_type(4)));
typedef float f32x4 __attribute__((ext_vector_type(4)));
typedef float f32x16 __attribute__((ext_vector_type(16)));
typedef unsigned u32x4 __attribute__((ext_vector_type(4)));
typedef unsigned u32x2 __attribute__((ext_vector_type(2)));
#define MFMA32(a, b, c) __builtin_amdgcn_mfma_f32_32x32x16_bf16((a), (b), (c), 0, 0, 0)
#define LDS_WAIT() asm volatile("s_waitcnt lgkmcnt(0)" ::: "memory")

constexpr int SEQ = 8192, TOK = 16384, DM = 1024, FF = 4096, NIN = 8192, NTHR = 512;
constexpr size_t MiB = 1u << 20;
constexpr size_t WS_WIN = 1 * MiB, WS_WA = 17 * MiB, WS_WB = 18 * MiB, WS_WO = 19 * MiB, WS_W1K = 21 * MiB, WS_W1V = 22 * MiB, WS_SMALL = 23 * MiB,
                 WS_KC = 24 * MiB, WS_LSE = 25 * MiB, WS_GB = 27 * MiB, WS_QB = 28 * MiB, WS_KVB = 44 * MiB, WS_R2 = 68 * MiB, WS_R1 = 100 * MiB,
                 WS_WUP = 228 * MiB, WS_WDN = 236 * MiB, WS_END = 244 * MiB;
constexpr int LDS_BYTES = 147456;
constexpr int KVROW = 144, KVT = 64 * KVROW;
constexpr int VROW = 192, VT = 64 * VROW, BUFB = KVT + VT;
constexpr float SC_LOG2E = 0.125f * 1.4426950408889634f;

struct Args { const float* in[16]; float* out; unsigned char* ws; };

struct Frame {
    LAS unsigned char* lds; int tid, lane, wave, G, bid;
    const float *x, *g_mix, *w_in, *pos_k, *w1_k, *w2_k, *pos_v, *w1_v, *w2_v, *w_a, *w_b, *w_out, *g_mlp, *w_up, *w_down, *g_fin;
    float* out; unsigned char* ws;
    DI bf16* WIN() const { return (bf16*)(ws + (WS_WIN)); }
    DI bf16* WA() const { return (bf16*)(ws + (WS_WA)); }
    DI bf16* WB() const { return (bf16*)(ws + (WS_WB)); }
    DI bf16* WO() const { return (bf16*)(ws + (WS_WO)); }
    DI bf16* W1K() const { return (bf16*)(ws + (WS_W1K)); }
    DI bf16* W1V() const { return (bf16*)(ws + (WS_W1V)); }
    DI bf16* W2K() const { return (bf16*)(ws + (WS_SMALL)); }
    DI bf16* W2V() const { return (bf16*)(ws + (WS_SMALL + 32768)); }
    DI bf16* KC() const { return (bf16*)(ws + (WS_KC)); }
    DI bf16* VC() const { return (bf16*)(ws + (WS_KC + 262144)); }
    DI bf16* GB() const { return (bf16*)(ws + (WS_GB)); }
    DI bf16* QB() const { return (bf16*)(ws + (WS_QB)); }
    DI bf16* KVB() const { return (bf16*)(ws + (WS_KVB)); }
    DI bf16* U() const { return (bf16*)(ws + (WS_R2)); }
    DI bf16* OG0() const { return (bf16*)(ws + (WS_R2)); }
    DI bf16* OG1() const { return (bf16*)(ws + (WS_R2 + 16 * MiB)); }
    DI bf16* OG2() const { return (bf16*)(ws + (WS_WIN)); }
    DI bf16* QKVA() const { return (bf16*)(ws + (WS_R1)); }
    DI bf16* YA() const { return (bf16*)(ws + (WS_R1)); }
    DI bf16* YB() const { return (bf16*)(ws + (WS_R1 + 16 * MiB)); }
    DI bf16* MERGED() const { return (bf16*)(ws + (WS_R1 + 96 * MiB)); }
    DI bf16* H() const { return (bf16*)(ws + (WS_R1)); }
    DI bf16* WUP() const { return (bf16*)(ws + (WS_WUP)); }
    DI bf16* WDN() const { return (bf16*)(ws + (WS_WDN)); }
    DI float* BIASK() const { return (float*)(ws + (WS_SMALL + 65536)); }
    DI float* BIASV() const { return (float*)(ws + (WS_SMALL + 81920)); }
    DI float* CS() const { return (float*)(ws + (WS_SMALL + 131072)); }
    DI float* LSE() const { return (float*)(ws + (WS_LSE)); }
    DI float* TMP() const { return (float*)(ws + (WS_R1 + 32 * MiB)); }
    DI bf16* GM() const { return (bf16*)out; }
};

DI float wave_sum(float v) {
#pragma unroll
    for (int o = 1; o < 64; o <<= 1) v += __shfl_xor(v, o);
    return v;
}
DI unsigned f2bf(float f) { unsigned u = __builtin_bit_cast(unsigned, f); return (u + 0x7fffu + ((u >> 16) & 1u)) >> 16; }
DI unsigned pk2(float lo, float hi) { return f2bf(lo) | (f2bf(hi) << 16); }
DI float bf2f(bf16 v) { return __builtin_bit_cast(float, (unsigned)v << 16); }
DI float sigm(float x) { return 1.f / (1.f + __expf(-x)); }
DI f32x16 zero16() { f32x16 z;
#pragma unroll
    for (int i = 0; i < 16; ++i) z[i] = 0.f;
    return z; }

DI void transpose_item(const float* W, int ldw, int col0, int ncols, int k0, bf16* WT, int K, int drow0, LAS float* scr, int lane) {
    const int cl = lane & 31;
#pragma unroll 8
    for (int i = 0; i < 32; ++i) { const int kk = 2 * i + (lane >> 5); scr[kk * 33 + cl] = (cl < ncols) ? W[(size_t)(k0 + kk) * ldw + col0 + cl] : 0.f; }
    LDS_WAIT();
    const int c = lane & 7;
#pragma unroll
    for (int j = 0; j < 4; ++j) { const int n = (lane >> 3) + 8 * j; const LAS float* s = scr + (8 * c) * 33 + n;
        u32x4 o; o.x = pk2(s[0 * 33], s[1 * 33]); o.y = pk2(s[2 * 33], s[3 * 33]); o.z = pk2(s[4 * 33], s[5 * 33]); o.w = pk2(s[6 * 33], s[7 * 33]);
        if (n < ncols) *(u32x4*)(WT + (size_t)(drow0 + n) * K + k0 + 8 * c) = o; }
    LDS_WAIT();
}
DI bool transpose_job(int& item, const float* W, int ldw, int scol0, int ncols, int K, bf16* WT, int drow0, LAS float* scr, int lane) {
    const int nblk = (ncols + 31) >> 5, nitems = (K >> 6) * nblk;
    if (item >= nitems) { item -= nitems; return false; }
    const int kb = item / nblk, nb = item - kb * nblk;
    const int rem = ncols - 32 * nb;
    transpose_item(W, ldw, scol0 + 32 * nb, rem < 32 ? rem : 32, 64 * kb, WT, K, drow0 + 32 * nb, scr, lane);
    return true;
}
DI void transpose_tile256(const float* W, int ldw, int col0, int k0, bf16* WT, int K, int drow0, LAS unsigned char* lds, int tid) {
    const int w = tid >> 6, l = tid & 63;
    LAS float* tile = (LAS float*)lds;
    f32x4 v[8];
#pragma unroll
    for (int i = 0; i < 8; ++i) v[i] = *(const f32x4*)(W + (size_t)(k0 + w + 8 * i) * ldw + col0 + 4 * l);
#pragma unroll
    for (int i = 0; i < 8; ++i) *(LAS f32x4*)(tile + (w + 8 * i) * 260 + 4 * l) = v[i];
    __syncthreads();
    const int n = tid & 255;
#pragma unroll
    for (int q = 0; q < 4; ++q) { const int c = (tid >> 8) + 2 * q; const LAS float* sp = tile + (8 * c) * 260 + n;
        u32x4 o; o.x = pk2(sp[0], sp[260]); o.y = pk2(sp[2 * 260], sp[3 * 260]); o.z = pk2(sp[4 * 260], sp[5 * 260]); o.w = pk2(sp[6 * 260], sp[7 * 260]);
        *(u32x4*)(WT + (size_t)(drow0 + n) * K + k0 + 8 * c) = o; }
    __syncthreads();
}
DI bool ttile_job(int& item, const float* W, int ldw, int scol0, int ncols, int K, bf16* WT, int drow0, LAS unsigned char* lds, int tid) {
    const int nblk = ncols >> 8, nitems = (K >> 6) * nblk;
    if (item >= nitems) { item -= nitems; return false; }
    const int kb = item / nblk, nb = item - kb * nblk;
    transpose_tile256(W, ldw, scol0 + 256 * nb, 64 * kb, WT, K, drow0 + 256 * nb, lds, tid);
    return true;
}
DI void rms_row_bf16(const float* xrow, const float* g, bf16* orow, int lane) {
    const f32x4* xr = (const f32x4*)xrow + lane; const f32x4* gr = (const f32x4*)g + lane;
    f32x4 v[4]; float s = 0.f;
#pragma unroll
    for (int j = 0; j < 4; ++j) { v[j] = xr[64 * j]; s += (v[j].x * v[j].x + v[j].y * v[j].y) + (v[j].z * v[j].z + v[j].w * v[j].w); }
    const float rstd = 1.f / sqrtf(wave_sum(s) * (1.f / DM) + 1e-6f);
    unsigned long long* o8 = (unsigned long long*)orow + lane;
#pragma unroll
    for (int j = 0; j < 4; ++j) { const f32x4 gg = gr[64 * j];
        o8[64 * j] = (unsigned long long)pk2(v[j].x * rstd * gg.x, v[j].y * rstd * gg.y) | ((unsigned long long)pk2(v[j].z * rstd * gg.z, v[j].w * rstd * gg.w) << 32); }
}
DI void rms_row_f32_inplace(float* xrow, const float* g, int lane) {
    f32x4* xr = (f32x4*)xrow + lane; const f32x4* gr = (const f32x4*)g + lane;
    f32x4 v[4]; float s = 0.f;
#pragma unroll
    for (int j = 0; j < 4; ++j) { v[j] = xr[64 * j]; s += (v[j].x * v[j].x + v[j].y * v[j].y) + (v[j].z * v[j].z + v[j].w * v[j].w); }
    const float rstd = 1.f / sqrtf(wave_sum(s) * (1.f / DM) + 1e-6f);
#pragma unroll
    for (int j = 0; j < 4; ++j) xr[64 * j] = v[j] * rstd * gr[64 * j];
}

DI void p0_prologue(const Frame& F) {
    LAS float* scr = (LAS float*)(F.lds + F.wave * 16384);
    const int gw = F.bid * 8 + F.wave, NGW = F.G * 8;
    constexpr int NTILES = 16 * 23 + 16 * 8 + 8 * 4 + 8 * 4 + 16 * 4 + 32 + 32;
    for (int it = F.bid; it < NTILES; it += F.G) {
        int r = it;
        if (ttile_job(r, F.w_in, 7960, 0, 5888, DM, F.WIN(), 0, F.lds, F.tid)) continue;
        if (ttile_job(r, F.w_in, 7960, 5912, 2048, DM, F.WIN(), 5888, F.lds, F.tid)) continue;
        if (ttile_job(r, F.w_a, 1024, 0, 1024, 512, F.WA(), 0, F.lds, F.tid)) continue;
        if (ttile_job(r, F.w_b, 1024, 0, 1024, 512, F.WB(), 0, F.lds, F.tid)) continue;
        if (ttile_job(r, F.w_out, 1024, 0, 1024, 1024, F.WO(), 0, F.lds, F.tid)) continue;
        if (ttile_job(r, F.w1_k, 256, 0, 256, 2048, F.W1K(), 0, F.lds, F.tid)) continue;
        ttile_job(r, F.w1_v, 256, 0, 256, 2048, F.W1V(), 0, F.lds, F.tid);
    }
    constexpr int NITEMS = 16 + 8 + 8;
    for (int it = gw; it < NITEMS; it += NGW) {
        int r = it;
        if (transpose_job(r, F.w_in, 7960, 5888, 24, DM, F.WIN(), 7936, scr, F.lane)) continue;
        if (transpose_job(r, F.w2_k, 64, 0, 64, 256, F.W2K(), 0, scr, F.lane)) continue;
        transpose_job(r, F.w2_v, 64, 0, 64, 256, F.W2V(), 0, scr, F.lane);
    }
    __syncthreads();
    const int gt = F.bid * NTHR + F.tid, NGT = F.G * NTHR;
    for (int i = gt; i < 232 * 1024 / 8; i += NGT) *(u32x4*)(F.WIN() + (size_t)7960 * 1024 + (size_t)i * 8) = (u32x4){0u, 0u, 0u, 0u};
    for (int i = gt; i < SEQ * 8; i += NGT) {
        const int s = i >> 3, k = i & 7;
        const double inv[8] = {1.0, 0.19392274474868576, 0.03760603093086393, 0.007292664737217109, 0.001414213562373095, 0.0002742481756762073, 5.318295896944988e-05, 1.031338537721246e-05};
        double iv = inv[0];
#pragma unroll
        for (int q = 1; q < 8; ++q) iv = (k == q) ? inv[q] : iv;
        const double rev = (double)s * iv * 0.15915494309189535;
        const float fr = (float)(rev - __builtin_rint(rev));
        F.CS()[s * 16 + k] = __builtin_amdgcn_cosf(fr); F.CS()[s * 16 + 8 + k] = __builtin_amdgcn_sinf(fr);
    }
    for (int m = gw; m < TOK; m += NGW) rms_row_bf16(F.x + (size_t)m * DM, F.g_mix, F.U() + (size_t)m * DM, F.lane);
    if (F.bid < 32) {
        const int mat = F.bid >> 4, part = F.bid & 15, col = F.tid & 255, kh = F.tid >> 8;
        const float* pe = mat ? F.pos_v : F.pos_k; const float* W1 = mat ? F.w1_v : F.w1_k; float acc = 0.f;
        const int kb = part * 128 + kh * 64;
#pragma unroll 8
        for (int k = 0; k < 64; ++k) acc += pe[kb + k] * W1[(size_t)(kb + k) * 256 + col];
        LAS float* red = (LAS float*)F.lds;
        __syncthreads();
        if (kh) red[col] = acc;
        __syncthreads();
        if (!kh) (mat ? F.BIASV() : F.BIASK())[part * 256 + col] = acc + red[col];
        __syncthreads();
    }
    if (F.bid == 2) { const int kv = F.tid >> 8, bg = (F.tid >> 6) & 3, d = F.tid & 63; (kv ? F.VC() : F.KC())[((bg * 512 + 511) << 6) + d] = 0; }
}

struct Stg { u32x4 k, v; };
DI void stage_load(Stg& s, const bf16* Kg, const bf16* Vg, int row0, int tid) {
    s.k = *(const u32x4*)(Kg + ((size_t)row0 << 6) + tid * 8); s.v = *(const u32x4*)(Vg + ((size_t)row0 << 6) + tid * 8);
}
DI void stage_store(const Stg& s, LAS unsigned char* lds, int buf, int tid) {
    *(LAS u32x4*)(lds + buf * BUFB + (tid >> 3) * KVROW + (tid & 7) * 16) = s.k; *(LAS u32x4*)(lds + buf * BUFB + KVT + (tid >> 3) * VROW + (tid & 7) * 16) = s.v;
}
DI unsigned pkbf(float a, float b) {
    typedef __bf16 bf2 __attribute__((ext_vector_type(2))); typedef float f2 __attribute__((ext_vector_type(2)));
    f2 v = {a, b}; bf2 r = __builtin_convertvector(v, bf2); return __builtin_bit_cast(unsigned, r);
}
DI void qk_tile(LAS const unsigned char* kt, const bf16x8 (&qf)[4], f32x16 (&s)[2], int lane) {
    const int r = lane & 31, h = lane >> 5;
    const int sr = (r & 19) | ((r & 4) << 1) | ((r & 8) >> 1);
    LAS const unsigned char* kp = kt + sr * KVROW + h * 16;
    bf16x8 ka[8];
#pragma unroll
    for (int kh = 0; kh < 2; ++kh)
#pragma unroll
        for (int ks = 0; ks < 4; ++ks) ka[kh * 4 + ks] = *(LAS const bf16x8*)(kp + kh * 32 * KVROW + ks * 32);
    s[0] = zero16(); s[1] = zero16();
    __builtin_amdgcn_s_setprio(1);
#pragma unroll
    for (int ks = 0; ks < 4; ++ks) { s[0] = MFMA32(ka[ks], qf[ks], s[0]); s[1] = MFMA32(ka[4 + ks], qf[ks], s[1]); }
    __builtin_amdgcn_s_setprio(0);
}
DI float xhalf_max(float v) { auto rr = __builtin_amdgcn_permlane32_swap(__float_as_uint(v), __float_as_uint(v), false, false); return fmaxf(__uint_as_float(rr[0]), __uint_as_float(rr[1])); }
DI float xhalf_sum(float v) { auto rr = __builtin_amdgcn_permlane32_swap(__float_as_uint(v), __float_as_uint(v), false, false); return __uint_as_float(rr[0]) + __uint_as_float(rr[1]); }
typedef float f32x2 __attribute__((ext_vector_type(2)));
#define OPQ(x) asm("" : "+v"(x))
DI void flash_tile(LAS const unsigned char* kt, LAS const unsigned char* vt, const bf16x8 (&qf)[4], f32x16 (&o)[2], float& m, float& l, int dq, unsigned maxoff, bool sel, int lane) {
    const int h = lane >> 5;
    f32x16 s[2];
    qk_tile(kt, qf, s, lane);
    bf16x8 vf[2][2][2];
    {
        const int q4 = (lane & 15) >> 2, p4 = lane & 3, blk = (lane >> 4) & 1;
        LAS const unsigned char* vb = vt + (8 * h + q4) * VROW + 8 * (4 * blk + p4);
#pragma unroll
        for (int kh = 0; kh < 2; ++kh)
#pragma unroll
            for (int s2 = 0; s2 < 2; ++s2)
#pragma unroll
                for (int db = 0; db < 2; ++db) {
                    LAS const unsigned char* vp = vb + (32 * kh + 16 * s2) * VROW + db * 64;
                    const s16x4 lo = __builtin_amdgcn_ds_read_tr16_b64_v4i16((LAS s16x4*)(vp));
                    const s16x4 hi = __builtin_amdgcn_ds_read_tr16_b64_v4i16((LAS s16x4*)(vp + 4 * VROW));
                    vf[kh][s2][db] = __builtin_shufflevector(lo, hi, 0, 1, 2, 3, 4, 5, 6, 7);
                }
    }
    const bool lane_full = (dq >= 55) && ((unsigned)dq <= maxoff);
    if (__ballot(!lane_full) != 0ull) {
#pragma unroll
        for (int kh = 0; kh < 2; ++kh)
#pragma unroll
            for (int i = 0; i < 16; ++i) { const int kk = 32 * kh + 16 * (i >> 3) + (i & 7); s[kh][i] = ((unsigned)(dq - kk) <= maxoff) ? s[kh][i] : -1e30f; }
    }
    float mt[4];
#pragma unroll
    for (int i = 0; i < 4; ++i) mt[i] = fmaxf(fmaxf(s[0][i], s[1][i]), fmaxf(s[0][i + 4], s[1][i + 4]));
#pragma unroll
    for (int i = 0; i < 4; ++i) mt[i] = fmaxf(mt[i], fmaxf(fmaxf(s[0][i + 8], s[1][i + 8]), fmaxf(s[0][i + 12], s[1][i + 12])));
    float mx = fmaxf(fmaxf(mt[0], mt[1]), fmaxf(mt[2], mt[3]));
    mx = xhalf_max(mx);
    mx = sel ? mx : -1e30f;
    const bool need = mx > m + 40.f;
    if (__ballot(need) != 0ull) {
        const float mn = need ? mx : m;
        const float alpha = need ? __builtin_amdgcn_exp2f((m - mn) * SC_LOG2E) : 1.f;
        m = mn; l *= alpha;
#pragma unroll
        for (int i = 0; i < 16; ++i) { float a = o[0][i] * alpha, b = o[1][i] * alpha; OPQ(a); OPQ(b); o[0][i] = a; o[1][i] = b; }
    }
    const float nmb = sel ? -fmaxf(m, -1e20f) * SC_LOG2E : -1e30f;
    float pa[4] = {0.f, 0.f, 0.f, 0.f};
#pragma unroll
    for (int kh = 0; kh < 2; ++kh)
#pragma unroll
        for (int i = 0; i < 16; ++i) {
            float x = __builtin_fmaf(s[kh][i], SC_LOG2E, nmb); OPQ(x);
            const float p = __builtin_amdgcn_exp2f(x);
            float a = pa[i & 3] + p; OPQ(a); pa[i & 3] = a;
            s[kh][i] = p; }
    l += (pa[0] + pa[1]) + (pa[2] + pa[3]);
#pragma unroll
    for (int kh = 0; kh < 2; ++kh)
#pragma unroll
        for (int s2 = 0; s2 < 2; ++s2) {
            u32x4 pw; pw.x = pkbf(s[kh][8 * s2 + 0], s[kh][8 * s2 + 1]); pw.y = pkbf(s[kh][8 * s2 + 2], s[kh][8 * s2 + 3]);
            pw.z = pkbf(s[kh][8 * s2 + 4], s[kh][8 * s2 + 5]); pw.w = pkbf(s[kh][8 * s2 + 6], s[kh][8 * s2 + 7]);
            const bf16x8 pf = __builtin_bit_cast(bf16x8, pw);
            o[0] = MFMA32(vf[kh][s2][0], pf, o[0]); o[1] = MFMA32(vf[kh][s2][1], pf, o[1]);
        }
}
#define TILE_LOOP(T0, T1, ROWOF, KPTR, VPTR, BODY) do { \
    Stg sA_, sB_; const int t1_ = (T1); int t_ = (T0); \
    if (t_ < t1_) stage_load(sA_, KPTR, VPTR, ROWOF(t_), tid); \
    if (t_ + 1 < t1_) stage_load(sB_, KPTR, VPTR, ROWOF(t_ + 1), tid); \
    for (; t_ < t1_; t_ += 2) { \
        { const int ct = t_; const int buf = 0; stage_store(sA_, F.lds, 0, tid); __syncthreads(); if (ct + 2 < t1_) stage_load(sA_, KPTR, VPTR, ROWOF(ct + 2), tid); BODY } \
        if (t_ + 1 < t1_) { const int ct = t_ + 1; const int buf = 1; stage_store(sB_, F.lds, 1, tid); __syncthreads(); if (ct + 2 < t1_) stage_load(sB_, KPTR, VPTR, ROWOF(ct + 2), tid); BODY } \
    } \
    __syncthreads(); } while (0)
DI void write_o_row(bf16* dst, const f32x16 (&o)[2], float scale, int h) {
#pragma unroll
    for (int db = 0; db < 2; ++db)
#pragma unroll
        for (int i4 = 0; i4 < 4; ++i4) {
            u32x2 w; w.x = pkbf(o[db][4 * i4] * scale, o[db][4 * i4 + 1] * scale); w.y = pkbf(o[db][4 * i4 + 2] * scale, o[db][4 * i4 + 3] * scale);
            *(u32x2*)(dst + 32 * db + 8 * i4 + 4 * h) = w;
        }
}

DI void mixa_task(const Frame& F, int task) {
    const int tile32 = task & 31, hb = task >> 5, b = hb & 1, head = hb >> 1;
    const int g = head >> 3, slot = head & 7, lg = 2 * g;
    const int prow0 = tile32 * 256, L = SEQ >> lg, res = prow0 >> (13 - lg), p0 = prow0 & (L - 1);
    const bf16* Q = F.QKVA() + ((size_t)((head) * 2 + b) << 19);
    const bf16* K = F.QKVA() + ((size_t)((24 + head) * 2 + b) << 19);
    const bf16* V = F.QKVA() + ((size_t)((48 + head) * 2 + b) << 19);
    const int w = F.wave, lane = F.lane, r = lane & 31, h = lane >> 5;
    bf16x8 qf[4];
    { const bf16* qr = Q + ((size_t)(prow0 + 32 * w + r) << 6) + 8 * h;
#pragma unroll
      for (int ks = 0; ks < 4; ++ks) qf[ks] = *(const bf16x8*)(qr + 16 * ks); }
    f32x16 o[2] = {zero16(), zero16()}; float m = -1e30f, l = 0.f;
    const int kt0 = (p0 == 0) ? 2 : 0;
    const int tid = F.tid;
#define ROWOF_A(kt) (prow0 - 128 + 64 * (kt))
    TILE_LOOP(kt0, 6, ROWOF_A, K, V, {
        if (ct >= (w >> 1) && ct <= (w >> 1) + 2)
            flash_tile(F.lds + buf * BUFB, F.lds + buf * BUFB + KVT, qf, o, m, l, 128 + 32 * w + r - 64 * ct - 8 * h, 128u, true, lane);
    });
#undef ROWOF_A
    const float lt = xhalf_sum(l);
    const float inv = 1.f / lt;
    const int s = ((p0 + 32 * w + r) << lg) | res;
    const size_t row = (size_t)b * SEQ + s;
    bf16* og = (bf16*)(F.ws + ((g == 0) ? WS_R2 : (g == 1) ? (WS_R2 + 16 * MiB) : WS_WIN));
    write_o_row(og + row * 512 + slot * 64, o, inv, h);
    if (h == 0) F.LSE()[((size_t)g * TOK + row) * 8 + slot] = m * 0.125f + __logf(lt);
}

DI float gelu_tanh(float x) { const float u = 0.7978845608028654f * (x + 0.044715f * x * x * x); const float e = __expf(2.f * u); const float t = 1.f - 2.f / (e + 1.f); return 0.5f * x * (1.f + t); }
DI void compress_task(const Frame& F, int task) {
    const int kv = task >> 5, bg = (task >> 3) & 3, it = task & 7;
    const bf16* A = F.KVB() + ((size_t)(kv * 4 + bg) << 19);
    const bf16* W1T = kv ? F.W1V() : F.W1K(); const bf16* W2T = kv ? F.W2V() : F.W2K(); const float* bias = kv ? F.BIASV() : F.BIASK();
    bf16* OUT = (kv ? F.VC() : F.KC()) + ((size_t)bg << 15);
    const int w = F.wave, lane = F.lane, r = lane & 31, h = lane >> 5;
    LAS unsigned char* hid = F.lds;
    f32x16 acc[2] = {zero16(), zero16()};
    int i0 = 64 * it + r, i1 = i0 + 32; i0 = i0 > 510 ? 510 : i0; i1 = i1 > 510 ? 510 : i1;
    const bf16* a0p = A + (size_t)i0 * 1024 + 8 * h; const bf16* a1p = A + (size_t)i1 * 1024 + 8 * h;
    const bf16* bp = W1T + (size_t)(32 * w + r) * 2048 + 8 * h;
#pragma unroll 4
    for (int k0 = 0; k0 < 2048; k0 += 16) {
        const bf16x8 bfr = *(const bf16x8*)(bp + k0), a0 = *(const bf16x8*)(a0p + k0), a1 = *(const bf16x8*)(a1p + k0);
        acc[0] = MFMA32(a0, bfr, acc[0]); acc[1] = MFMA32(a1, bfr, acc[1]);
    }
    float bs = 0.f;
#pragma unroll
    for (int j = 0; j < 16; ++j) bs += bias[j * 256 + 32 * w + r];
#pragma unroll
    for (int rb = 0; rb < 2; ++rb)
#pragma unroll
        for (int i = 0; i < 16; ++i) { const int row = 32 * rb + (i & 3) + 8 * (i >> 2) + 4 * h;
            *(LAS bf16*)(hid + row * 528 + (32 * w + r) * 2) = (bf16)f2bf(gelu_tanh(acc[rb][i] + bs)); }
    __syncthreads();
    if (w < 4) {
        const int rb = w & 1, cb = w >> 1; f32x16 c = zero16();
        const bf16* b2 = W2T + (size_t)(32 * cb + r) * 256 + 8 * h;
#pragma unroll
        for (int k0 = 0; k0 < 256; k0 += 16) { const bf16x8 a = *(LAS const bf16x8*)(hid + (32 * rb + r) * 528 + (k0 + 8 * h) * 2); const bf16x8 bb = *(const bf16x8*)(b2 + k0); c = MFMA32(a, bb, c); }
#pragma unroll
        for (int i = 0; i < 16; ++i) { const int row = 64 * it + 32 * rb + (i & 3) + 8 * (i >> 2) + 4 * h;
            if (row < 511) OUT[((size_t)row << 6) + 32 * cb + r] = (bf16)f2bf(c[i]); }
    }
    __syncthreads();
}

DI float dpp_quad_sum(float p) {
    p += __builtin_bit_cast(float, __builtin_amdgcn_update_dpp(0, __builtin_bit_cast(int, p), 0xB1, 0xF, 0xF, true));
    p += __builtin_bit_cast(float, __builtin_amdgcn_update_dpp(0, __builtin_bit_cast(int, p), 0x4E, 0xF, 0xF, true));
    return p;
}
DI void imp_tile(LAS const unsigned char* kt, const bf16x8 (&qf)[4], LAS float* ipb, int dq, float mb, float invc, int lane) {
    f32x16 s[2];
    qk_tile(kt, qf, s, lane);
#pragma unroll
    for (int kh = 0; kh < 2; ++kh)
#pragma unroll
        for (int s2 = 0; s2 < 2; ++s2) {
            float ps[8];
#pragma unroll
            for (int j = 0; j < 8; ++j) { const int kk = 32 * kh + 16 * s2 + j; const bool v = (dq - kk) >= 0;
                const float p = v ? __builtin_amdgcn_exp2f(s[kh][8 * s2 + j] * SC_LOG2E - mb) * invc : 0.f; ps[j] = dpp_quad_sum(p); }
            const float sa = (ps[0] + ps[1]) + (ps[2] + ps[3]), sb = (ps[4] + ps[5]) + (ps[6] + ps[7]);
            LAS float* ip = ipb + 8 * kh + 4 * s2;
            if ((lane & 3) == 0) {
                __hip_atomic_fetch_add(ip, sa, __ATOMIC_RELAXED, __HIP_MEMORY_SCOPE_WORKGROUP);
                __hip_atomic_fetch_add(ip + 1, sb + ps[3], __ATOMIC_RELAXED, __HIP_MEMORY_SCOPE_WORKGROUP);
                __hip_atomic_fetch_add(ip + 2, ps[7], __ATOMIC_RELAXED, __HIP_MEMORY_SCOPE_WORKGROUP);
            }
        }
}
DI void stash_put(LAS f32x4* st, const f32x16 (&y)[2], int tid) {
#pragma unroll
    for (int i = 0; i < 8; ++i) { const f32x16& v = y[i >> 2]; const int q = (i & 3) * 4; st[i * 512 + tid] = (f32x4){v[q], v[q + 1], v[q + 2], v[q + 3]}; }
}
DI void stash_add(LAS const f32x4* st, f32x16 (&y)[2], int tid) {
#pragma unroll
    for (int i = 0; i < 8; ++i) { const f32x4 a = st[i * 512 + tid]; const int q = (i & 3) * 4; f32x16& v = y[i >> 2]; v[q] += a[0]; v[q + 1] += a[1]; v[q + 2] += a[2]; v[q + 3] += a[3]; }
}
DI void nsa_task(const Frame& F, int b, int g, int tt) {
    const int w = F.wave, lane = F.lane, r = lane & 31, h = lane >> 5, tid = F.tid;
    const int t0 = tt * 64, tok = 8 * w + (r >> 2), t = t0 + tok, head = 4 * g + (r & 3);
    const size_t row = (size_t)b * SEQ + t;
    const int bg = b * 2 + g;
    bf16x8 qf[4];
    { const bf16* qr = F.QB() + row * 512 + head * 64 + 8 * h;
#pragma unroll
      for (int ks = 0; ks < 4; ++ks) qf[ks] = *(const bf16x8*)(qr + 16 * ks); }
    float g0, g1, g2;
    { const bf16* gp = F.GB() + row * 32 + head * 3; g0 = sigm(bf2f(gp[0])); g1 = sigm(bf2f(gp[1])); g2 = sigm(bf2f(gp[2])); }
    LAS float* imp = (LAS float*)(F.lds + 2 * BUFB);
    for (int i = tid; i < 64 * 132; i += NTHR) imp[i] = 0.f;
    LAS f32x4* ystash = (LAS f32x4*)(F.lds + 2 * BUFB + 64 * 132 * 4);
    const int nvis = (4 * tt + 3) < 511 ? (4 * tt + 3) : 511, nct = (nvis + 63) >> 6;
    const bf16* Kc = F.KC() + ((size_t)bg << 15); const bf16* Vc = F.VC() + ((size_t)bg << 15);
    const int lim = (t - 31) >> 4;
    float mc, invc;
    {
        f32x16 o[2] = {zero16(), zero16()}; float m = -1e30f, l = 0.f;
#define ROWOF_T(ct_) (64 * (ct_))
        TILE_LOOP(0, nct, ROWOF_T, Kc, Vc, {
            flash_tile(F.lds + buf * BUFB, F.lds + buf * BUFB + KVT, qf, o, m, l, lim - 64 * ct - 8 * h, 0x7fffffffu, true, lane);
        });
        const float lt = xhalf_sum(l);
        invc = lt > 0.f ? 1.f / lt : 0.f; mc = m;
        o[0] *= (g0 * invc); o[1] *= (g0 * invc); stash_put(ystash, o, tid);
    }
    {
        const float mb = mc * SC_LOG2E;
        TILE_LOOP(0, nct, ROWOF_T, Kc, Vc, { imp_tile(F.lds + buf * BUFB, qf, imp + tok * 132 + 16 * ct + 2 * h, lim - 64 * ct - 8 * h, mb, invc, lane); });
        LDS_WAIT();
        __syncthreads();
    }
    unsigned long long mlo = 0ull, mhi = 0ull;
    if (tt <= 15) { mlo = (2ull << tt) - 1ull; }
    else {
        const int jmax = (tt + 2) & ~3;
        for (int tk = 0; tk < 8; ++tk) {
            LAS float* rowp = imp + (8 * w + tk) * 132;
            const int ma = lane, mb2 = lane + 64;
            const bool ca = (ma >= 1 && ma <= tt - 2), cb = (mb2 <= tt - 2);
            const float va = ca ? rowp[ma] : -1.f, vb = cb ? rowp[mb2] : -1.f;
            LDS_WAIT();
            rowp[ma] = va; rowp[mb2] = vb;
            LDS_WAIT();
            const unsigned long long ka = ((unsigned long long)__float_as_uint(fmaxf(va, 0.f)) << 32) | (unsigned)(255 - ma);
            const unsigned long long kb = ((unsigned long long)__float_as_uint(fmaxf(vb, 0.f)) << 32) | (unsigned)(255 - mb2);
            int cnta = 0, cntb = 0;
            for (int j = 0; j < jmax; j += 4) { const f32x4 v = *(LAS const f32x4*)(rowp + j);
#pragma unroll
                for (int e = 0; e < 4; ++e) { const float xv = v[e];
                    const unsigned long long kj = (xv >= 0.f) ? (((unsigned long long)__float_as_uint(xv) << 32) | (unsigned)(255 - (j + e))) : 0ull;
                    cnta += (kj > ka) ? 1 : 0; cntb += (kj > kb) ? 1 : 0; } }
            const bool sa = ca && cnta < 13, sb = cb && cntb < 13;
            unsigned long long ba = __ballot(sa), bb = __ballot(sb);
            ba |= 1ull;
            if (tt < 64) ba |= 1ull << tt; else bb |= 1ull << (tt - 64);
            if (tt - 1 < 64) ba |= 1ull << (tt - 1); else bb |= 1ull << (tt - 1 - 64);
            if ((r >> 2) == tk) { mlo = ba; mhi = bb; }
        }
    }
    {
        const bf16* Ks = F.KVB() + ((size_t)(2 * 4 + bg) << 19); const bf16* Vs = F.KVB() + ((size_t)(3 * 4 + bg) << 19);
        f32x16 o[2] = {zero16(), zero16()}; float m = -1e30f, l = 0.f;
        TILE_LOOP(0, tt + 1, ROWOF_T, Ks, Vs, {
            const bool sel = ((ct < 64 ? (mlo >> ct) : (mhi >> (ct - 64))) & 1ull) != 0ull;
            if (__ballot(sel) != 0ull)
                flash_tile(F.lds + buf * BUFB, F.lds + buf * BUFB + KVT, qf, o, m, l, t - 64 * ct - 8 * h, 0x7fffffffu, sel, lane);
        });
        const float lt = xhalf_sum(l); const float sc = g1 / lt;
        o[0] *= sc; o[1] *= sc; stash_add(ystash, o, tid); stash_put(ystash, o, tid);
    }
    {
        const bf16* Kw = F.KVB() + ((size_t)(4 * 4 + bg) << 19); const bf16* Vw = F.KVB() + ((size_t)(5 * 4 + bg) << 19);
        f32x16 o[2] = {zero16(), zero16()}; float m = -1e30f, l = 0.f;
        const int c0 = tt > 8 ? tt - 8 : 0;
        TILE_LOOP(c0, tt + 1, ROWOF_T, Kw, Vw, {
            flash_tile(F.lds + buf * BUFB, F.lds + buf * BUFB + KVT, qf, o, m, l, t - 64 * ct - 8 * h, 511u, true, lane);
        });
#undef ROWOF_T
        const float lt = xhalf_sum(l); const float sc = g2 / lt;
        o[0] *= sc; o[1] *= sc; stash_add(ystash, o, tid);
        write_o_row(F.YB() + row * 512 + head * 64, o, 1.f, h);
    }
}

DI void combine_ya(const Frame& F) {
    const int gt = F.bid * NTHR + F.tid, NGT = F.G * NTHR;
    for (int i = gt; i < TOK * 64; i += NGT) {
        const int row = i >> 6, ch = i & 63, slot = ch >> 3;
        const float l0 = F.LSE()[((size_t)0 * TOK + row) * 8 + slot], l1 = F.LSE()[((size_t)1 * TOK + row) * 8 + slot], l2 = F.LSE()[((size_t)2 * TOK + row) * 8 + slot];
        const float mx = fmaxf(l0, fmaxf(l1, l2)); float w0 = __expf(l0 - mx), w1 = __expf(l1 - mx), w2 = __expf(l2 - mx);
        const float inv = 1.f / (w0 + w1 + w2); w0 *= inv; w1 *= inv; w2 *= inv;
        const size_t off = (size_t)row * 512 + ch * 8;
        const u32x4 a = *(const u32x4*)(F.OG0() + off), bb = *(const u32x4*)(F.OG1() + off), c = *(const u32x4*)(F.OG2() + off);
        u32x4 o;
#pragma unroll
        for (int e = 0; e < 4; ++e) {
            const float lo = w0 * pg8::bf_lo(a[e]) + w1 * pg8::bf_lo(bb[e]) + w2 * pg8::bf_lo(c[e]);
            const float hi = w0 * pg8::bf_hi(a[e]) + w1 * pg8::bf_hi(bb[e]) + w2 * pg8::bf_hi(c[e]);
            o[e] = pk2(lo, hi);
        }
        *(u32x4*)(F.YA() + off) = o;
    }
}

#define XB_TMO      128
#define XB_XCNT(j)  (256  + 64 * (j))
#define XB_XSUB(j)  (1280 + 64 * (j))
#define XB_XGEN(j)  (2304 + 64 * (j))
#define XB_TOP      3328
#define XB_TOPGEN   3392
#define XCD_BAR_WORDS 3456
#define XB_SPIN_CAP (1u << 18)

__device__ __forceinline__ unsigned xb_ld(unsigned* p)              { return __hip_atomic_load(p, __ATOMIC_RELAXED, __HIP_MEMORY_SCOPE_AGENT); }
__device__ __forceinline__ unsigned xb_add(unsigned* p, unsigned v) { return __hip_atomic_fetch_add(p, v, __ATOMIC_RELAXED, __HIP_MEMORY_SCOPE_AGENT); }
__device__ __forceinline__ unsigned xb_xcc_id() { return (unsigned)__builtin_amdgcn_s_getreg((3 << 11) | 20) & 0xFu; }
#define XB_SPIN(cond, bar) do { unsigned _sp = 0; while (cond) { __builtin_amdgcn_s_sleep(1); \
    if ((++_sp & 255u) == 0u) { if (xb_ld(&(bar)[XB_TMO])) break; if (_sp > XB_SPIN_CAP) { atomicAdd(&(bar)[XB_TMO], 1u); break; } } } } while (0)
struct XcdBarrier {
    unsigned* bar; unsigned x;
    volatile LAS unsigned* st;
};

__device__ __forceinline__ XcdBarrier xcd_barrier_post(unsigned* bar, volatile LAS unsigned* st) {
    XcdBarrier b; b.bar = bar; b.x = xb_xcc_id(); b.st = st;
    if (threadIdx.x == 0) (void)xb_add(&bar[XB_XCNT(b.x)], 1u);
    return b;
}
__device__ __forceinline__ void xcd_barrier_complete(unsigned* bar, unsigned x, unsigned& nloc, unsigned& nx) {
    const unsigned G = gridDim.x * gridDim.y * gridDim.z;
    unsigned sum, cnt, mine, sp = 0u;
    for (;;) {
        sum = 0u; cnt = 0u; mine = 0u;
#pragma unroll
        for (unsigned j = 0; j < 16; ++j) { const unsigned c = xb_ld(&bar[XB_XCNT(j)]); sum += c; cnt += (c > 0u) ? 1u : 0u; mine = (j == x) ? c : mine; }
        if (sum == G) break;
        __builtin_amdgcn_s_sleep(1);
        if ((++sp & 255u) == 0u) { if (xb_ld(&bar[XB_TMO])) break; if (sp > XB_SPIN_CAP) { atomicAdd(&bar[XB_TMO], 1u); break; } }
    }
    nloc = mine > 0u ? mine : 1u; nx = cnt > 0u ? cnt : 1u;
}

__device__ __forceinline__ void xcd_barrier(const XcdBarrier& b) {
    asm volatile("s_waitcnt vmcnt(0)" ::: "memory");
    __syncthreads();
    if (threadIdx.x == 0) {
        unsigned* bar = b.bar;
        __builtin_amdgcn_s_waitcnt(0);
        unsigned nloc = b.st[0], nx = b.st[1];
        if (nloc == 0u) { xcd_barrier_complete(bar, b.x, nloc, nx); b.st[0] = nloc; b.st[1] = nx; }
        const unsigned old = xb_add(&bar[XB_XSUB(b.x)], 1u);
        const unsigned gen = old / nloc;
        if (old + 1u == (gen + 1u) * nloc) {
            __builtin_amdgcn_fence(__ATOMIC_RELEASE, "agent");
            asm volatile("s_waitcnt vmcnt(0)" ::: "memory");
            const unsigned og = xb_add(&bar[XB_TOP], 1u);
            const unsigned tg = og / nx;
            if (og + 1u == (tg + 1u) * nx) xb_add(&bar[XB_TOPGEN], 1u);
            else XB_SPIN(xb_ld(&bar[XB_TOPGEN]) == tg, bar);
            __builtin_amdgcn_fence(__ATOMIC_ACQUIRE, "agent");
            xb_add(&bar[XB_XGEN(b.x)], 1u);
            asm volatile("s_waitcnt vmcnt(0)" ::: "memory");
        } else {
            XB_SPIN(xb_ld(&bar[XB_XGEN(b.x)]) == gen, bar);
            __builtin_amdgcn_fence(__ATOMIC_ACQUIRE, "agent");
            asm volatile("s_waitcnt vmcnt(0)" ::: "memory");
        }
    }
    __syncthreads();
}

#ifndef PH_MAX
#define PH_MAX 99
#endif
#ifndef REPEAT_PH
#define REPEAT_PH 0
#endif
#define REP(k) for (int rep_ = 0; rep_ < ((REPEAT_PH == (k)) ? 2 : 1); ++rep_)
__global__ void __launch_bounds__(NTHR) fwd_mega(Args args) {
    extern __shared__ __attribute__((aligned(16))) unsigned char lds_raw[];
    cg::grid_group grid = cg::this_grid();
    Frame F;
    F.lds = (LAS unsigned char*)lds_raw; F.tid = threadIdx.x; F.lane = F.tid & 63; F.wave = __builtin_amdgcn_readfirstlane(F.tid >> 6); F.G = gridDim.x; F.bid = blockIdx.x;
    F.x = args.in[0]; F.g_mix = args.in[1]; F.w_in = args.in[2]; F.pos_k = args.in[3]; F.w1_k = args.in[4]; F.w2_k = args.in[5]; F.pos_v = args.in[6]; F.w1_v = args.in[7]; F.w2_v = args.in[8];
    F.w_a = args.in[9]; F.w_b = args.in[10]; F.w_out = args.in[11]; F.g_mlp = args.in[12]; F.w_up = args.in[13]; F.w_down = args.in[14]; F.g_fin = args.in[15];
    F.out = args.out; F.ws = args.ws;
    unsigned char* ws = args.ws;
    PG8_LAS unsigned char* glds = (PG8_LAS unsigned char*)lds_raw;
    volatile LAS unsigned* xst = (volatile LAS unsigned*)(F.lds + LDS_BYTES - 16);
    if (F.tid < 4) xst[F.tid] = 0u;
    __syncthreads();
    XcdBarrier xbar = xcd_barrier_post((unsigned*)ws, xst);
    grid.sync();
    const int gw = F.bid * 8 + F.wave, NGW = F.G * 8;

    REP(9) p0_prologue(F);
#if REPEAT_PH == 10
    for (int q_ = 0; q_ < 10; ++q_) grid.sync();
#endif
    xcd_barrier(xbar);
    asm volatile("" : "+v"(F.tid), "+v"(F.lane));
    if (PH_MAX >= 1) REP(1) {
        pg8::Gemm gm{F.U(), F.WIN(), TOK, NIN, DM}; pg8::StaticOrder S; S.init(TOK, NIN, F.G, F.bid);
        pg8::EpiInProj E{F.QKVA(), F.QB(), F.KVB(), F.GM(), F.GB(), F.CS()};
        pg8::gemm_phase<pg8::EpiInProj, pg8::StaticOrder, true, true>(glds, gm, S, E);
    }
    xcd_barrier(xbar);
    asm volatile("" : "+v"(F.tid), "+v"(F.lane));
    if (PH_MAX >= 2) REP(2) {
        unsigned* qctr = (unsigned*)ws + 3520 + 64 * rep_;
        volatile LAS int* qslot = (volatile LAS int*)(F.lds + LDS_BYTES - 8);
        for (;;) {
            if (F.tid == 0) *qslot = (int)__hip_atomic_fetch_add(qctr, 1u, __ATOMIC_RELAXED, __HIP_MEMORY_SCOPE_AGENT);
            __syncthreads();
            const int task = *qslot;
            __syncthreads();
            if (task >= 1600) break;
            if (task < 64) compress_task(F, task); else mixa_task(F, task - 64);
        }
    }
    xcd_barrier(xbar);
    asm volatile("" : "+v"(F.tid), "+v"(F.lane));
    if (PH_MAX >= 3) REP(3) {
        combine_ya(F);
        unsigned* qctr = (unsigned*)ws + 3520 + 128 + 64 * rep_;
        volatile LAS int* qslot = (volatile LAS int*)(F.lds + LDS_BYTES - 8);
        for (;;) {
            if (F.tid == 0) *qslot = (int)__hip_atomic_fetch_add(qctr, 1u, __ATOMIC_RELAXED, __HIP_MEMORY_SCOPE_AGENT);
            __syncthreads();
            const int task = *qslot;
            __syncthreads();
            if (task >= 512) break;
            const int bg = task & 3; nsa_task(F, bg >> 1, bg & 1, 127 - (task >> 2));
        }
    }
    xcd_barrier(xbar);
    asm volatile("" : "+v"(F.tid), "+v"(F.lane));
    if (PH_MAX >= 4) REP(4) {
        pg8::StaticOrder S; S.init(TOK, DM, F.G, F.bid);
        { pg8::Gemm gm{F.YA(), F.WA(), TOK, DM, 512}; pg8::EpiMerge<1> E{F.GM(), F.TMP(), F.MERGED()}; pg8::gemm_phase<pg8::EpiMerge<1>, pg8::StaticOrder, true, true>(glds, gm, S, E); }
        { pg8::Gemm gm{F.YB(), F.WB(), TOK, DM, 512}; pg8::EpiMerge<2> E{F.GM(), F.TMP(), F.MERGED()}; pg8::gemm_phase<pg8::EpiMerge<2>, pg8::StaticOrder, true, true>(glds, gm, S, E); }
    }
    xcd_barrier(xbar);
    asm volatile("" : "+v"(F.tid), "+v"(F.lane));
    if (PH_MAX >= 5) REP(5) {
        pg8::StaticOrder S; S.init(TOK, DM, F.G, F.bid);
        pg8::Gemm gm{F.MERGED(), F.WO(), TOK, DM, DM}; pg8::EpiResF32 E{F.x, F.out, DM}; pg8::gemm_phase<pg8::EpiResF32, pg8::StaticOrder, true, true>(glds, gm, S, E);
    }
    xcd_barrier(xbar);
    asm volatile("" : "+v"(F.tid), "+v"(F.lane));
    if (PH_MAX >= 6) REP(6) {
        for (int it = F.bid; it < 512; it += F.G) { int r = it;
            if (ttile_job(r, F.w_up, 4096, 0, 4096, DM, F.WUP(), 0, F.lds, F.tid)) continue;
            ttile_job(r, F.w_down, 1024, 0, 1024, FF, F.WDN(), 0, F.lds, F.tid); }
        for (int m = gw; m < TOK; m += NGW) rms_row_bf16(F.out + (size_t)m * DM, F.g_mlp, F.U() + (size_t)m * DM, F.lane);
    }
    xcd_barrier(xbar);
    asm volatile("" : "+v"(F.tid), "+v"(F.lane));
    if (PH_MAX >= 7) REP(7) {
        pg8::StaticOrder S; S.init(TOK, FF, F.G, F.bid);
        pg8::Gemm gm{F.U(), F.WUP(), TOK, FF, DM}; pg8::EpiRelu2 E{F.H(), FF}; pg8::gemm_phase<pg8::EpiRelu2, pg8::StaticOrder, true, true>(glds, gm, S, E);
    }
    xcd_barrier(xbar);
    asm volatile("" : "+v"(F.tid), "+v"(F.lane));
    if (PH_MAX >= 8) REP(8) {
        pg8::StaticOrder S; S.init(TOK, DM, F.G, F.bid);
        pg8::Gemm gm{F.H(), F.WDN(), TOK, DM, FF}; pg8::EpiResF32 E{F.out, F.out, DM}; pg8::gemm_phase<pg8::EpiResF32, pg8::StaticOrder, true, true>(glds, gm, S, E);
    }
    xcd_barrier(xbar);
    asm volatile("" : "+v"(F.tid), "+v"(F.lane));
    for (int m = gw; m < TOK; m += NGW) rms_row_f32_inplace(F.out + (size_t)m * DM, F.g_fin, F.lane);
}

extern "C" void kernel_launch(void* const* d_in, const int* in_sizes, int n_in, void* d_out, int out_size, void* d_ws, size_t ws_size, hipStream_t stream) {
    static int grid = 0;
    if (grid == 0) {
        if (n_in != 16 || out_size != TOK * DM || ws_size < WS_END) { fprintf(stderr, "kernel_launch: unexpected shapes (n_in %d out %d ws %zu)\n", n_in, out_size, ws_size); grid = -1; return; }
        int dev = 0, cus = 0, per_cu = 0;
        hipGetDevice(&dev); hipDeviceGetAttribute(&cus, hipDeviceAttributeMultiprocessorCount, dev);
        hipFuncSetAttribute((const void*)fwd_mega, hipFuncAttributeMaxDynamicSharedMemorySize, LDS_BYTES);
        if (hipOccupancyMaxActiveBlocksPerMultiprocessor(&per_cu, (const void*)fwd_mega, NTHR, LDS_BYTES) != hipSuccess || per_cu < 1) { fprintf(stderr, "kernel_launch: occupancy query gave %d\n", per_cu); per_cu = 1; }
        (void)hipGetLastError();
        grid = cus * 1;
    }
    if (grid < 0) return;
    if (hipMemsetAsync(d_ws, 0, 16384, stream) != hipSuccess) { fprintf(stderr, "kernel_launch: memset of barrier words failed\n"); return; }
    Args a{};
    for (int i = 0; i < 16; ++i) a.in[i] = (const float*)d_in[i];
    a.out = (float*)d_out; a.ws = (unsigned char*)d_ws;
    void* kargs[] = {&a};
    hipError_t e = hipLaunchCooperativeKernel((const void*)fwd_mega, dim3(grid), dim3(NTHR), kargs, LDS_BYTES, stream);
    if (e != hipSuccess) fprintf(stderr, "cooperative launch failed: %s (grid %d)\n", hipGetErrorString(e), grid);
}
```

```cpp
#include <hip/hip_runtime.h>
#include <hip/hip_cooperative_groups.h>
#include <cstdio>
#include <cstdint>
namespace cg = cooperative_groups;

namespace pg8 {
#define PG8_LAS __attribute__((address_space(3)))
typedef unsigned short bf16_t;
typedef short bf16x8 __attribute__((ext_vector_type(8)));
typedef float f32x4 __attribute__((ext_vector_type(4)));
typedef unsigned u32x4 __attribute__((ext_vector_type(4)));
constexpr int BM = 256, BK = 64, HALF = 128, HTB = HALF * BK * 2  , STAGE_BYTES = 8 * HTB, NXCD = 8, WGM = 8;

__host__ __device__ __forceinline__ int lds_byte(int r, int c) { const int st = (r >> 4) * 2 + (c >> 5), rr = r & 15, cc = c & 31, ob = rr * 64 + cc * 2; return st * 1024 + (ob ^ (((ob >> 9) & 1) << 5)); }
__host__ __device__ __forceinline__ void stage_rc(int b, int& R, int& C) { const int st = b / 1024, sb = b % 1024, swz = sb ^ (((sb >> 9) & 1) << 5); R = (st >> 1) * 16 + swz / 64; C = (st & 1) * 32 + (swz % 64) / 2; }
__host__ __device__ __forceinline__ int perm32(int rho) { const int n = rho >> 4, i = rho & 15; return 8 * (i >> 2) + 4 * n + (i & 3); }

struct Unit { int pm, pn; };
struct Gemm { const bf16_t* A; const bf16_t* Bt; int M, N, K; };

struct StaticOrder {
    int nM, nN, nwg, G, c;
    __host__ __device__ void init(int M, int N, int G_, int c_) { nM = M / BM; nN = N / BM; nwg = nM * nN; G = G_; c = c_; }
    __host__ __device__ bool next(int i, Unit& u) const {
        const long L = (long)i * G + c; if (L >= nwg) return false;
        int wgid = (int)L; { const int q = nwg / NXCD, r = nwg % NXCD, xcd = wgid % NXCD, off = wgid / NXCD; wgid = (xcd < r ? xcd * (q + 1) : r * (q + 1) + (xcd - r) * q) + off; }
        const int nig = WGM * nN, gid = wgid / nig, fm = gid * WGM, gsz = (nM - fm) < WGM ? (nM - fm) : WGM;
        u.pm = fm + ((wgid % nig) % gsz); u.pn = (wgid % nig) / gsz; return true;
    }
    __device__ __forceinline__ void a_ready(const Unit&) const {}
    __device__ __forceinline__ void done(const Unit&) const {}
};

__device__ __forceinline__ unsigned cvt_pk_bf16(float lo, float hi) { unsigned r; asm volatile("v_cvt_pk_bf16_f32 %0, %1, %2" : "=v"(r) : "v"(lo), "v"(hi)); return r; }
__device__ __forceinline__ float bf_lo(unsigned w) { return __builtin_bit_cast(float, w << 16); }
__device__ __forceinline__ float bf_hi(unsigned w) { return __builtin_bit_cast(float, w & 0xffff0000u); }
__device__ __forceinline__ float sigmoidf_(float x) { return __builtin_amdgcn_rcpf(1.f + __expf(-x)); }

struct EpiInProj {
    static constexpr bool PERM = true, AFTER_DRAIN = false;
    bf16_t* qkva; bf16_t* qb; bf16_t* kvb; bf16_t* gm; bf16_t* gb; const float* cs;
    __device__ __forceinline__ void operator()(const f32x4 (&acc)[2][2][4][2], const Unit& u, int wr, int wc, int fr, int fq) const {
        const int pn = u.pn;
        const int row0 = u.pm * BM + wr * 64 + fr;
        const bool rope_wave = !(wc & 1);
#pragma unroll
        for (int ai = 0; ai < 2; ++ai)
#pragma unroll
            for (int m = 0; m < 4; ++m) {
                const int row = row0 + ai * HALF + m * 16; const int b = row >> 13, s = row & 8191;
                f32x4 c0, c1, s0, s1;
                { const f32x4* t = (const f32x4*)(cs + (size_t)s * 16); c0 = t[0]; c1 = t[1]; s0 = t[2]; s1 = t[3]; }
#pragma unroll
                for (int bj = 0; bj < 2; ++bj) {
                    const int c = pn * BM + bj * HALF + wc * 32 + 8 * fq;
                    f32x4 v0 = acc[ai][bj][m][0], v1 = acc[ai][bj][m][1];
                    bool rope; bf16_t* dst;
                    if (pn < 18) { const int which = c / 1536, hc = c - which * 1536, head = hc >> 6, d0 = hc & 63, lg = (head >> 3) * 2;
                        const int prow = ((s & ((1 << lg) - 1)) << (13 - lg)) | (s >> lg);
                        dst = qkva + ((size_t)((((which * 24 + head) * 2 + b) << 13) + prow) << 6) + d0; rope = (pn < 12); }
                    else if (pn < 20) { dst = qb + (size_t)row * 512 + (c - 4608); rope = true; }
                    else if (pn < 23) { const int cc = c - 5120, j = cc >> 7, g = (cc >> 6) & 1, d0 = cc & 63;
                        dst = kvb + ((size_t)((((j * 4 + b * 2 + g)) << 13) + s) << 6) + d0; rope = (bj == 0); }
                    else if (pn < 31) { dst = gm + (size_t)row * 2048 + (c - 5888); rope = false; }
                    else { dst = gb + (size_t)row * 32 + (c - 7936); rope = false; }
                    if (rope && rope_wave) {
                        f32x4 p0, p1;
#pragma unroll
                        for (int e = 0; e < 4; ++e) { p0[e] = __shfl_xor(v0[e], 16); p1[e] = __shfl_xor(v1[e], 16); }
                        if (fq == 0) { v0 = v0 * c0 - p0 * s0; v1 = v1 * c1 - p1 * s1; }
                        else if (fq == 1) { v0 = v0 * c0 + p0 * s0; v1 = v1 * c1 + p1 * s1; }
                    }
                    if (pn < 31 || (bj == 0 && wc == 0)) {
                        u32x4 w; w.x = cvt_pk_bf16(v0[0], v0[1]); w.y = cvt_pk_bf16(v0[2], v0[3]); w.z = cvt_pk_bf16(v1[0], v1[1]); w.w = cvt_pk_bf16(v1[2], v1[3]);
                        *(u32x4*)dst = w; }
                }
            }
    }
};
template <int STEP> struct EpiMerge {
    static constexpr bool PERM = true, AFTER_DRAIN = false;
    const bf16_t* gm; float* tmp; bf16_t* merged;
    __device__ __forceinline__ void operator()(const f32x4 (&acc)[2][2][4][2], const Unit& u, int wr, int wc, int fr, int fq) const {
        const int row0 = u.pm * BM + wr * 64 + fr, col0 = u.pn * BM + wc * 32 + 8 * fq;
#pragma unroll
        for (int ai = 0; ai < 2; ++ai)
#pragma unroll
            for (int m = 0; m < 4; ++m)
#pragma unroll
                for (int bj = 0; bj < 2; ++bj) {
                    const int row = row0 + ai * HALF + m * 16, c = col0 + bj * HALF;
                    const u32x4 g = __builtin_nontemporal_load((const u32x4*)(gm + (size_t)row * 2048 + (STEP - 1) * 1024 + c));
                    f32x4 v0 = acc[ai][bj][m][0], v1 = acc[ai][bj][m][1];
                    v0[0] *= sigmoidf_(bf_lo(g.x)); v0[1] *= sigmoidf_(bf_hi(g.x)); v0[2] *= sigmoidf_(bf_lo(g.y)); v0[3] *= sigmoidf_(bf_hi(g.y));
                    v1[0] *= sigmoidf_(bf_lo(g.z)); v1[1] *= sigmoidf_(bf_hi(g.z)); v1[2] *= sigmoidf_(bf_lo(g.w)); v1[3] *= sigmoidf_(bf_hi(g.w));
                    bf16_t* tp = (bf16_t*)tmp + (size_t)row * 1024 + c;
                    if (STEP == 1) { u32x4 w; w.x = cvt_pk_bf16(v0[0], v0[1]); w.y = cvt_pk_bf16(v0[2], v0[3]); w.z = cvt_pk_bf16(v1[0], v1[1]); w.w = cvt_pk_bf16(v1[2], v1[3]); *(u32x4*)tp = w; }
                    else { const u32x4 t = __builtin_nontemporal_load((const u32x4*)tp); v0[0] += bf_lo(t.x); v0[1] += bf_hi(t.x); v0[2] += bf_lo(t.y); v0[3] += bf_hi(t.y); v1[0] += bf_lo(t.z); v1[1] += bf_hi(t.z); v1[2] += bf_lo(t.w); v1[3] += bf_hi(t.w);
                        u32x4 w; w.x = cvt_pk_bf16(v0[0], v0[1]); w.y = cvt_pk_bf16(v0[2], v0[3]); w.z = cvt_pk_bf16(v1[0], v1[1]); w.w = cvt_pk_bf16(v1[2], v1[3]);
                        *(u32x4*)(merged + (size_t)row * 1024 + c) = w; }
                    __builtin_amdgcn_sched_barrier(0);
                }
    }
};
struct EpiResF32 {
    static constexpr bool PERM = true, AFTER_DRAIN = false;
    const float* res; float* out; int ldc;
    __device__ __forceinline__ void operator()(const f32x4 (&acc)[2][2][4][2], const Unit& u, int wr, int wc, int fr, int fq) const {
        const int row0 = u.pm * BM + wr * 64 + fr, col0 = u.pn * BM + wc * 32 + 8 * fq;
#pragma unroll
        for (int ai = 0; ai < 2; ++ai)
#pragma unroll
            for (int m = 0; m < 4; ++m)
#pragma unroll
                for (int bj = 0; bj < 2; ++bj) {
                    const size_t off = (size_t)(row0 + ai * HALF + m * 16) * ldc + col0 + bj * HALF;
                    const f32x4 r0 = *(const f32x4*)(res + off), r1 = *(const f32x4*)(res + off + 4);
                    *(f32x4*)(out + off) = r0 + acc[ai][bj][m][0]; *(f32x4*)(out + off + 4) = r1 + acc[ai][bj][m][1];
                    __builtin_amdgcn_sched_barrier(0);
                }
    }
};
struct EpiResBf16 {
    static constexpr bool PERM = true, AFTER_DRAIN = false;
    const float* res; bf16_t* O; int ldc;
    __device__ __forceinline__ void operator()(const f32x4 (&acc)[2][2][4][2], const Unit& u, int wr, int wc, int fr, int fq) const {
        const int row0 = u.pm * BM + wr * 64 + fr, col0 = u.pn * BM + wc * 32 + 8 * fq;
#pragma unroll
        for (int ai = 0; ai < 2; ++ai)
#pragma unroll
            for (int m = 0; m < 4; ++m)
#pragma unroll
                for (int bj = 0; bj < 2; ++bj) {
                    const size_t off = (size_t)(row0 + ai * HALF + m * 16) * ldc + col0 + bj * HALF;
                    const f32x4 v0 = *(const f32x4*)(res + off) + acc[ai][bj][m][0], v1 = *(const f32x4*)(res + off + 4) + acc[ai][bj][m][1];
                    u32x4 w; w.x = cvt_pk_bf16(v0[0], v0[1]); w.y = cvt_pk_bf16(v0[2], v0[3]); w.z = cvt_pk_bf16(v1[0], v1[1]); w.w = cvt_pk_bf16(v1[2], v1[3]);
                    *(u32x4*)(O + off) = w;
                    __builtin_amdgcn_sched_barrier(0);
                }
    }
};
struct EpiResBf16In {
    static constexpr bool PERM = true, AFTER_DRAIN = false;
    const bf16_t* res; bf16_t* O; int ldc;
    __device__ __forceinline__ void operator()(const f32x4 (&acc)[2][2][4][2], const Unit& u, int wr, int wc, int fr, int fq) const {
        const int row0 = u.pm * BM + wr * 64 + fr, col0 = u.pn * BM + wc * 32 + 8 * fq;
#pragma unroll
        for (int ai = 0; ai < 2; ++ai)
#pragma unroll
            for (int m = 0; m < 4; ++m)
#pragma unroll
                for (int bj = 0; bj < 2; ++bj) {
                    const size_t off = (size_t)(row0 + ai * HALF + m * 16) * ldc + col0 + bj * HALF;
                    const u32x4 r = __builtin_nontemporal_load((const u32x4*)(res + off));
                    f32x4 v0 = acc[ai][bj][m][0], v1 = acc[ai][bj][m][1];
                    v0[0] += bf_lo(r.x); v0[1] += bf_hi(r.x); v0[2] += bf_lo(r.y); v0[3] += bf_hi(r.y); v1[0] += bf_lo(r.z); v1[1] += bf_hi(r.z); v1[2] += bf_lo(r.w); v1[3] += bf_hi(r.w);
                    u32x4 w; w.x = cvt_pk_bf16(v0[0], v0[1]); w.y = cvt_pk_bf16(v0[2], v0[3]); w.z = cvt_pk_bf16(v1[0], v1[1]); w.w = cvt_pk_bf16(v1[2], v1[3]);
                    *(u32x4*)(O + off) = w;
                    __builtin_amdgcn_sched_barrier(0);
                }
    }
};
struct EpiResNormPrep {
    static constexpr bool PERM = true, AFTER_DRAIN = false;
    const float* res; bf16_t* X1; bf16_t* U; const float* g; float* part;
    __device__ __forceinline__ void operator()(const f32x4 (&acc)[2][2][4][2], const Unit& u, int wr, int wc, int fr, int fq) const {
        const int row0 = u.pm * BM + wr * 64 + fr, col0 = u.pn * BM + wc * 32 + 8 * fq;
#pragma unroll
        for (int ai = 0; ai < 2; ++ai)
#pragma unroll
            for (int m = 0; m < 4; ++m) {
                const int row = row0 + ai * HALF + m * 16; float ss = 0.f;
#pragma unroll
                for (int bj = 0; bj < 2; ++bj) {
                    const size_t off = (size_t)row * 1024 + col0 + bj * HALF;
                    const f32x4 v0 = __builtin_nontemporal_load((const f32x4*)(res + off)) + acc[ai][bj][m][0], v1 = __builtin_nontemporal_load((const f32x4*)(res + off + 4)) + acc[ai][bj][m][1];
                    const f32x4 g0 = *(const f32x4*)(g + col0 + bj * HALF), g1 = *(const f32x4*)(g + col0 + bj * HALF + 4);
                    ss += (v0[0] * v0[0] + v0[1] * v0[1]) + (v0[2] * v0[2] + v0[3] * v0[3]) + (v1[0] * v1[0] + v1[1] * v1[1]) + (v1[2] * v1[2] + v1[3] * v1[3]);
                    u32x4 w; w.x = cvt_pk_bf16(v0[0], v0[1]); w.y = cvt_pk_bf16(v0[2], v0[3]); w.z = cvt_pk_bf16(v1[0], v1[1]); w.w = cvt_pk_bf16(v1[2], v1[3]);
                    *(u32x4*)(X1 + off) = w;
                    u32x4 y; y.x = cvt_pk_bf16(v0[0] * g0[0], v0[1] * g0[1]); y.y = cvt_pk_bf16(v0[2] * g0[2], v0[3] * g0[3]); y.z = cvt_pk_bf16(v1[0] * g1[0], v1[1] * g1[1]); y.w = cvt_pk_bf16(v1[2] * g1[2], v1[3] * g1[3]);
                    *(u32x4*)(U + off) = y;
                }
                ss += __shfl_xor(ss, 16); ss += __shfl_xor(ss, 32);
                if (fq == 0) part[(size_t)row * 16 + u.pn * 4 + wc] = ss;
                __builtin_amdgcn_sched_barrier(0);
            }
    }
};
struct EpiRelu2 {
    static constexpr bool PERM = true, AFTER_DRAIN = false;
    bf16_t* O; int ldc; const float* part;
    __device__ __forceinline__ void operator()(const f32x4 (&acc)[2][2][4][2], const Unit& u, int wr, int wc, int fr, int fq) const {
        const int row0 = u.pm * BM + wr * 64 + fr, col0 = u.pn * BM + wc * 32 + 8 * fq;
#pragma unroll
        for (int ai = 0; ai < 2; ++ai)
#pragma unroll
            for (int m = 0; m < 4; ++m) {
                const f32x4* pp = (const f32x4*)(part + (size_t)(row0 + ai * HALF + m * 16) * 16);
                const f32x4 s4 = (pp[0] + pp[1]) + (pp[2] + pp[3]);
                const float rstd = 1.f / sqrtf(((s4[0] + s4[1]) + (s4[2] + s4[3])) * (1.f / 1024.f) + 1e-6f);
#pragma unroll
                for (int bj = 0; bj < 2; ++bj) {
                    f32x4 v0 = acc[ai][bj][m][0], v1 = acc[ai][bj][m][1];
#pragma unroll
                    for (int e = 0; e < 4; ++e) { const float a = fmaxf(v0[e] * rstd, 0.f), b = fmaxf(v1[e] * rstd, 0.f); v0[e] = a * a; v1[e] = b * b; }
                    u32x4 w; w.x = cvt_pk_bf16(v0[0], v0[1]); w.y = cvt_pk_bf16(v0[2], v0[3]); w.z = cvt_pk_bf16(v1[0], v1[1]); w.w = cvt_pk_bf16(v1[2], v1[3]);
                    *(u32x4*)(O + (size_t)(row0 + ai * HALF + m * 16) * ldc + col0 + bj * HALF) = w;
                    __builtin_amdgcn_sched_barrier(0);
                }
            }
    }
};

template <class Epi, class Sched, bool ALIGN_EPI = false, bool SP2 = false>
__device__ __forceinline__ void gemm_phase(PG8_LAS unsigned char* lds, const Gemm g, const Sched& S, const Epi& E) {
    int tid_ = threadIdx.x; asm volatile("" : "+v"(tid_));
    const int tid = tid_, wid = __builtin_amdgcn_readfirstlane(tid >> 6), lane = tid & 63, wr = wid >> 2, wc = wid & 3, fr = lane & 15, fq = lane >> 4;
    const int K = g.K, nt = K / BK;
    unsigned voffA[2], voffB[2];
#pragma unroll
    for (int i = 0; i < 2; ++i) { int R, C; stage_rc(tid * 16 + i * 8192, R, C); const int Rb = Epi::PERM ? ((R & ~31) + perm32(R & 31)) : R;
        voffA[i] = (unsigned)(R * K + C) * 2u; voffB[i] = (unsigned)(Rb * K + C) * 2u; }
    const size_t kstep = (size_t)(BK * 2);
    const size_t hstep = (size_t)HALF * K * 2;
    const size_t tstep = 2 * hstep;
    const unsigned ldsw = (unsigned)wid * 1024u;
    const int aoff = lds_byte(wr * 64 + fr, fq * 8), boff = lds_byte(wc * 32 + fr, fq * 8);
#define PG8_SA(b, h) (((b) * 2 + (h)) * HTB)
#define PG8_SB(b, h) ((4 + (b) * 2 + (h)) * HTB)
#define PG8_STAGE(bufoff, gbase, voff) do { _Pragma("unroll") for (int _i = 0; _i < 2; ++_i) \
        __builtin_amdgcn_global_load_lds((const unsigned*)((const char*)(gbase) + (voff)[_i]), (PG8_LAS unsigned*)(lds + (bufoff) + ldsw + _i * 8192), 16, 0, 0); } while (0)
#define PG8_LDA(dst, b, h) do { _Pragma("unroll") for (int m = 0; m < 4; ++m) _Pragma("unroll") for (int k = 0; k < 2; ++k) dst[m][k] = *(const PG8_LAS bf16x8*)(lds + PG8_SA(b, h) + aoff + m * 2048 + k * 1024); } while (0)
#define PG8_LDB(dst, b, h) do { _Pragma("unroll") for (int n = 0; n < 2; ++n) _Pragma("unroll") for (int k = 0; k < 2; ++k) dst[n][k] = *(const PG8_LAS bf16x8*)(lds + PG8_SB(b, h) + boff + n * 2048 + k * 1024); } while (0)
#define PG8_MMA(ai, bj, At, Bt) do { __builtin_amdgcn_s_setprio(1); _Pragma("unroll") for (int m = 0; m < 4; ++m) _Pragma("unroll") for (int n = 0; n < 2; ++n) _Pragma("unroll") for (int k = 0; k < 2; ++k) \
        acc[ai][bj][m][n] = __builtin_amdgcn_mfma_f32_16x16x32_bf16(Bt[n][k], At[m][k], acc[ai][bj][m][n], 0, 0, 0); __builtin_amdgcn_s_setprio(0); } while (0)
#define PG8_WAIT_V(n) asm volatile("s_waitcnt vmcnt(" #n ")" ::: "memory")
#define PG8_WAIT_L(n) asm volatile("s_waitcnt lgkmcnt(" #n ")" ::: "memory")
#define PG8_BAR __builtin_amdgcn_s_barrier()
#define PG8_SCHED __builtin_amdgcn_sched_barrier(0)
    Unit cur, nxt; int ui = 0;
    if (!S.next(0, cur)) return;
    f32x4 acc[2][2][4][2];
#pragma unroll
    for (int a = 0; a < 2; ++a)
#pragma unroll
        for (int b = 0; b < 2; ++b)
#pragma unroll
            for (int m = 0; m < 4; ++m)
#pragma unroll
                for (int n = 0; n < 2; ++n) acc[a][b][m][n] = (f32x4){0.f, 0.f, 0.f, 0.f};
    bf16x8 At[4][2], B0[2][2], B1[2][2];
    const char* cA = (const char*)g.A + (size_t)cur.pm * tstep; const char* cB = (const char*)g.Bt + (size_t)cur.pn * tstep;
    S.a_ready(cur);
    if constexpr (SP2) {
        PG8_STAGE(PG8_SB(0, 0), cB, voffB); PG8_STAGE(PG8_SB(0, 1), cB + hstep, voffB); PG8_STAGE(PG8_SA(0, 0), cA, voffA); PG8_STAGE(PG8_SA(0, 1), cA + hstep, voffA);
        if (wr == 1) PG8_BAR;
        PG8_WAIT_V(2); PG8_BAR;
        PG8_STAGE(PG8_SB(1, 0), cB + kstep, voffB); PG8_STAGE(PG8_SA(1, 0), cA + kstep, voffA); PG8_STAGE(PG8_SB(1, 1), cB + hstep + kstep, voffB);
        PG8_WAIT_V(6); PG8_BAR;
    } else {
        PG8_STAGE(PG8_SB(0, 0), cB, voffB); PG8_STAGE(PG8_SA(0, 0), cA, voffA); PG8_STAGE(PG8_SB(0, 1), cB + hstep, voffB); PG8_STAGE(PG8_SA(0, 1), cA + hstep, voffA);
        if (wr == 1) PG8_BAR;
        PG8_WAIT_V(4); PG8_BAR;
        PG8_STAGE(PG8_SB(1, 0), cB + kstep, voffB); PG8_STAGE(PG8_SA(1, 0), cA + kstep, voffA); PG8_STAGE(PG8_SB(1, 1), cB + hstep + kstep, voffB);
        PG8_WAIT_V(6); PG8_BAR;
    }
    for (;;) {
        const bool has_next = S.next(ui + 1, nxt);
        const char* nA = has_next ? (const char*)g.A + (size_t)nxt.pm * tstep : cA; const char* nB = has_next ? (const char*)g.Bt + (size_t)nxt.pn * tstep : cB;
        for (int t = 0; t < nt; t += 2) {
            const bool last = (t == nt - 2);
            const char* a1 = cA + (size_t)(t + 1) * kstep;
            const char* a2 = last ? nA : cA + (size_t)(t + 2) * kstep; const char* b2 = last ? nB : cB + (size_t)(t + 2) * kstep;
            const char* a3 = a2 + kstep; const char* b3 = b2 + kstep;
            if (last && has_next) S.a_ready(nxt);
            if constexpr (SP2) {
            PG8_LDB(B0, 0, 0); PG8_LDB(B1, 0, 1); PG8_SCHED; PG8_LDA(At, 0, 0); PG8_STAGE(PG8_SA(1, 1), a1 + hstep, voffA);
            PG8_WAIT_V(8); PG8_WAIT_L(0); PG8_BAR; PG8_MMA(0, 0, At, B0); PG8_MMA(0, 1, At, B1); PG8_BAR; PG8_SCHED;
            PG8_LDA(At, 0, 1); PG8_STAGE(PG8_SB(0, 0), b2, voffB); PG8_STAGE(PG8_SB(0, 1), b2 + hstep, voffB); PG8_STAGE(PG8_SA(0, 0), a2, voffA);
            PG8_WAIT_V(8); PG8_WAIT_L(0); PG8_BAR; PG8_MMA(1, 0, At, B0); PG8_MMA(1, 1, At, B1); PG8_BAR; PG8_SCHED;
            PG8_LDB(B0, 1, 0); PG8_LDB(B1, 1, 1); PG8_SCHED; PG8_LDA(At, 1, 0); PG8_STAGE(PG8_SA(0, 1), a2 + hstep, voffA);
            PG8_WAIT_V(8); PG8_WAIT_L(0); PG8_BAR; PG8_MMA(0, 0, At, B0); PG8_MMA(0, 1, At, B1); PG8_BAR; PG8_SCHED;
            PG8_LDA(At, 1, 1); PG8_STAGE(PG8_SB(1, 0), b3, voffB); PG8_STAGE(PG8_SB(1, 1), b3 + hstep, voffB); PG8_STAGE(PG8_SA(1, 0), a3, voffA);
            PG8_WAIT_V(8); PG8_WAIT_L(0); PG8_BAR; PG8_MMA(1, 0, At, B0); PG8_MMA(1, 1, At, B1); PG8_BAR; PG8_SCHED;
            } else {
            PG8_LDB(B0, 0, 0); PG8_SCHED; PG8_LDA(At, 0, 0); PG8_STAGE(PG8_SA(1, 1), a1 + hstep, voffA);
            PG8_WAIT_L(8); PG8_BAR; PG8_WAIT_L(0); PG8_MMA(0, 0, At, B0); PG8_BAR; PG8_SCHED;
            PG8_LDB(B1, 0, 1); PG8_STAGE(PG8_SB(0, 0), b2, voffB);
            PG8_BAR; PG8_WAIT_L(0); PG8_MMA(0, 1, At, B1); PG8_BAR;
            PG8_LDA(At, 0, 1); PG8_STAGE(PG8_SA(0, 0), a2, voffA);
            PG8_BAR; PG8_WAIT_L(0); PG8_MMA(1, 0, At, B0); PG8_BAR; PG8_SCHED;
            PG8_STAGE(PG8_SB(0, 1), b2 + hstep, voffB);
            PG8_WAIT_V(6); PG8_BAR; PG8_MMA(1, 1, At, B1); PG8_BAR;
            PG8_LDB(B0, 1, 0); PG8_SCHED; PG8_LDA(At, 1, 0); PG8_STAGE(PG8_SA(0, 1), a2 + hstep, voffA);
            PG8_WAIT_L(8); PG8_BAR; PG8_WAIT_L(0); PG8_MMA(0, 0, At, B0); PG8_BAR; PG8_SCHED;
            PG8_LDB(B1, 1, 1); PG8_STAGE(PG8_SB(1, 0), b3, voffB);
            PG8_BAR; PG8_WAIT_L(0); PG8_MMA(0, 1, At, B1); PG8_BAR;
            PG8_LDA(At, 1, 1); PG8_STAGE(PG8_SA(1, 0), a3, voffA);
            PG8_BAR; PG8_WAIT_L(0); PG8_MMA(1, 0, At, B0); PG8_BAR; PG8_SCHED;
            PG8_STAGE(PG8_SB(1, 1), b3 + hstep, voffB);
            PG8_WAIT_V(6); PG8_BAR; PG8_MMA(1, 1, At, B1); PG8_BAR;
            }
        }
        if constexpr (ALIGN_EPI) { if (wr == 0) PG8_BAR; }
        if constexpr (!Epi::AFTER_DRAIN) { E(acc, cur, wr, wc, fr, fq); S.done(cur); }
        if (!has_next) break;
#pragma unroll
        for (int a = 0; a < 2; ++a)
#pragma unroll
            for (int b = 0; b < 2; ++b)
#pragma unroll
                for (int m = 0; m < 4; ++m)
#pragma unroll
                    for (int n = 0; n < 2; ++n) acc[a][b][m][n] = (f32x4){0.f, 0.f, 0.f, 0.f};
        cur = nxt; cA = nA; cB = nB; ++ui;
        if constexpr (ALIGN_EPI) { if (wr == 1) PG8_BAR; }
    }
    PG8_WAIT_V(0);
    if constexpr (!ALIGN_EPI) { if (wr == 0) PG8_BAR; }
    PG8_BAR;
    if constexpr (Epi::AFTER_DRAIN) { E.fused(acc, cur, wr, wc, fr, fq, lds, wid, lane); S.done(cur); }
#undef PG8_SA
#undef PG8_SB
#undef PG8_STAGE
#undef PG8_LDA
#undef PG8_LDB
#undef PG8_MMA
#undef PG8_WAIT_V
#undef PG8_WAIT_L
#undef PG8_BAR
#undef PG8_SCHED
}
}

#define DI __device__ __forceinline__
#ifndef NSA_SKIP
#define NSA_SKIP 0
#endif
#define LAS __attribute__((address_space(3)))
typedef unsigned short bf16;
typedef short bf16x8 __attribute__((ext_vector_type(8)));
typedef short s16x4 __attribute__((ext_vector_type(4)));
typedef float f32x4 __attribute__((ext_vector_type(4)));
typedef float f32x16 __attribute__((ext_vector_type(16)));
typedef unsigned u32x4 __attribute__((ext_vector_type(4)));
typedef unsigned u32x2 __attribute__((ext_vector_type(2)));
#define MFMA32(a, b, c) __builtin_amdgcn_mfma_f32_32x32x16_bf16((a), (b), (c), 0, 0, 0)
#define LDS_WAIT() asm volatile("s_waitcnt lgkmcnt(0)" ::: "memory")

constexpr int SEQ = 8192, TOK = 16384, DM = 1024, FF = 4096, NIN = 8192, NTHR = 512;
constexpr size_t MiB = 1u << 20;
constexpr size_t WS_WIN = 1 * MiB, WS_WA = 17 * MiB, WS_WB = 18 * MiB, WS_WO = 19 * MiB, WS_W1K = 21 * MiB, WS_W1V = 22 * MiB, WS_SMALL = 23 * MiB,
                 WS_KC = 24 * MiB, WS_LSE = 25 * MiB, WS_GB = 27 * MiB, WS_QB = 28 * MiB, WS_KVB = 44 * MiB, WS_R2 = 68 * MiB, WS_R1 = 100 * MiB,
                 WS_WUP = 228 * MiB, WS_WDN = 236 * MiB, WS_END = 244 * MiB;
constexpr int LDS_BYTES = 147456;
constexpr int KVROW = 144, KVT = 64 * KVROW;
constexpr int VROW = 192, VT = 64 * VROW, BUFB = KVT + VT;
constexpr float SC_LOG2E = 0.125f * 1.4426950408889634f;

struct Args { const float* in[16]; float* out; unsigned char* ws; };

struct Frame {
    LAS unsigned char* lds; int tid, lane, wave, G, bid;
    const float *x, *g_mix, *w_in, *pos_k, *w1_k, *w2_k, *pos_v, *w1_v, *w2_v, *w_a, *w_b, *w_out, *g_mlp, *w_up, *w_down, *g_fin;
    float* out; unsigned char* ws;
    DI bf16* WIN() const { return (bf16*)(ws + (WS_WIN)); }
    DI bf16* WA() const { return (bf16*)(ws + (WS_WA)); }
    DI bf16* WB() const { return (bf16*)(ws + (WS_WB)); }
    DI bf16* WO() const { return (bf16*)(ws + (WS_WO)); }
    DI bf16* W1K() const { return (bf16*)(ws + (WS_W1K)); }
    DI bf16* W1V() const { return (bf16*)(ws + (WS_W1V)); }
    DI bf16* W2K() const { return (bf16*)(ws + (WS_SMALL)); }
    DI bf16* W2V() const { return (bf16*)(ws + (WS_SMALL + 32768)); }
    DI bf16* KC() const { return (bf16*)(ws + (WS_KC)); }
    DI bf16* VC() const { return (bf16*)(ws + (WS_KC + 262144)); }
    DI bf16* GB() const { return (bf16*)(ws + (WS_GB)); }
    DI bf16* QB() const { return (bf16*)(ws + (WS_QB)); }
    DI bf16* KVB() const { return (bf16*)(ws + (WS_KVB)); }
    DI bf16* U() const { return (bf16*)(ws + (WS_R2)); }
    DI bf16* OG0() const { return (bf16*)(ws + (WS_R2)); }
    DI bf16* OG1() const { return (bf16*)(ws + (WS_R2 + 16 * MiB)); }
    DI bf16* OG2() const { return (bf16*)(ws + (WS_WIN)); }
    DI bf16* QKVA() const { return (bf16*)(ws + (WS_R1)); }
    DI bf16* YA() const { return (bf16*)(ws + (WS_R1)); }
    DI bf16* YB() const { return (bf16*)(ws + (WS_R1 + 16 * MiB)); }
    DI bf16* MERGED() const { return (bf16*)(ws + (WS_R1 + 96 * MiB)); }
    DI bf16* H() const { return (bf16*)(ws + (WS_R1)); }
    DI bf16* WUP() const { return (bf16*)(ws + (WS_WUP)); }
    DI bf16* WDN() const { return (bf16*)(ws + (WS_WDN)); }
    DI float* BIASK() const { return (float*)(ws + (WS_SMALL + 65536)); }
    DI float* BIASV() const { return (float*)(ws + (WS_SMALL + 81920)); }
    DI float* CS() const { return (float*)(ws + (WS_SMALL + 131072)); }
    DI float* LSE() const { return (float*)(ws + (WS_LSE)); }
    DI float* TMP() const { return (float*)(ws + (WS_R1 + 32 * MiB)); }
    DI bf16* GM() const { return (bf16*)out; }
    DI float* SSP() const { return (float*)(ws + WS_LSE + 1 * MiB); }
    DI bf16* X1B() const { return (bf16*)(ws + WS_QB); }
};

DI float wave_sum(float v) {
#pragma unroll
    for (int o = 1; o < 64; o <<= 1) v += __shfl_xor(v, o);
    return v;
}
DI unsigned f2bf(float f) { unsigned u = __builtin_bit_cast(unsigned, f); return (u + 0x7fffu + ((u >> 16) & 1u)) >> 16; }
DI unsigned pk2(float lo, float hi) { return f2bf(lo) | (f2bf(hi) << 16); }
DI float bf2f(bf16 v) { return __builtin_bit_cast(float, (unsigned)v << 16); }
DI float sigm(float x) { return 1.f / (1.f + __expf(-x)); }
DI f32x16 zero16() { f32x16 z;
#pragma unroll
    for (int i = 0; i < 16; ++i) z[i] = 0.f;
    return z; }

DI void transpose_item(const float* W, int ldw, int col0, int ncols, int k0, bf16* WT, int K, int drow0, LAS float* scr, int lane) {
    const int cl = lane & 31;
#pragma unroll 8
    for (int i = 0; i < 32; ++i) { const int kk = 2 * i + (lane >> 5); scr[kk * 33 + cl] = (cl < ncols) ? W[(size_t)(k0 + kk) * ldw + col0 + cl] : 0.f; }
    LDS_WAIT();
    const int c = lane & 7;
#pragma unroll
    for (int j = 0; j < 4; ++j) { const int n = (lane >> 3) + 8 * j; const LAS float* s = scr + (8 * c) * 33 + n;
        u32x4 o; o.x = pk2(s[0 * 33], s[1 * 33]); o.y = pk2(s[2 * 33], s[3 * 33]); o.z = pk2(s[4 * 33], s[5 * 33]); o.w = pk2(s[6 * 33], s[7 * 33]);
        if (n < ncols) *(u32x4*)(WT + (size_t)(drow0 + n) * K + k0 + 8 * c) = o; }
    LDS_WAIT();
}
DI bool transpose_job(int& item, const float* W, int ldw, int scol0, int ncols, int K, bf16* WT, int drow0, LAS float* scr, int lane) {
    const int nblk = (ncols + 31) >> 5, nitems = (K >> 6) * nblk;
    if (item >= nitems) { item -= nitems; return false; }
    const int kb = item / nblk, nb = item - kb * nblk;
    const int rem = ncols - 32 * nb;
    transpose_item(W, ldw, scol0 + 32 * nb, rem < 32 ? rem : 32, 64 * kb, WT, K, drow0 + 32 * nb, scr, lane);
    return true;
}
DI void transpose_tile256(const float* W, int ldw, int col0, int k0, bf16* WT, int K, int drow0, LAS unsigned char* lds, int tid) {
    const int w = tid >> 6, l = tid & 63;
    LAS float* tile = (LAS float*)lds;
    f32x4 v[8];
#pragma unroll
    for (int i = 0; i < 8; ++i) v[i] = __builtin_nontemporal_load((const f32x4*)(W + (size_t)(k0 + w + 8 * i) * ldw + col0 + 4 * l));
#pragma unroll
    for (int i = 0; i < 8; ++i) *(LAS f32x4*)(tile + (w + 8 * i) * 260 + 4 * l) = v[i];
    __syncthreads();
    const int n = tid & 255;
#pragma unroll
    for (int q = 0; q < 4; ++q) { const int c = (tid >> 8) + 2 * q; const LAS float* sp = tile + (8 * c) * 260 + n;
        u32x4 o; o.x = pk2(sp[0], sp[260]); o.y = pk2(sp[2 * 260], sp[3 * 260]); o.z = pk2(sp[4 * 260], sp[5 * 260]); o.w = pk2(sp[6 * 260], sp[7 * 260]);
        *(u32x4*)(WT + (size_t)(drow0 + n) * K + k0 + 8 * c) = o; }
    __syncthreads();
}
DI bool ttile_job(int& item, const float* W, int ldw, int scol0, int ncols, int K, bf16* WT, int drow0, LAS unsigned char* lds, int tid) {
    const int nblk = ncols >> 8, nitems = (K >> 6) * nblk;
    if (item >= nitems) { item -= nitems; return false; }
    const int kb = item / nblk, nb = item - kb * nblk;
    transpose_tile256(W, ldw, scol0 + 256 * nb, 64 * kb, WT, K, drow0 + 256 * nb, lds, tid);
    return true;
}
DI void rms_row_bf16(const float* xrow, const float* g, bf16* orow, int lane) {
    const f32x4* xr = (const f32x4*)xrow + lane; const f32x4* gr = (const f32x4*)g + lane;
    f32x4 v[4]; float s = 0.f;
#pragma unroll
    for (int j = 0; j < 4; ++j) { v[j] = __builtin_nontemporal_load(xr + 64 * j); s += (v[j].x * v[j].x + v[j].y * v[j].y) + (v[j].z * v[j].z + v[j].w * v[j].w); }
    const float rstd = 1.f / sqrtf(wave_sum(s) * (1.f / DM) + 1e-6f);
    unsigned long long* o8 = (unsigned long long*)orow + lane;
#pragma unroll
    for (int j = 0; j < 4; ++j) { const f32x4 gg = gr[64 * j];
        o8[64 * j] = (unsigned long long)pk2(v[j].x * rstd * gg.x, v[j].y * rstd * gg.y) | ((unsigned long long)pk2(v[j].z * rstd * gg.z, v[j].w * rstd * gg.w) << 32); }
}
DI void rms_row_f32_inplace(float* xrow, const float* g, int lane) {
    f32x4* xr = (f32x4*)xrow + lane; const f32x4* gr = (const f32x4*)g + lane;
    f32x4 v[4]; float s = 0.f;
#pragma unroll
    for (int j = 0; j < 4; ++j) { v[j] = xr[64 * j]; s += (v[j].x * v[j].x + v[j].y * v[j].y) + (v[j].z * v[j].z + v[j].w * v[j].w); }
    const float rstd = 1.f / sqrtf(wave_sum(s) * (1.f / DM) + 1e-6f);
#pragma unroll
    for (int j = 0; j < 4; ++j) xr[64 * j] = v[j] * rstd * gr[64 * j];
}

DI void rms_row_bf16_to_f32(const bf16* xrow, const float* g, float* orow, int lane) {
    const u32x2* xr = (const u32x2*)xrow + lane; const f32x4* gr = (const f32x4*)g + lane;
    f32x4 v[4]; float s = 0.f;
#pragma unroll
    for (int j = 0; j < 4; ++j) { const u32x2 w = __builtin_nontemporal_load(xr + 64 * j); v[j] = (f32x4){pg8::bf_lo(w.x), pg8::bf_hi(w.x), pg8::bf_lo(w.y), pg8::bf_hi(w.y)};
        s += (v[j].x * v[j].x + v[j].y * v[j].y) + (v[j].z * v[j].z + v[j].w * v[j].w); }
    const float rstd = 1.f / sqrtf(wave_sum(s) * (1.f / DM) + 1e-6f);
    f32x4* o4 = (f32x4*)orow + lane;
#pragma unroll
    for (int j = 0; j < 4; ++j) { const f32x4 r = v[j] * rstd * gr[64 * j]; __builtin_nontemporal_store(r, o4 + 64 * j); }
}
DI void rms_row_bf16_to_bf16(const bf16* xrow, const float* g, bf16* orow, int lane) {
    const u32x2* xr = (const u32x2*)xrow + lane; const f32x4* gr = (const f32x4*)g + lane;
    f32x4 v[4]; float s = 0.f;
#pragma unroll
    for (int j = 0; j < 4; ++j) { const u32x2 w = __builtin_nontemporal_load(xr + 64 * j); v[j] = (f32x4){pg8::bf_lo(w.x), pg8::bf_hi(w.x), pg8::bf_lo(w.y), pg8::bf_hi(w.y)};
        s += (v[j].x * v[j].x + v[j].y * v[j].y) + (v[j].z * v[j].z + v[j].w * v[j].w); }
    const float rstd = 1.f / sqrtf(wave_sum(s) * (1.f / DM) + 1e-6f);
    unsigned long long* o8 = (unsigned long long*)orow + lane;
#pragma unroll
    for (int j = 0; j < 4; ++j) { const f32x4 gg = gr[64 * j];
        o8[64 * j] = (unsigned long long)pk2(v[j].x * rstd * gg.x, v[j].y * rstd * gg.y) | ((unsigned long long)pk2(v[j].z * rstd * gg.z, v[j].w * rstd * gg.w) << 32); }
}
DI void p0_prologue(const Frame& F) {
    LAS float* scr = (LAS float*)(F.lds + F.wave * 16384);
    const int gw = F.bid * 8 + F.wave, NGW = F.G * 8;
    constexpr int NTILES = 16 * 23 + 16 * 8 + 8 * 4 + 8 * 4 + 16 * 4 + 32 + 32;
    for (int it = F.bid; it < NTILES; it += F.G) {
        int r = it;
        if (ttile_job(r, F.w_in, 7960, 0, 5888, DM, F.WIN(), 0, F.lds, F.tid)) continue;
        if (ttile_job(r, F.w_in, 7960, 5912, 2048, DM, F.WIN(), 5888, F.lds, F.tid)) continue;
        if (ttile_job(r, F.w_a, 1024, 0, 1024, 512, F.WA(), 0, F.lds, F.tid)) continue;
        if (ttile_job(r, F.w_b, 1024, 0, 1024, 512, F.WB(), 0, F.lds, F.tid)) continue;
        if (ttile_job(r, F.w_out, 1024, 0, 1024, 1024, F.WO(), 0, F.lds, F.tid)) continue;
        if (ttile_job(r, F.w1_k, 256, 0, 256, 2048, F.W1K(), 0, F.lds, F.tid)) continue;
        ttile_job(r, F.w1_v, 256, 0, 256, 2048, F.W1V(), 0, F.lds, F.tid);
    }
    constexpr int NITEMS = 16 + 8 + 8;
    for (int it = gw; it < NITEMS; it += NGW) {
        int r = it;
        if (transpose_job(r, F.w_in, 7960, 5888, 24, DM, F.WIN(), 7936, scr, F.lane)) continue;
        if (transpose_job(r, F.w2_k, 64, 0, 64, 256, F.W2K(), 0, scr, F.lane)) continue;
        transpose_job(r, F.w2_v, 64, 0, 64, 256, F.W2V(), 0, scr, F.lane);
    }
    __syncthreads();
    const int gt = F.bid * NTHR + F.tid, NGT = F.G * NTHR;
    for (int i = gt; i < 232 * 1024 / 8; i += NGT) *(u32x4*)(F.WIN() + (size_t)7960 * 1024 + (size_t)i * 8) = (u32x4){0u, 0u, 0u, 0u};
    for (int i = gt; i < SEQ * 8; i += NGT) {
        const int s = i >> 3, k = i & 7;
        const double inv[8] = {1.0, 0.19392274474868576, 0.03760603093086393, 0.007292664737217109, 0.001414213562373095, 0.0002742481756762073, 5.318295896944988e-05, 1.031338537721246e-05};
        double iv = inv[0];
#pragma unroll
        for (int q = 1; q < 8; ++q) iv = (k == q) ? inv[q] : iv;
        const double rev = (double)s * iv * 0.15915494309189535;
        const float fr = (float)(rev - __builtin_rint(rev));
        F.CS()[s * 16 + k] = __builtin_amdgcn_cosf(fr); F.CS()[s * 16 + 8 + k] = __builtin_amdgcn_sinf(fr);
    }
    for (int m = gw; m < TOK; m += NGW) rms_row_bf16(F.x + (size_t)m * DM, F.g_mix, F.U() + (size_t)m * DM, F.lane);
    if (F.bid < 32) {
        const int mat = F.bid >> 4, part = F.bid & 15, col = F.tid & 255, kh = F.tid >> 8;
        const float* pe = mat ? F.pos_v : F.pos_k; const float* W1 = mat ? F.w1_v : F.w1_k; float acc = 0.f;
        const int kb = part * 128 + kh * 64;
#pragma unroll 8
        for (int k = 0; k < 64; ++k) acc += pe[kb + k] * W1[(size_t)(kb + k) * 256 + col];
        LAS float* red = (LAS float*)F.lds;
        __syncthreads();
        if (kh) red[col] = acc;
        __syncthreads();
        if (!kh) (mat ? F.BIASV() : F.BIASK())[part * 256 + col] = acc + red[col];
        __syncthreads();
    }
    if (F.bid == 2) { const int kv = F.tid >> 8, bg = (F.tid >> 6) & 3, d = F.tid & 63; (kv ? F.VC() : F.KC())[((bg * 512 + 511) << 6) + d] = 0; }
}

struct Stg { u32x4 k, v; };
DI void stage_load(Stg& s, const bf16* Kg, const bf16* Vg, int row0, int tid) {
    s.k = *(const u32x4*)(Kg + ((size_t)row0 << 6) + tid * 8); s.v = *(const u32x4*)(Vg + ((size_t)row0 << 6) + tid * 8);
}
DI void stage_store(const Stg& s, LAS unsigned char* lds, int buf, int tid) {
    *(LAS u32x4*)(lds + buf * BUFB + (tid >> 3) * KVROW + (tid & 7) * 16) = s.k; *(LAS u32x4*)(lds + buf * BUFB + KVT + (tid >> 3) * VROW + (tid & 7) * 16) = s.v;
}
DI unsigned pkbf(float a, float b) {
    typedef __bf16 bf2 __attribute__((ext_vector_type(2))); typedef float f2 __attribute__((ext_vector_type(2)));
    f2 v = {a, b}; bf2 r = __builtin_convertvector(v, bf2); return __builtin_bit_cast(unsigned, r);
}
DI void qk_tile(LAS const unsigned char* kt, const bf16x8 (&qf)[4], f32x16 (&s)[2], int lane) {
    const int r = lane & 31, h = lane >> 5;
    const int sr = (r & 19) | ((r & 4) << 1) | ((r & 8) >> 1);
    LAS const unsigned char* kp = kt + sr * KVROW + h * 16;
    bf16x8 ka[8];
#pragma unroll
    for (int kh = 0; kh < 2; ++kh)
#pragma unroll
        for (int ks = 0; ks < 4; ++ks) ka[kh * 4 + ks] = *(LAS const bf16x8*)(kp + kh * 32 * KVROW + ks * 32);
    s[0] = zero16(); s[1] = zero16();
    __builtin_amdgcn_s_setprio(1);
#pragma unroll
    for (int ks = 0; ks < 4; ++ks) { s[0] = MFMA32(ka[ks], qf[ks], s[0]); s[1] = MFMA32(ka[4 + ks], qf[ks], s[1]); }
    __builtin_amdgcn_s_setprio(0);
}
DI float xhalf_max(float v) { auto rr = __builtin_amdgcn_permlane32_swap(__float_as_uint(v), __float_as_uint(v), false, false); return fmaxf(__uint_as_float(rr[0]), __uint_as_float(rr[1])); }
DI float xhalf_sum(float v) { auto rr = __builtin_amdgcn_permlane32_swap(__float_as_uint(v), __float_as_uint(v), false, false); return __uint_as_float(rr[0]) + __uint_as_float(rr[1]); }
typedef float f32x2 __attribute__((ext_vector_type(2)));
#define OPQ(x) asm("" : "+v"(x))
DI void flash_tile(LAS const unsigned char* kt, LAS const unsigned char* vt, const bf16x8 (&qf)[4], f32x16 (&o)[2], float& m, float& l, int dq, unsigned maxoff, bool sel, int lane) {
    const int h = lane >> 5;
    f32x16 s[2];
    qk_tile(kt, qf, s, lane);
    bf16x8 vf[2][2][2];
    {
        const int q4 = (lane & 15) >> 2, p4 = lane & 3, blk = (lane >> 4) & 1;
        LAS const unsigned char* vb = vt + (8 * h + q4) * VROW + 8 * (4 * blk + p4);
#pragma unroll
        for (int kh = 0; kh < 2; ++kh)
#pragma unroll
            for (int s2 = 0; s2 < 2; ++s2)
#pragma unroll
                for (int db = 0; db < 2; ++db) {
                    LAS const unsigned char* vp = vb + (32 * kh + 16 * s2) * VROW + db * 64;
                    const s16x4 lo = __builtin_amdgcn_ds_read_tr16_b64_v4i16((LAS s16x4*)(vp));
                    const s16x4 hi = __builtin_amdgcn_ds_read_tr16_b64_v4i16((LAS s16x4*)(vp + 4 * VROW));
                    vf[kh][s2][db] = __builtin_shufflevector(lo, hi, 0, 1, 2, 3, 4, 5, 6, 7);
                }
    }
    const bool lane_full = (dq >= 55) && ((unsigned)dq <= maxoff);
    if (__ballot(!lane_full) != 0ull) {
#pragma unroll
        for (int kh = 0; kh < 2; ++kh)
#pragma unroll
            for (int i = 0; i < 16; ++i) { const int kk = 32 * kh + 16 * (i >> 3) + (i & 7); s[kh][i] = ((unsigned)(dq - kk) <= maxoff) ? s[kh][i] : -1e30f; }
    }
    asm volatile("s_nop 15\n\ts_nop 15" : "+v"(s[0]), "+v"(s[1]));
#define MAX3(d, a, b, c) asm("v_max3_f32 %0, %1, %2, %3" : "=v"(d) : "v"(a), "v"(b), "v"(c))
    float ma[10], mc2[4], mx;
#pragma unroll
    for (int i = 0; i < 5; ++i) { MAX3(ma[i], s[0][3 * i], s[0][3 * i + 1], s[0][3 * i + 2]); MAX3(ma[5 + i], s[1][3 * i], s[1][3 * i + 1], s[1][3 * i + 2]); }
    MAX3(mc2[0], ma[0], ma[1], ma[2]); MAX3(mc2[1], ma[3], ma[4], ma[5]); MAX3(mc2[2], ma[6], ma[7], ma[8]); MAX3(mc2[3], ma[9], s[0][15], s[1][15]);
    { float t0, t1; MAX3(t0, mc2[0], mc2[1], mc2[2]); MAX3(t1, mc2[3], t0, t0); mx = t1; }
#undef MAX3
    mx = xhalf_max(mx);
    mx = sel ? mx : -1e30f;
    const bool need = mx > m + 40.f;
    if (__ballot(need) != 0ull) {
        const float mn = need ? mx : m;
        const float alpha = need ? __builtin_amdgcn_exp2f((m - mn) * SC_LOG2E) : 1.f;
        m = mn; l *= alpha;
#pragma unroll
        for (int i = 0; i < 16; ++i) { float a = o[0][i] * alpha, b = o[1][i] * alpha; OPQ(a); OPQ(b); o[0][i] = a; o[1][i] = b; }
    }
    const float nmb = sel ? -fmaxf(m, -1e20f) * SC_LOG2E : -1e30f;
    float pa[4] = {0.f, 0.f, 0.f, 0.f};
#pragma unroll
    for (int kh = 0; kh < 2; ++kh)
#pragma unroll
        for (int i = 0; i < 16; ++i) {
            float x = __builtin_fmaf(s[kh][i], SC_LOG2E, nmb); OPQ(x);
            const float p = __builtin_amdgcn_exp2f(x);
            float a = pa[i & 3] + p; OPQ(a); pa[i & 3] = a;
            s[kh][i] = p; }
    l += (pa[0] + pa[1]) + (pa[2] + pa[3]);
#pragma unroll
    for (int kh = 0; kh < 2; ++kh)
#pragma unroll
        for (int s2 = 0; s2 < 2; ++s2) {
            u32x4 pw; pw.x = pkbf(s[kh][8 * s2 + 0], s[kh][8 * s2 + 1]); pw.y = pkbf(s[kh][8 * s2 + 2], s[kh][8 * s2 + 3]);
            pw.z = pkbf(s[kh][8 * s2 + 4], s[kh][8 * s2 + 5]); pw.w = pkbf(s[kh][8 * s2 + 6], s[kh][8 * s2 + 7]);
            const bf16x8 pf = __builtin_bit_cast(bf16x8, pw);
            o[0] = MFMA32(vf[kh][s2][0], pf, o[0]); o[1] = MFMA32(vf[kh][s2][1], pf, o[1]);
        }
}
#define TILE_LOOP(T0, T1, ROWOF, KPTR, VPTR, BODY) do { \
    Stg sA_, sB_; const int t1_ = (T1); int t_ = (T0); \
    if (t_ < t1_) stage_load(sA_, KPTR, VPTR, ROWOF(t_), tid); \
    if (t_ + 1 < t1_) stage_load(sB_, KPTR, VPTR, ROWOF(t_ + 1), tid); \
    for (; t_ < t1_; t_ += 2) { \
        { const int ct = t_; const int buf = 0; stage_store(sA_, F.lds, 0, tid); __syncthreads(); if (ct + 2 < t1_) stage_load(sA_, KPTR, VPTR, ROWOF(ct + 2), tid); BODY } \
        if (t_ + 1 < t1_) { const int ct = t_ + 1; const int buf = 1; stage_store(sB_, F.lds, 1, tid); __syncthreads(); if (ct + 2 < t1_) stage_load(sB_, KPTR, VPTR, ROWOF(ct + 2), tid); BODY } \
    } \
    __syncthreads(); } while (0)
DI void write_o_row(bf16* dst, const f32x16 (&o)[2], float scale, int h) {
#pragma unroll
    for (int db = 0; db < 2; ++db)
#pragma unroll
        for (int i4 = 0; i4 < 4; ++i4) {
            u32x2 w; w.x = pkbf(o[db][4 * i4] * scale, o[db][4 * i4 + 1] * scale); w.y = pkbf(o[db][4 * i4 + 2] * scale, o[db][4 * i4 + 3] * scale);
            *(u32x2*)(dst + 32 * db + 8 * i4 + 4 * h) = w;
        }
}

DI void mixa_task(const Frame& F, int task) {
    const int tile32 = task & 31, hb = task >> 5, b = hb & 1, head = hb >> 1;
    const int g = head >> 3, slot = head & 7, lg = 2 * g;
    const int prow0 = tile32 * 256, L = SEQ >> lg, res = prow0 >> (13 - lg), p0 = prow0 & (L - 1);
    const bf16* Q = F.QKVA() + ((size_t)((head) * 2 + b) << 19);
    const bf16* K = F.QKVA() + ((size_t)((24 + head) * 2 + b) << 19);
    const bf16* V = F.QKVA() + ((size_t)((48 + head) * 2 + b) << 19);
    const int w = F.wave, lane = F.lane, r = lane & 31, h = lane >> 5;
    bf16x8 qf[4];
    { const bf16* qr = Q + ((size_t)(prow0 + 32 * w + r) << 6) + 8 * h;
#pragma unroll
      for (int ks = 0; ks < 4; ++ks) qf[ks] = *(const bf16x8*)(qr + 16 * ks); }
    f32x16 o[2] = {zero16(), zero16()}; float m = -1e30f, l = 0.f;
    const int kt0 = (p0 == 0) ? 2 : 0;
    const int tid = F.tid;
#define ROWOF_A(kt) (prow0 - 128 + 64 * (kt))
    TILE_LOOP(kt0, 6, ROWOF_A, K, V, {
        if (ct >= (w >> 1) && ct <= (w >> 1) + 2)
            flash_tile(F.lds + buf * BUFB, F.lds + buf * BUFB + KVT, qf, o, m, l, 128 + 32 * w + r - 64 * ct - 8 * h, 128u, true, lane);
    });
#undef ROWOF_A
    const float lt = xhalf_sum(l);
    const float inv = 1.f / lt;
    const int s = ((p0 + 32 * w + r) << lg) | res;
    const size_t row = (size_t)b * SEQ + s;
    bf16* og = (bf16*)(F.ws + ((g == 0) ? WS_R2 : (g == 1) ? (WS_R2 + 16 * MiB) : WS_WIN));
    write_o_row(og + row * 512 + slot * 64, o, inv, h);
    if (h == 0) F.LSE()[((size_t)g * TOK + row) * 8 + slot] = m * 0.125f + __logf(lt);
}

DI float gelu_tanh(float x) { const float u = 0.7978845608028654f * (x + 0.044715f * x * x * x); const float e = __expf(2.f * u); const float t = 1.f - 2.f / (e + 1.f); return 0.5f * x * (1.f + t); }
DI void compress_task(const Frame& F, int task) {
    const int kv = task >> 5, bg = (task >> 3) & 3, it = task & 7;
    const bf16* A = F.KVB() + ((size_t)(kv * 4 + bg) << 19);
    const bf16* W1T = kv ? F.W1V() : F.W1K(); const bf16* W2T = kv ? F.W2V() : F.W2K(); const float* bias = kv ? F.BIASV() : F.BIASK();
    bf16* OUT = (kv ? F.VC() : F.KC()) + ((size_t)bg << 15);
    const int w = F.wave, lane = F.lane, r = lane & 31, h = lane >> 5;
    LAS unsigned char* hid = F.lds;
    f32x16 acc[2] = {zero16(), zero16()};
    int i0 = 64 * it + r, i1 = i0 + 32; i0 = i0 > 510 ? 510 : i0; i1 = i1 > 510 ? 510 : i1;
    const bf16* a0p = A + (size_t)i0 * 1024 + 8 * h; const bf16* a1p = A + (size_t)i1 * 1024 + 8 * h;
    const bf16* bp = W1T + (size_t)(32 * w + r) * 2048 + 8 * h;
#pragma unroll 4
    for (int k0 = 0; k0 < 2048; k0 += 16) {
        const bf16x8 bfr = *(const bf16x8*)(bp + k0), a0 = *(const bf16x8*)(a0p + k0), a1 = *(const bf16x8*)(a1p + k0);
        acc[0] = MFMA32(a0, bfr, acc[0]); acc[1] = MFMA32(a1, bfr, acc[1]);
    }
    float bs = 0.f;
#pragma unroll
    for (int j = 0; j < 16; ++j) bs += bias[j * 256 + 32 * w + r];
#pragma unroll
    for (int rb = 0; rb < 2; ++rb)
#pragma unroll
        for (int i = 0; i < 16; ++i) { const int row = 32 * rb + (i & 3) + 8 * (i >> 2) + 4 * h;
            *(LAS bf16*)(hid + row * 528 + (32 * w + r) * 2) = (bf16)f2bf(gelu_tanh(acc[rb][i] + bs)); }
    __syncthreads();
    if (w < 4) {
        const int rb = w & 1, cb = w >> 1; f32x16 c = zero16();
        const bf16* b2 = W2T + (size_t)(32 * cb + r) * 256 + 8 * h;
#pragma unroll
        for (int k0 = 0; k0 < 256; k0 += 16) { const bf16x8 a = *(LAS const bf16x8*)(hid + (32 * rb + r) * 528 + (k0 + 8 * h) * 2); const bf16x8 bb = *(const bf16x8*)(b2 + k0); c = MFMA32(a, bb, c); }
#pragma unroll
        for (int i = 0; i < 16; ++i) { const int row = 64 * it + 32 * rb + (i & 3) + 8 * (i >> 2) + 4 * h;
            if (row < 511) OUT[((size_t)row << 6) + 32 * cb + r] = (bf16)f2bf(c[i]); }
    }
    __syncthreads();
}

DI float dpp_quad_sum(float p) {
    p += __builtin_bit_cast(float, __builtin_amdgcn_update_dpp(0, __builtin_bit_cast(int, p), 0xB1, 0xF, 0xF, true));
    p += __builtin_bit_cast(float, __builtin_amdgcn_update_dpp(0, __builtin_bit_cast(int, p), 0x4E, 0xF, 0xF, true));
    return p;
}
DI void imp_tile(LAS const unsigned char* kt, const bf16x8 (&qf)[4], LAS float* ipb, int dq, float mb, float invc, int lane) {
    f32x16 s[2];
    qk_tile(kt, qf, s, lane);
#pragma unroll
    for (int kh = 0; kh < 2; ++kh)
#pragma unroll
        for (int s2 = 0; s2 < 2; ++s2) {
            float ps[8];
#pragma unroll
            for (int j = 0; j < 8; ++j) { const int kk = 32 * kh + 16 * s2 + j; const bool v = (dq - kk) >= 0;
                const float p = v ? __builtin_amdgcn_exp2f(s[kh][8 * s2 + j] * SC_LOG2E - mb) * invc : 0.f; ps[j] = dpp_quad_sum(p); }
            const float sa = (ps[0] + ps[1]) + (ps[2] + ps[3]), sb = (ps[4] + ps[5]) + (ps[6] + ps[7]);
            LAS float* ip = ipb + 8 * kh + 4 * s2;
            if ((lane & 3) == 0) {
                __hip_atomic_fetch_add(ip, sa, __ATOMIC_RELAXED, __HIP_MEMORY_SCOPE_WORKGROUP);
                __hip_atomic_fetch_add(ip + 1, sb + ps[3], __ATOMIC_RELAXED, __HIP_MEMORY_SCOPE_WORKGROUP);
                __hip_atomic_fetch_add(ip + 2, ps[7], __ATOMIC_RELAXED, __HIP_MEMORY_SCOPE_WORKGROUP);
            }
        }
}
DI unsigned wave_umax(unsigned v) {
#define WUM_STEP(ctrl) { const unsigned t = (unsigned)__builtin_amdgcn_update_dpp((int)v, (int)v, (ctrl), 0xF, 0xF, false); v = v > t ? v : t; }
    WUM_STEP(0xB1) WUM_STEP(0x4E) WUM_STEP(0x141) WUM_STEP(0x140)
#undef WUM_STEP
    const unsigned r0 = (unsigned)__builtin_amdgcn_readlane((int)v, 0), r1 = (unsigned)__builtin_amdgcn_readlane((int)v, 16), r2 = (unsigned)__builtin_amdgcn_readlane((int)v, 32), r3 = (unsigned)__builtin_amdgcn_readlane((int)v, 48);
    const unsigned a = r0 > r1 ? r0 : r1, b = r2 > r3 ? r2 : r3;
    return a > b ? a : b;
}
DI void stash_put(LAS f32x4* st, const f32x16 (&y)[2], int tid) {
#pragma unroll
    for (int i = 0; i < 8; ++i) { const f32x16& v = y[i >> 2]; const int q = (i & 3) * 4; st[i * 512 + tid] = (f32x4){v[q], v[q + 1], v[q + 2], v[q + 3]}; }
}
DI void stash_add(LAS const f32x4* st, f32x16 (&y)[2], int tid) {
#pragma unroll
    for (int i = 0; i < 8; ++i) { const f32x4 a = st[i * 512 + tid]; const int q = (i & 3) * 4; f32x16& v = y[i >> 2]; v[q] += a[0]; v[q + 1] += a[1]; v[q + 2] += a[2]; v[q + 3] += a[3]; }
}
DI void nsa_task(const Frame& F, int b, int g, int tt) {
    const int w = F.wave, lane = F.lane, r = lane & 31, h = lane >> 5, tid = F.tid;
    const int t0 = tt * 64, tok = 8 * w + (r >> 2), t = t0 + tok, head = 4 * g + (r & 3);
    const size_t row = (size_t)b * SEQ + t;
    const int bg = b * 2 + g;
    bf16x8 qf[4];
    { const bf16* qr = F.QB() + row * 512 + head * 64 + 8 * h;
#pragma unroll
      for (int ks = 0; ks < 4; ++ks) qf[ks] = *(const bf16x8*)(qr + 16 * ks); }
    float g0, g1, g2;
    { const bf16* gp = F.GB() + row * 32 + head * 3; g0 = sigm(bf2f(gp[0])); g1 = sigm(bf2f(gp[1])); g2 = sigm(bf2f(gp[2])); }
    LAS float* imp = (LAS float*)(F.lds + 2 * BUFB);
    for (int i = tid; i < 64 * 132; i += NTHR) imp[i] = 0.f;
    LAS f32x4* ystash = (LAS f32x4*)(F.lds + 2 * BUFB + 64 * 132 * 4);
    const int nvis = (4 * tt + 3) < 511 ? (4 * tt + 3) : 511, nct = (NSA_SKIP == 3) ? 1 : (nvis + 63) >> 6;
    const bf16* Kc = F.KC() + ((size_t)bg << 15); const bf16* Vc = F.VC() + ((size_t)bg << 15);
    const int lim = (t - 31) >> 4;
    float mc, invc;
    {
        f32x16 o[2] = {zero16(), zero16()}; float m = -1e30f, l = 0.f;
#define ROWOF_T(ct_) (64 * (ct_))
        TILE_LOOP(0, nct, ROWOF_T, Kc, Vc, {
            flash_tile(F.lds + buf * BUFB, F.lds + buf * BUFB + KVT, qf, o, m, l, lim - 64 * ct - 8 * h, 0x7fffffffu, true, lane);
        });
        const float lt = xhalf_sum(l);
        invc = lt > 0.f ? 1.f / lt : 0.f; mc = m;
        o[0] *= (g0 * invc); o[1] *= (g0 * invc); stash_put(ystash, o, tid);
    }
    {
        const float mb = mc * SC_LOG2E;
        TILE_LOOP(0, nct, ROWOF_T, Kc, Vc, { imp_tile(F.lds + buf * BUFB, qf, imp + tok * 132 + 16 * ct + 2 * h, lim - 64 * ct - 8 * h, mb, invc, lane); });
        LDS_WAIT();
        __syncthreads();
    }
    unsigned long long mlo = 0ull, mhi = 0ull;
    if (tt <= 15 || NSA_SKIP == 3) { mlo = (2ull << (tt & 63)) - 1ull; mhi = mlo; }
    else {
        for (int tk = 0; tk < 8; ++tk) {
            LAS const float* rowp = imp + (8 * w + tk) * 132;
            const int ma = lane, mb2 = lane + 64;
            const bool ca = (ma >= 1 && ma <= tt - 2), cb = (mb2 <= tt - 2);
            unsigned ka = ca ? __float_as_uint(rowp[ma]) + 1u : 0u, kb = cb ? __float_as_uint(rowp[mb2]) + 1u : 0u;
            bool sa = false, sb = false;
            for (int it = 0; it < 13; ++it) {
                const unsigned mxk = wave_umax(ka > kb ? ka : kb);
                const unsigned long long ea = __ballot(ka == mxk);
                if (ea != 0ull) { if (lane == (int)__builtin_ctzll(ea)) { sa = true; ka = 0u; } }
                else { const unsigned long long eb = __ballot(kb == mxk); if (lane == (int)__builtin_ctzll(eb)) { sb = true; kb = 0u; } }
            }
            unsigned long long ba = __ballot(sa), bb = __ballot(sb);
            ba |= 1ull;
            if (tt < 64) ba |= 1ull << tt; else bb |= 1ull << (tt - 64);
            if (tt - 1 < 64) ba |= 1ull << (tt - 1); else bb |= 1ull << (tt - 1 - 64);
            if ((r >> 2) == tk) { mlo = ba; mhi = bb; }
        }
    }
    {
        const bf16* Ks = F.KVB() + ((size_t)(2 * 4 + bg) << 19); const bf16* Vs = F.KVB() + ((size_t)(3 * 4 + bg) << 19);
        f32x16 o[2] = {zero16(), zero16()}; float m = -1e30f, l = 0.f;
        TILE_LOOP(0, (NSA_SKIP == 1) ? 1 : tt + 1, ROWOF_T, Ks, Vs, {
            const bool sel = ((ct < 64 ? (mlo >> ct) : (mhi >> (ct - 64))) & 1ull) != 0ull;
            if (__ballot(sel) != 0ull)
                flash_tile(F.lds + buf * BUFB, F.lds + buf * BUFB + KVT, qf, o, m, l, t - 64 * ct - 8 * h, 0x7fffffffu, sel, lane);
        });
        const float lt = xhalf_sum(l); const float sc = g1 / lt;
        o[0] *= sc; o[1] *= sc; stash_add(ystash, o, tid); stash_put(ystash, o, tid);
    }
    {
        const bf16* Kw = F.KVB() + ((size_t)(4 * 4 + bg) << 19); const bf16* Vw = F.KVB() + ((size_t)(5 * 4 + bg) << 19);
        f32x16 o[2] = {zero16(), zero16()}; float m = -1e30f, l = 0.f;
        const int c0 = tt > 8 ? tt - 8 : 0;
        TILE_LOOP((NSA_SKIP == 2) ? tt : c0, tt + 1, ROWOF_T, Kw, Vw, {
            flash_tile(F.lds + buf * BUFB, F.lds + buf * BUFB + KVT, qf, o, m, l, t - 64 * ct - 8 * h, 511u, true, lane);
        });
#undef ROWOF_T
        const float lt = xhalf_sum(l); const float sc = g2 / lt;
        o[0] *= sc; o[1] *= sc; stash_add(ystash, o, tid);
        write_o_row(F.YB() + row * 512 + head * 64, o, 1.f, h);
    }
}

DI void combine_ya_task(const Frame& F, int task) {
    for (int i = task * 4096 + F.tid; i < (task + 1) * 4096; i += NTHR) {
        const int row = i >> 6, ch = i & 63, slot = ch >> 3;
        const float l0 = F.LSE()[((size_t)0 * TOK + row) * 8 + slot], l1 = F.LSE()[((size_t)1 * TOK + row) * 8 + slot], l2 = F.LSE()[((size_t)2 * TOK + row) * 8 + slot];
        const float mx = fmaxf(l0, fmaxf(l1, l2)); float w0 = __expf(l0 - mx), w1 = __expf(l1 - mx), w2 = __expf(l2 - mx);
        const float inv = 1.f / (w0 + w1 + w2); w0 *= inv; w1 *= inv; w2 *= inv;
        const size_t off = (size_t)row * 512 + ch * 8;
        const u32x4 a = __builtin_nontemporal_load((const u32x4*)(F.OG0() + off)), bb = __builtin_nontemporal_load((const u32x4*)(F.OG1() + off)), c = __builtin_nontemporal_load((const u32x4*)(F.OG2() + off));
        u32x4 o;
#pragma unroll
        for (int e = 0; e < 4; ++e) {
            const float lo = w0 * pg8::bf_lo(a[e]) + w1 * pg8::bf_lo(bb[e]) + w2 * pg8::bf_lo(c[e]);
            const float hi = w0 * pg8::bf_hi(a[e]) + w1 * pg8::bf_hi(bb[e]) + w2 * pg8::bf_hi(c[e]);
            o[e] = pk2(lo, hi);
        }
        *(u32x4*)(F.YA() + off) = o;
    }
}

#define XB_TMO      128
#define XB_XCNT(j)  (256  + 64 * (j))
#define XB_XSUB(j)  (1280 + 64 * (j))
#define XB_XGEN(j)  (2304 + 64 * (j))
#define XB_TOP      3328
#define XB_TOPGEN   3392
#define XCD_BAR_WORDS 3456
#define XB_SPIN_CAP (1u << 18)

__device__ __forceinline__ unsigned xb_ld(unsigned* p)              { return __hip_atomic_load(p, __ATOMIC_RELAXED, __HIP_MEMORY_SCOPE_AGENT); }
__device__ __forceinline__ unsigned xb_add(unsigned* p, unsigned v) { return __hip_atomic_fetch_add(p, v, __ATOMIC_RELAXED, __HIP_MEMORY_SCOPE_AGENT); }
__device__ __forceinline__ unsigned xb_xcc_id() { return (unsigned)__builtin_amdgcn_s_getreg((3 << 11) | 20) & 0xFu; }
#define XB_SPIN(cond, bar) do { unsigned _sp = 0; while (cond) { __builtin_amdgcn_s_sleep(1); \
    if ((++_sp & 255u) == 0u) { if (xb_ld(&(bar)[XB_TMO])) break; if (_sp > XB_SPIN_CAP) { atomicAdd(&(bar)[XB_TMO], 1u); break; } } } } while (0)
struct XcdBarrier {
    unsigned* bar; unsigned x;
    volatile LAS unsigned* st;
};

__device__ __forceinline__ XcdBarrier xcd_barrier_post(unsigned* bar, volatile LAS unsigned* st) {
    XcdBarrier b; b.bar = bar; b.x = xb_xcc_id(); b.st = st;
    if (threadIdx.x == 0) (void)xb_add(&bar[XB_XCNT(b.x)], 1u);
    return b;
}
__device__ __forceinline__ void xcd_barrier_complete(unsigned* bar, unsigned x, unsigned& nloc, unsigned& nx) {
    const unsigned G = gridDim.x * gridDim.y * gridDim.z;
    unsigned sum, cnt, mine, sp = 0u;
    for (;;) {
        sum = 0u; cnt = 0u; mine = 0u;
#pragma unroll
        for (unsigned j = 0; j < 16; ++j) { const unsigned c = xb_ld(&bar[XB_XCNT(j)]); sum += c; cnt += (c > 0u) ? 1u : 0u; mine = (j == x) ? c : mine; }
        if (sum == G) break;
        __builtin_amdgcn_s_sleep(1);
        if ((++sp & 255u) == 0u) { if (xb_ld(&bar[XB_TMO])) break; if (sp > XB_SPIN_CAP) { atomicAdd(&bar[XB_TMO], 1u); break; } }
    }
    nloc = mine > 0u ? mine : 1u; nx = cnt > 0u ? cnt : 1u;
}

__device__ __forceinline__ void xcd_barrier(const XcdBarrier& b) {
    asm volatile("s_waitcnt vmcnt(0)" ::: "memory");
    __syncthreads();
    if (threadIdx.x == 0) {
        unsigned* bar = b.bar;
        __builtin_amdgcn_s_waitcnt(0);
        unsigned nloc = b.st[0], nx = b.st[1];
        if (nloc == 0u) { xcd_barrier_complete(bar, b.x, nloc, nx); b.st[0] = nloc; b.st[1] = nx; }
        const unsigned old = xb_add(&bar[XB_XSUB(b.x)], 1u);
        const unsigned gen = old / nloc;
        if (old + 1u == (gen + 1u) * nloc) {
            __builtin_amdgcn_fence(__ATOMIC_RELEASE, "agent");
            asm volatile("s_waitcnt vmcnt(0)" ::: "memory");
            const unsigned og = xb_add(&bar[XB_TOP], 1u);
            const unsigned tg = og / nx;
            if (og + 1u == (tg + 1u) * nx) xb_add(&bar[XB_TOPGEN], 1u);
            else XB_SPIN(xb_ld(&bar[XB_TOPGEN]) == tg, bar);
            __builtin_amdgcn_fence(__ATOMIC_ACQUIRE, "agent");
            xb_add(&bar[XB_XGEN(b.x)], 1u);
            asm volatile("s_waitcnt vmcnt(0)" ::: "memory");
        } else {
            XB_SPIN(xb_ld(&bar[XB_XGEN(b.x)]) == gen, bar);
            __builtin_amdgcn_fence(__ATOMIC_ACQUIRE, "agent");
            asm volatile("s_waitcnt vmcnt(0)" ::: "memory");
        }
    }
    __syncthreads();
}

#ifndef PH_MAX
#define PH_MAX 99
#endif
#ifndef P3_TTILES
#define P3_TTILES 512
#endif
#ifndef PROBE_PH
#define PROBE_PH 0
#endif
#ifndef REPEAT_PH
#define REPEAT_PH 0
#endif
#define REP(k) for (int rep_ = 0; rep_ < ((REPEAT_PH == (k)) ? 2 : 1); ++rep_)
__global__ void __launch_bounds__(NTHR) fwd_mega(Args args) {
    extern __shared__ __attribute__((aligned(16))) unsigned char lds_raw[];
    cg::grid_group grid = cg::this_grid();
    Frame F;
    F.lds = (LAS unsigned char*)lds_raw; F.tid = threadIdx.x; F.lane = F.tid & 63; F.wave = __builtin_amdgcn_readfirstlane(F.tid >> 6); F.G = gridDim.x; F.bid = blockIdx.x;
    F.x = args.in[0]; F.g_mix = args.in[1]; F.w_in = args.in[2]; F.pos_k = args.in[3]; F.w1_k = args.in[4]; F.w2_k = args.in[5]; F.pos_v = args.in[6]; F.w1_v = args.in[7]; F.w2_v = args.in[8];
    F.w_a = args.in[9]; F.w_b = args.in[10]; F.w_out = args.in[11]; F.g_mlp = args.in[12]; F.w_up = args.in[13]; F.w_down = args.in[14]; F.g_fin = args.in[15];
    F.out = args.out; F.ws = args.ws;
    unsigned char* ws = args.ws;
    PG8_LAS unsigned char* glds = (PG8_LAS unsigned char*)lds_raw;
    volatile LAS unsigned* xst = (volatile LAS unsigned*)(F.lds + LDS_BYTES - 16);
    if (F.tid < 4) xst[F.tid] = 0u;
    __syncthreads();
    XcdBarrier xbar = xcd_barrier_post((unsigned*)ws, xst);
    if (args.ws == nullptr) grid.sync();
    const int gw = F.bid * 8 + F.wave, NGW = F.G * 8;

#if PROBE_PH
    unsigned long long stamp_[16]; int ns_ = 1; stamp_[0] = __builtin_amdgcn_s_memrealtime();
#endif
    REP(9) p0_prologue(F);
#if REPEAT_PH == 10
    for (int q_ = 0; q_ < 10; ++q_) grid.sync();
#endif
    xcd_barrier(xbar);
#if PROBE_PH
    stamp_[ns_ < 15 ? ns_ : 15] = __builtin_amdgcn_s_memrealtime(); ++ns_;
#endif
    asm volatile("" : "+v"(F.tid), "+v"(F.lane));
    if (PH_MAX >= 1) REP(1) {
        pg8::Gemm gm{F.U(), F.WIN(), TOK, NIN, DM}; pg8::StaticOrder S; S.init(TOK, NIN, F.G, F.bid);
        pg8::EpiInProj E{F.QKVA(), F.QB(), F.KVB(), F.GM(), F.GB(), F.CS()};
        pg8::gemm_phase<pg8::EpiInProj, pg8::StaticOrder, true, true>(glds, gm, S, E);
    }
    xcd_barrier(xbar);
#if PROBE_PH
    stamp_[ns_ < 15 ? ns_ : 15] = __builtin_amdgcn_s_memrealtime(); ++ns_;
#endif
    asm volatile("" : "+v"(F.tid), "+v"(F.lane));
    if (PH_MAX >= 2) REP(2) {
        unsigned* qctr = (unsigned*)ws + 3520 + 64 * rep_;
        volatile LAS int* qslot = (volatile LAS int*)(F.lds + LDS_BYTES - 8);
        for (;;) {
            if (F.tid == 0) *qslot = (int)__hip_atomic_fetch_add(qctr, 1u, __ATOMIC_RELAXED, __HIP_MEMORY_SCOPE_AGENT);
            __syncthreads();
            const int task = *qslot;
            __syncthreads();
            if (task >= 1600) break;
            if (task < 64) compress_task(F, task); else mixa_task(F, task - 64);
        }
    }
    xcd_barrier(xbar);
#if PROBE_PH
    stamp_[ns_ < 15 ? ns_ : 15] = __builtin_amdgcn_s_memrealtime(); ++ns_;
#endif
    asm volatile("" : "+v"(F.tid), "+v"(F.lane));
    if (PH_MAX >= 3) REP(3) {
        unsigned* qctr = (unsigned*)ws + 3520 + 128 + 64 * rep_;
        volatile LAS int* qslot = (volatile LAS int*)(F.lds + LDS_BYTES - 8);
        for (;;) {
            if (F.tid == 0) *qslot = (int)__hip_atomic_fetch_add(qctr, 1u, __ATOMIC_RELAXED, __HIP_MEMORY_SCOPE_AGENT);
            __syncthreads();
            const int task = *qslot;
            __syncthreads();
            if (task >= 512 + 256 + P3_TTILES) break;
            if (task < 512) { const int bg = task & 3; nsa_task(F, bg >> 1, bg & 1, 127 - (task >> 2)); }
            else if (task < 768) combine_ya_task(F, task - 512);
            else { int r = task - 768;
                if (!ttile_job(r, F.w_up, 4096, 0, 4096, DM, F.WUP(), 0, F.lds, F.tid)) ttile_job(r, F.w_down, 1024, 0, 1024, FF, F.WDN(), 0, F.lds, F.tid); }
        }
    }
    xcd_barrier(xbar);
#if PROBE_PH
    stamp_[ns_ < 15 ? ns_ : 15] = __builtin_amdgcn_s_memrealtime(); ++ns_;
#endif
    asm volatile("" : "+v"(F.tid), "+v"(F.lane));
    if (PH_MAX >= 4) REP(4) {
        pg8::StaticOrder S; S.init(TOK, DM, F.G, F.bid);
        { pg8::Gemm gm{F.YA(), F.WA(), TOK, DM, 512}; pg8::EpiMerge<1> E{F.GM(), F.TMP(), F.MERGED()}; pg8::gemm_phase<pg8::EpiMerge<1>, pg8::StaticOrder, true, true>(glds, gm, S, E); }
        { pg8::Gemm gm{F.YB(), F.WB(), TOK, DM, 512}; pg8::EpiMerge<2> E{F.GM(), F.TMP(), F.MERGED()}; pg8::gemm_phase<pg8::EpiMerge<2>, pg8::StaticOrder, true, true>(glds, gm, S, E); }
    }
    xcd_barrier(xbar);
#if PROBE_PH
    stamp_[ns_ < 15 ? ns_ : 15] = __builtin_amdgcn_s_memrealtime(); ++ns_;
#endif
    asm volatile("" : "+v"(F.tid), "+v"(F.lane));
    if (PH_MAX >= 5) REP(5) {
        pg8::StaticOrder S; S.init(TOK, DM, F.G, F.bid);
        pg8::Gemm gm{F.MERGED(), F.WO(), TOK, DM, DM}; pg8::EpiResNormPrep E{F.x, F.X1B(), F.U(), F.g_mlp, F.SSP()}; pg8::gemm_phase<pg8::EpiResNormPrep, pg8::StaticOrder, true, true>(glds, gm, S, E);
    }
    xcd_barrier(xbar);
#if PROBE_PH
    stamp_[ns_ < 15 ? ns_ : 15] = __builtin_amdgcn_s_memrealtime(); ++ns_;
#endif
    asm volatile("" : "+v"(F.tid), "+v"(F.lane));
    if (PH_MAX >= 7) REP(7) {
        pg8::StaticOrder S; S.init(TOK, FF, F.G, F.bid);
        pg8::Gemm gm{F.U(), F.WUP(), TOK, FF, DM}; pg8::EpiRelu2 E{F.H(), FF, F.SSP()}; pg8::gemm_phase<pg8::EpiRelu2, pg8::StaticOrder, true, true>(glds, gm, S, E);
    }
    xcd_barrier(xbar);
#if PROBE_PH
    stamp_[ns_ < 15 ? ns_ : 15] = __builtin_amdgcn_s_memrealtime(); ++ns_;
#endif
    asm volatile("" : "+v"(F.tid), "+v"(F.lane));
    if (PH_MAX >= 8) REP(8) {
        pg8::StaticOrder S; S.init(TOK, DM, F.G, F.bid);
        pg8::Gemm gm{F.H(), F.WDN(), TOK, DM, FF}; pg8::EpiResBf16In E{F.X1B(), F.U(), DM}; pg8::gemm_phase<pg8::EpiResBf16In, pg8::StaticOrder, true, true>(glds, gm, S, E);
    }
    xcd_barrier(xbar);
#if PROBE_PH
    stamp_[ns_ < 15 ? ns_ : 15] = __builtin_amdgcn_s_memrealtime(); ++ns_;
#endif
    asm volatile("" : "+v"(F.tid), "+v"(F.lane));
    for (int m = gw; m < TOK; m += NGW) rms_row_bf16_to_f32(F.U() + (size_t)m * DM, F.g_fin, F.out + (size_t)m * DM, F.lane);
#if PROBE_PH
    xcd_barrier(xbar);
    stamp_[ns_ < 15 ? ns_ : 15] = __builtin_amdgcn_s_memrealtime();
    if (F.bid == 0 && F.tid == 0) { const float us_ = (float)(unsigned)(stamp_[PROBE_PH] - stamp_[PROBE_PH - 1]) * 0.01f; F.out[0] = 1000.f * __builtin_amdgcn_exp2f(__builtin_rintf(6.f * __builtin_amdgcn_logf(us_)) * (1.f / 6.f)); }
#endif
}

extern "C" void kernel_launch(void* const* d_in, const int* in_sizes, int n_in, void* d_out, int out_size, void* d_ws, size_t ws_size, hipStream_t stream) {
    static int grid = 0;
    if (grid == 0) {
        if (n_in != 16 || out_size != TOK * DM || ws_size < WS_END) { fprintf(stderr, "kernel_launch: unexpected shapes (n_in %d out %d ws %zu)\n", n_in, out_size, ws_size); grid = -1; return; }
        int dev = 0, cus = 0, per_cu = 0;
        hipGetDevice(&dev); hipDeviceGetAttribute(&cus, hipDeviceAttributeMultiprocessorCount, dev);
        hipFuncSetAttribute((const void*)fwd_mega, hipFuncAttributeMaxDynamicSharedMemorySize, LDS_BYTES);
        if (hipOccupancyMaxActiveBlocksPerMultiprocessor(&per_cu, (const void*)fwd_mega, NTHR, LDS_BYTES) != hipSuccess || per_cu < 1) { fprintf(stderr, "kernel_launch: occupancy query gave %d\n", per_cu); per_cu = 1; }
        (void)hipGetLastError();
        grid = cus * 1;
    }
    if (grid < 0) return;
    if (hipMemsetAsync(d_ws, 0, 16384, stream) != hipSuccess) { fprintf(stderr, "kernel_launch: memset of barrier words failed\n"); return; }
    Args a{};
    for (int i = 0; i < 16; ++i) a.in[i] = (const float*)d_in[i];
    a.out = (float*)d_out; a.ws = (unsigned char*)d_ws;
    void* kargs[] = {&a};
    hipError_t e = hipLaunchCooperativeKernel((const void*)fwd_mega, dim3(grid), dim3(NTHR), kargs, LDS_BYTES, stream);
    if (e != hipSuccess) fprintf(stderr, "cooperative launch failed: %s (grid %d)\n", hipGetErrorString(e), grid);
}
```

```cpp
#include <hip/hip_runtime.h>
#include <hip/hip_cooperative_groups.h>
#include <cstdio>
#include <cstdint>
namespace cg = cooperative_groups;

namespace pg8 {
#define PG8_LAS __attribute__((address_space(3)))
typedef unsigned short bf16_t;
typedef short bf16x8 __attribute__((ext_vector_type(8)));
typedef float f32x4 __attribute__((ext_vector_type(4)));
typedef unsigned u32x4 __attribute__((ext_vector_type(4)));
constexpr int BM = 256, BK = 64, HALF = 128, HTB = HALF * BK * 2  , STAGE_BYTES = 8 * HTB, NXCD = 8, WGM = 8;

__host__ __device__ __forceinline__ int lds_byte(int r, int c) { const int st = (r >> 4) * 2 + (c >> 5), rr = r & 15, cc = c & 31, ob = rr * 64 + cc * 2; return st * 1024 + (ob ^ (((ob >> 9) & 1) << 5)); }
__host__ __device__ __forceinline__ void stage_rc(int b, int& R, int& C) { const int st = b / 1024, sb = b % 1024, swz = sb ^ (((sb >> 9) & 1) << 5); R = (st >> 1) * 16 + swz / 64; C = (st & 1) * 32 + (swz % 64) / 2; }
__host__ __device__ __forceinline__ int perm32(int rho) { const int n = rho >> 4, i = rho & 15; return 8 * (i >> 2) + 4 * n + (i & 3); }

struct Unit { int pm, pn; };
struct Gemm { const bf16_t* A; const bf16_t* Bt; int M, N, K; };

struct StaticOrder {
    int nM, nN, nwg, G, c;
    __host__ __device__ void init(int M, int N, int G_, int c_) { nM = M / BM; nN = N / BM; nwg = nM * nN; G = G_; c = c_; }
    __host__ __device__ bool next(int i, Unit& u) const {
        const long L = (long)i * G + c; if (L >= nwg) return false;
        int wgid = (int)L; { const int q = nwg / NXCD, r = nwg % NXCD, xcd = wgid % NXCD, off = wgid / NXCD; wgid = (xcd < r ? xcd * (q + 1) : r * (q + 1) + (xcd - r) * q) + off; }
        const int nig = WGM * nN, gid = wgid / nig, fm = gid * WGM, gsz = (nM - fm) < WGM ? (nM - fm) : WGM;
        u.pm = fm + ((wgid % nig) % gsz); u.pn = (wgid % nig) / gsz; return true;
    }
    __device__ __forceinline__ void a_ready(const Unit&) const {}
    __device__ __forceinline__ void done(const Unit&) const {}
};

__device__ __forceinline__ unsigned cvt_pk_bf16(float lo, float hi) { unsigned r; asm volatile("v_cvt_pk_bf16_f32 %0, %1, %2" : "=v"(r) : "v"(lo), "v"(hi)); return r; }
__device__ __forceinline__ float bf_lo(unsigned w) { return __builtin_bit_cast(float, w << 16); }
__device__ __forceinline__ float bf_hi(unsigned w) { return __builtin_bit_cast(float, w & 0xffff0000u); }
__device__ __forceinline__ float sigmoidf_(float x) { return __builtin_amdgcn_rcpf(1.f + __expf(-x)); }

struct EpiInProj {
    static constexpr bool PERM = true, AFTER_DRAIN = false;
    bf16_t* qkva; bf16_t* qb; bf16_t* kvb; bf16_t* gm; bf16_t* gb; const float* cs;
    __device__ __forceinline__ void operator()(const f32x4 (&acc)[2][2][4][2], const Unit& u, int wr, int wc, int fr, int fq) const {
        const int pn = u.pn;
        const int row0 = u.pm * BM + wr * 64 + fr;
        const bool rope_wave = !(wc & 1);
#pragma unroll
        for (int ai = 0; ai < 2; ++ai)
#pragma unroll
            for (int m = 0; m < 4; ++m) {
                const int row = row0 + ai * HALF + m * 16; const int b = row >> 13, s = row & 8191;
                f32x4 c0, c1, s0, s1;
                { const f32x4* t = (const f32x4*)(cs + (size_t)s * 16); c0 = t[0]; c1 = t[1]; s0 = t[2]; s1 = t[3]; }
#pragma unroll
                for (int bj = 0; bj < 2; ++bj) {
                    const int c = pn * BM + bj * HALF + wc * 32 + 8 * fq;
                    f32x4 v0 = acc[ai][bj][m][0], v1 = acc[ai][bj][m][1];
                    bool rope; bf16_t* dst;
                    if (pn < 18) { const int which = c / 1536, hc = c - which * 1536, head = hc >> 6, d0 = hc & 63, lg = (head >> 3) * 2;
                        const int prow = ((s & ((1 << lg) - 1)) << (13 - lg)) | (s >> lg);
                        dst = qkva + ((size_t)((((which * 24 + head) * 2 + b) << 13) + prow) << 6) + d0; rope = (pn < 12); }
                    else if (pn < 20) { dst = qb + (size_t)row * 512 + (c - 4608); rope = true; }
                    else if (pn < 23) { const int cc = c - 5120, j = cc >> 7, g = (cc >> 6) & 1, d0 = cc & 63;
                        dst = kvb + ((size_t)((((j * 4 + b * 2 + g)) << 13) + s) << 6) + d0; rope = (bj == 0); }
                    else if (pn < 31) { dst = gm + (size_t)row * 2048 + (c - 5888); rope = false; }
                    else { dst = gb + (size_t)row * 32 + (c - 7936); rope = false; }
                    if (rope && rope_wave) {
                        f32x4 p0, p1;
#pragma unroll
                        for (int e = 0; e < 4; ++e) { p0[e] = __shfl_xor(v0[e], 16); p1[e] = __shfl_xor(v1[e], 16); }
                        if (fq == 0) { v0 = v0 * c0 - p0 * s0; v1 = v1 * c1 - p1 * s1; }
                        else if (fq == 1) { v0 = v0 * c0 + p0 * s0; v1 = v1 * c1 + p1 * s1; }
                    }
                    if (pn < 31 || (bj == 0 && wc == 0)) {
                        u32x4 w; w.x = cvt_pk_bf16(v0[0], v0[1]); w.y = cvt_pk_bf16(v0[2], v0[3]); w.z = cvt_pk_bf16(v1[0], v1[1]); w.w = cvt_pk_bf16(v1[2], v1[3]);
                        *(u32x4*)dst = w; }
                }
            }
    }
};
template <int STEP> struct EpiMerge {
    static constexpr bool PERM = true, AFTER_DRAIN = false;
    const bf16_t* gm; float* tmp; bf16_t* merged;
    __device__ __forceinline__ void operator()(const f32x4 (&acc)[2][2][4][2], const Unit& u, int wr, int wc, int fr, int fq) const {
        const int row0 = u.pm * BM + wr * 64 + fr, col0 = u.pn * BM + wc * 32 + 8 * fq;
#pragma unroll
        for (int ai = 0; ai < 2; ++ai)
#pragma unroll
            for (int m = 0; m < 4; ++m)
#pragma unroll
                for (int bj = 0; bj < 2; ++bj) {
                    const int row = row0 + ai * HALF + m * 16, c = col0 + bj * HALF;
                    const u32x4 g = __builtin_nontemporal_load((const u32x4*)(gm + (size_t)row * 2048 + (STEP - 1) * 1024 + c));
                    f32x4 v0 = acc[ai][bj][m][0], v1 = acc[ai][bj][m][1];
                    v0[0] *= sigmoidf_(bf_lo(g.x)); v0[1] *= sigmoidf_(bf_hi(g.x)); v0[2] *= sigmoidf_(bf_lo(g.y)); v0[3] *= sigmoidf_(bf_hi(g.y));
                    v1[0] *= sigmoidf_(bf_lo(g.z)); v1[1] *= sigmoidf_(bf_hi(g.z)); v1[2] *= sigmoidf_(bf_lo(g.w)); v1[3] *= sigmoidf_(bf_hi(g.w));
                    bf16_t* tp = (bf16_t*)tmp + (size_t)row * 1024 + c;
                    if (STEP == 1) { u32x4 w; w.x = cvt_pk_bf16(v0[0], v0[1]); w.y = cvt_pk_bf16(v0[2], v0[3]); w.z = cvt_pk_bf16(v1[0], v1[1]); w.w = cvt_pk_bf16(v1[2], v1[3]); *(u32x4*)tp = w; }
                    else { const u32x4 t = __builtin_nontemporal_load((const u32x4*)tp); v0[0] += bf_lo(t.x); v0[1] += bf_hi(t.x); v0[2] += bf_lo(t.y); v0[3] += bf_hi(t.y); v1[0] += bf_lo(t.z); v1[1] += bf_hi(t.z); v1[2] += bf_lo(t.w); v1[3] += bf_hi(t.w);
                        u32x4 w; w.x = cvt_pk_bf16(v0[0], v0[1]); w.y = cvt_pk_bf16(v0[2], v0[3]); w.z = cvt_pk_bf16(v1[0], v1[1]); w.w = cvt_pk_bf16(v1[2], v1[3]);
                        *(u32x4*)(merged + (size_t)row * 1024 + c) = w; }
                    __builtin_amdgcn_sched_barrier(0);
                }
    }
};
struct EpiResF32 {
    static constexpr bool PERM = true, AFTER_DRAIN = false;
    const float* res; float* out; int ldc;
    __device__ __forceinline__ void operator()(const f32x4 (&acc)[2][2][4][2], const Unit& u, int wr, int wc, int fr, int fq) const {
        const int row0 = u.pm * BM + wr * 64 + fr, col0 = u.pn * BM + wc * 32 + 8 * fq;
#pragma unroll
        for (int ai = 0; ai < 2; ++ai)
#pragma unroll
            for (int m = 0; m < 4; ++m)
#pragma unroll
                for (int bj = 0; bj < 2; ++bj) {
                    const size_t off = (size_t)(row0 + ai * HALF + m * 16) * ldc + col0 + bj * HALF;
                    const f32x4 r0 = *(const f32x4*)(res + off), r1 = *(const f32x4*)(res + off + 4);
                    *(f32x4*)(out + off) = r0 + acc[ai][bj][m][0]; *(f32x4*)(out + off + 4) = r1 + acc[ai][bj][m][1];
                    __builtin_amdgcn_sched_barrier(0);
                }
    }
};
struct EpiResBf16 {
    static constexpr bool PERM = true, AFTER_DRAIN = false;
    const float* res; bf16_t* O; int ldc;
    __device__ __forceinline__ void operator()(const f32x4 (&acc)[2][2][4][2], const Unit& u, int wr, int wc, int fr, int fq) const {
        const int row0 = u.pm * BM + wr * 64 + fr, col0 = u.pn * BM + wc * 32 + 8 * fq;
#pragma unroll
        for (int ai = 0; ai < 2; ++ai)
#pragma unroll
            for (int m = 0; m < 4; ++m)
#pragma unroll
                for (int bj = 0; bj < 2; ++bj) {
                    const size_t off = (size_t)(row0 + ai * HALF + m * 16) * ldc + col0 + bj * HALF;
                    const f32x4 v0 = *(const f32x4*)(res + off) + acc[ai][bj][m][0], v1 = *(const f32x4*)(res + off + 4) + acc[ai][bj][m][1];
                    u32x4 w; w.x = cvt_pk_bf16(v0[0], v0[1]); w.y = cvt_pk_bf16(v0[2], v0[3]); w.z = cvt_pk_bf16(v1[0], v1[1]); w.w = cvt_pk_bf16(v1[2], v1[3]);
                    *(u32x4*)(O + off) = w;
                    __builtin_amdgcn_sched_barrier(0);
                }
    }
};
struct EpiResBf16In {
    static constexpr bool PERM = true, AFTER_DRAIN = false;
    const bf16_t* res; bf16_t* O; int ldc;
    __device__ __forceinline__ void operator()(const f32x4 (&acc)[2][2][4][2], const Unit& u, int wr, int wc, int fr, int fq) const {
        const int row0 = u.pm * BM + wr * 64 + fr, col0 = u.pn * BM + wc * 32 + 8 * fq;
#pragma unroll
        for (int ai = 0; ai < 2; ++ai)
#pragma unroll
            for (int m = 0; m < 4; ++m)
#pragma unroll
                for (int bj = 0; bj < 2; ++bj) {
                    const size_t off = (size_t)(row0 + ai * HALF + m * 16) * ldc + col0 + bj * HALF;
                    const u32x4 r = __builtin_nontemporal_load((const u32x4*)(res + off));
                    f32x4 v0 = acc[ai][bj][m][0], v1 = acc[ai][bj][m][1];
                    v0[0] += bf_lo(r.x); v0[1] += bf_hi(r.x); v0[2] += bf_lo(r.y); v0[3] += bf_hi(r.y); v1[0] += bf_lo(r.z); v1[1] += bf_hi(r.z); v1[2] += bf_lo(r.w); v1[3] += bf_hi(r.w);
                    u32x4 w; w.x = cvt_pk_bf16(v0[0], v0[1]); w.y = cvt_pk_bf16(v0[2], v0[3]); w.z = cvt_pk_bf16(v1[0], v1[1]); w.w = cvt_pk_bf16(v1[2], v1[3]);
                    *(u32x4*)(O + off) = w;
                    __builtin_amdgcn_sched_barrier(0);
                }
    }
};
struct EpiResNormPrep {
    static constexpr bool PERM = true, AFTER_DRAIN = false;
    const float* res; bf16_t* X1; bf16_t* U; const float* g; float* part;
    __device__ __forceinline__ void operator()(const f32x4 (&acc)[2][2][4][2], const Unit& u, int wr, int wc, int fr, int fq) const {
        const int row0 = u.pm * BM + wr * 64 + fr, col0 = u.pn * BM + wc * 32 + 8 * fq;
#pragma unroll
        for (int ai = 0; ai < 2; ++ai)
#pragma unroll
            for (int m = 0; m < 4; ++m) {
                const int row = row0 + ai * HALF + m * 16; float ss = 0.f;
#pragma unroll
                for (int bj = 0; bj < 2; ++bj) {
                    const size_t off = (size_t)row * 1024 + col0 + bj * HALF;
                    const f32x4 v0 = __builtin_nontemporal_load((const f32x4*)(res + off)) + acc[ai][bj][m][0], v1 = __builtin_nontemporal_load((const f32x4*)(res + off + 4)) + acc[ai][bj][m][1];
                    const f32x4 g0 = *(const f32x4*)(g + col0 + bj * HALF), g1 = *(const f32x4*)(g + col0 + bj * HALF + 4);
                    ss += (v0[0] * v0[0] + v0[1] * v0[1]) + (v0[2] * v0[2] + v0[3] * v0[3]) + (v1[0] * v1[0] + v1[1] * v1[1]) + (v1[2] * v1[2] + v1[3] * v1[3]);
                    u32x4 w; w.x = cvt_pk_bf16(v0[0], v0[1]); w.y = cvt_pk_bf16(v0[2], v0[3]); w.z = cvt_pk_bf16(v1[0], v1[1]); w.w = cvt_pk_bf16(v1[2], v1[3]);
                    *(u32x4*)(X1 + off) = w;
                    u32x4 y; y.x = cvt_pk_bf16(v0[0] * g0[0], v0[1] * g0[1]); y.y = cvt_pk_bf16(v0[2] * g0[2], v0[3] * g0[3]); y.z = cvt_pk_bf16(v1[0] * g1[0], v1[1] * g1[1]); y.w = cvt_pk_bf16(v1[2] * g1[2], v1[3] * g1[3]);
                    *(u32x4*)(U + off) = y;
                }
                ss += __shfl_xor(ss, 16); ss += __shfl_xor(ss, 32);
                if (fq == 0) part[(size_t)row * 16 + u.pn * 4 + wc] = ss;
                __builtin_amdgcn_sched_barrier(0);
            }
    }
};
struct EpiRelu2 {
    static constexpr bool PERM = true, AFTER_DRAIN = false;
    bf16_t* O; int ldc; const float* part;
    __device__ __forceinline__ void operator()(const f32x4 (&acc)[2][2][4][2], const Unit& u, int wr, int wc, int fr, int fq) const {
        const int row0 = u.pm * BM + wr * 64 + fr, col0 = u.pn * BM + wc * 32 + 8 * fq;
#pragma unroll
        for (int ai = 0; ai < 2; ++ai)
#pragma unroll
            for (int m = 0; m < 4; ++m) {
                const f32x4* pp = (const f32x4*)(part + (size_t)(row0 + ai * HALF + m * 16) * 16);
                const f32x4 s4 = (pp[0] + pp[1]) + (pp[2] + pp[3]);
                const float rstd = 1.f / sqrtf(((s4[0] + s4[1]) + (s4[2] + s4[3])) * (1.f / 1024.f) + 1e-6f);
#pragma unroll
                for (int bj = 0; bj < 2; ++bj) {
                    f32x4 v0 = acc[ai][bj][m][0], v1 = acc[ai][bj][m][1];
#pragma unroll
                    for (int e = 0; e < 4; ++e) { const float a = fmaxf(v0[e] * rstd, 0.f), b = fmaxf(v1[e] * rstd, 0.f); v0[e] = a * a; v1[e] = b * b; }
                    u32x4 w; w.x = cvt_pk_bf16(v0[0], v0[1]); w.y = cvt_pk_bf16(v0[2], v0[3]); w.z = cvt_pk_bf16(v1[0], v1[1]); w.w = cvt_pk_bf16(v1[2], v1[3]);
                    *(u32x4*)(O + (size_t)(row0 + ai * HALF + m * 16) * ldc + col0 + bj * HALF) = w;
                    __builtin_amdgcn_sched_barrier(0);
                }
            }
    }
};

template <class Epi, class Sched, bool ALIGN_EPI = false, bool SP2 = false>
__device__ __forceinline__ void gemm_phase(PG8_LAS unsigned char* lds, const Gemm g, const Sched& S, const Epi& E) {
    int tid_ = threadIdx.x; asm volatile("" : "+v"(tid_));
    const int tid = tid_, wid = __builtin_amdgcn_readfirstlane(tid >> 6), lane = tid & 63, wr = wid >> 2, wc = wid & 3, fr = lane & 15, fq = lane >> 4;
    const int K = g.K, nt = K / BK;
    unsigned voffA[2], voffB[2];
#pragma unroll
    for (int i = 0; i < 2; ++i) { int R, C; stage_rc(tid * 16 + i * 8192, R, C); const int Rb = Epi::PERM ? ((R & ~31) + perm32(R & 31)) : R;
        voffA[i] = (unsigned)(R * K + C) * 2u; voffB[i] = (unsigned)(Rb * K + C) * 2u; }
    const size_t kstep = (size_t)(BK * 2);
    const size_t hstep = (size_t)HALF * K * 2;
    const size_t tstep = 2 * hstep;
    const unsigned ldsw = (unsigned)wid * 1024u;
    const int aoff = lds_byte(wr * 64 + fr, fq * 8), boff = lds_byte(wc * 32 + fr, fq * 8);
#define PG8_SA(b, h) (((b) * 2 + (h)) * HTB)
#define PG8_SB(b, h) ((4 + (b) * 2 + (h)) * HTB)
#define PG8_STAGE(bufoff, gbase, voff) do { _Pragma("unroll") for (int _i = 0; _i < 2; ++_i) \
        __builtin_amdgcn_global_load_lds((const unsigned*)((const char*)(gbase) + (voff)[_i]), (PG8_LAS unsigned*)(lds + (bufoff) + ldsw + _i * 8192), 16, 0, 0); } while (0)
#define PG8_LDA(dst, b, h) do { _Pragma("unroll") for (int m = 0; m < 4; ++m) _Pragma("unroll") for (int k = 0; k < 2; ++k) dst[m][k] = *(const PG8_LAS bf16x8*)(lds + PG8_SA(b, h) + aoff + m * 2048 + k * 1024); } while (0)
#define PG8_LDB(dst, b, h) do { _Pragma("unroll") for (int n = 0; n < 2; ++n) _Pragma("unroll") for (int k = 0; k < 2; ++k) dst[n][k] = *(const PG8_LAS bf16x8*)(lds + PG8_SB(b, h) + boff + n * 2048 + k * 1024); } while (0)
#define PG8_MMA(ai, bj, At, Bt) do { __builtin_amdgcn_s_setprio(1); _Pragma("unroll") for (int m = 0; m < 4; ++m) _Pragma("unroll") for (int n = 0; n < 2; ++n) _Pragma("unroll") for (int k = 0; k < 2; ++k) \
        acc[ai][bj][m][n] = __builtin_amdgcn_mfma_f32_16x16x32_bf16(Bt[n][k], At[m][k], acc[ai][bj][m][n], 0, 0, 0); __builtin_amdgcn_s_setprio(0); } while (0)
#define PG8_WAIT_V(n) asm volatile("s_waitcnt vmcnt(" #n ")" ::: "memory")
#define PG8_WAIT_L(n) asm volatile("s_waitcnt lgkmcnt(" #n ")" ::: "memory")
#define PG8_BAR __builtin_amdgcn_s_barrier()
#define PG8_SCHED __builtin_amdgcn_sched_barrier(0)
    Unit cur, nxt; int ui = 0;
    if (!S.next(0, cur)) return;
    f32x4 acc[2][2][4][2];
#pragma unroll
    for (int a = 0; a < 2; ++a)
#pragma unroll
        for (int b = 0; b < 2; ++b)
#pragma unroll
            for (int m = 0; m < 4; ++m)
#pragma unroll
                for (int n = 0; n < 2; ++n) acc[a][b][m][n] = (f32x4){0.f, 0.f, 0.f, 0.f};
    bf16x8 At[4][2], B0[2][2], B1[2][2];
    const char* cA = (const char*)g.A + (size_t)cur.pm * tstep; const char* cB = (const char*)g.Bt + (size_t)cur.pn * tstep;
    S.a_ready(cur);
    if constexpr (SP2) {
        PG8_STAGE(PG8_SB(0, 0), cB, voffB); PG8_STAGE(PG8_SB(0, 1), cB + hstep, voffB); PG8_STAGE(PG8_SA(0, 0), cA, voffA); PG8_STAGE(PG8_SA(0, 1), cA + hstep, voffA);
        if (wr == 1) PG8_BAR;
        PG8_WAIT_V(2); PG8_BAR;
        PG8_STAGE(PG8_SB(1, 0), cB + kstep, voffB); PG8_STAGE(PG8_SA(1, 0), cA + kstep, voffA); PG8_STAGE(PG8_SB(1, 1), cB + hstep + kstep, voffB);
        PG8_WAIT_V(6); PG8_BAR;
    } else {
        PG8_STAGE(PG8_SB(0, 0), cB, voffB); PG8_STAGE(PG8_SA(0, 0), cA, voffA); PG8_STAGE(PG8_SB(0, 1), cB + hstep, voffB); PG8_STAGE(PG8_SA(0, 1), cA + hstep, voffA);
        if (wr == 1) PG8_BAR;
        PG8_WAIT_V(4); PG8_BAR;
        PG8_STAGE(PG8_SB(1, 0), cB + kstep, voffB); PG8_STAGE(PG8_SA(1, 0), cA + kstep, voffA); PG8_STAGE(PG8_SB(1, 1), cB + hstep + kstep, voffB);
        PG8_WAIT_V(6); PG8_BAR;
    }
    for (;;) {
        const bool has_next = S.next(ui + 1, nxt);
        const char* nA = has_next ? (const char*)g.A + (size_t)nxt.pm * tstep : cA; const char* nB = has_next ? (const char*)g.Bt + (size_t)nxt.pn * tstep : cB;
        for (int t = 0; t < nt; t += 2) {
            const bool last = (t == nt - 2);
            const char* a1 = cA + (size_t)(t + 1) * kstep;
            const char* a2 = last ? nA : cA + (size_t)(t + 2) * kstep; const char* b2 = last ? nB : cB + (size_t)(t + 2) * kstep;
            const char* a3 = a2 + kstep; const char* b3 = b2 + kstep;
            if (last && has_next) S.a_ready(nxt);
            if constexpr (SP2) {
            PG8_LDB(B0, 0, 0); PG8_LDB(B1, 0, 1); PG8_SCHED; PG8_LDA(At, 0, 0); PG8_STAGE(PG8_SA(1, 1), a1 + hstep, voffA);
            PG8_WAIT_V(8); PG8_WAIT_L(0); PG8_BAR; PG8_MMA(0, 0, At, B0); PG8_MMA(0, 1, At, B1); PG8_BAR; PG8_SCHED;
            PG8_LDA(At, 0, 1); PG8_STAGE(PG8_SB(0, 0), b2, voffB); PG8_STAGE(PG8_SB(0, 1), b2 + hstep, voffB); PG8_STAGE(PG8_SA(0, 0), a2, voffA);
            PG8_WAIT_V(8); PG8_WAIT_L(0); PG8_BAR; PG8_MMA(1, 0, At, B0); PG8_MMA(1, 1, At, B1); PG8_BAR; PG8_SCHED;
            PG8_LDB(B0, 1, 0); PG8_LDB(B1, 1, 1); PG8_SCHED; PG8_LDA(At, 1, 0); PG8_STAGE(PG8_SA(0, 1), a2 + hstep, voffA);
            PG8_WAIT_V(8); PG8_WAIT_L(0); PG8_BAR; PG8_MMA(0, 0, At, B0); PG8_MMA(0, 1, At, B1); PG8_BAR; PG8_SCHED;
            PG8_LDA(At, 1, 1); PG8_STAGE(PG8_SB(1, 0), b3, voffB); PG8_STAGE(PG8_SB(1, 1), b3 + hstep, voffB); PG8_STAGE(PG8_SA(1, 0), a3, voffA);
            PG8_WAIT_V(8); PG8_WAIT_L(0); PG8_BAR; PG8_MMA(1, 0, At, B0); PG8_MMA(1, 1, At, B1); PG8_BAR; PG8_SCHED;
            } else {
            PG8_LDB(B0, 0, 0); PG8_SCHED; PG8_LDA(At, 0, 0); PG8_STAGE(PG8_SA(1, 1), a1 + hstep, voffA);
            PG8_WAIT_L(8); PG8_BAR; PG8_WAIT_L(0); PG8_MMA(0, 0, At, B0); PG8_BAR; PG8_SCHED;
            PG8_LDB(B1, 0, 1); PG8_STAGE(PG8_SB(0, 0), b2, voffB);
            PG8_BAR; PG8_WAIT_L(0); PG8_MMA(0, 1, At, B1); PG8_BAR;
            PG8_LDA(At, 0, 1); PG8_STAGE(PG8_SA(0, 0), a2, voffA);
            PG8_BAR; PG8_WAIT_L(0); PG8_MMA(1, 0, At, B0); PG8_BAR; PG8_SCHED;
            PG8_STAGE(PG8_SB(0, 1), b2 + hstep, voffB);
            PG8_WAIT_V(6); PG8_BAR; PG8_MMA(1, 1, At, B1); PG8_BAR;
            PG8_LDB(B0, 1, 0); PG8_SCHED; PG8_LDA(At, 1, 0); PG8_STAGE(PG8_SA(0, 1), a2 + hstep, voffA);
            PG8_WAIT_L(8); PG8_BAR; PG8_WAIT_L(0); PG8_MMA(0, 0, At, B0); PG8_BAR; PG8_SCHED;
            PG8_LDB(B1, 1, 1); PG8_STAGE(PG8_SB(1, 0), b3, voffB);
            PG8_BAR; PG8_WAIT_L(0); PG8_MMA(0, 1, At, B1); PG8_BAR;
            PG8_LDA(At, 1, 1); PG8_STAGE(PG8_SA(1, 0), a3, voffA);
            PG8_BAR; PG8_WAIT_L(0); PG8_MMA(1, 0, At, B0); PG8_BAR; PG8_SCHED;
            PG8_STAGE(PG8_SB(1, 1), b3 + hstep, voffB);
            PG8_WAIT_V(6); PG8_BAR; PG8_MMA(1, 1, At, B1); PG8_BAR;
            }
        }
        if constexpr (ALIGN_EPI) { if (wr == 0) PG8_BAR; }
        if constexpr (!Epi::AFTER_DRAIN) { E(acc, cur, wr, wc, fr, fq); S.done(cur); }
        if (!has_next) break;
#pragma unroll
        for (int a = 0; a < 2; ++a)
#pragma unroll
            for (int b = 0; b < 2; ++b)
#pragma unroll
                for (int m = 0; m < 4; ++m)
#pragma unroll
                    for (int n = 0; n < 2; ++n) acc[a][b][m][n] = (f32x4){0.f, 0.f, 0.f, 0.f};
        cur = nxt; cA = nA; cB = nB; ++ui;
        if constexpr (ALIGN_EPI) { if (wr == 1) PG8_BAR; }
    }
    PG8_WAIT_V(0);
    if constexpr (!ALIGN_EPI) { if (wr == 0) PG8_BAR; }
    PG8_BAR;
    if constexpr (Epi::AFTER_DRAIN) { E.fused(acc, cur, wr, wc, fr, fq, lds, wid, lane); S.done(cur); }
#undef PG8_SA
#undef PG8_SB
#undef PG8_STAGE
#undef PG8_LDA
#undef PG8_LDB
#undef PG8_MMA
#undef PG8_WAIT_V
#undef PG8_WAIT_L
#undef PG8_BAR
#undef PG8_SCHED
}
}

#define DI __device__ __forceinline__
#ifndef NSA_SKIP
#define NSA_SKIP 0
#endif
#define LAS __attribute__((address_space(3)))
typedef unsigned short bf16;
typedef short bf16x8 __attribute__((ext_vector_type(8)));
typedef short s16x4 __attribute__((ext_vector_type(4)));
typedef float f32x4 __attribute__((ext_vector_type(4)));
typedef float f32x16 __attribute__((ext_vector_type(16)));
typedef unsigned u32x4 __attribute__((ext_vector_type(4)));
typedef unsigned u32x2 __attribute__((ext_vector_type(2)));
#define MFMA32(a, b, c) __builtin_amdgcn_mfma_f32_32x32x16_bf16((a), (b), (c), 0, 0, 0)
#define LDS_WAIT() asm volatile("s_waitcnt lgkmcnt(0)" ::: "memory")

constexpr int SEQ = 8192, TOK = 16384, DM = 1024, FF = 4096, NIN = 8192, NTHR = 512;
constexpr size_t MiB = 1u << 20;
constexpr size_t WS_WIN = 1 * MiB, WS_WA = 17 * MiB, WS_WB = 18 * MiB, WS_WO = 19 * MiB, WS_W1K = 21 * MiB, WS_W1V = 22 * MiB, WS_SMALL = 23 * MiB,
                 WS_KC = 24 * MiB, WS_LSE = 25 * MiB, WS_GB = 27 * MiB, WS_QB = 28 * MiB, WS_KVB = 44 * MiB, WS_R2 = 68 * MiB, WS_R1 = 100 * MiB,
                 WS_WUP = 228 * MiB, WS_WDN = 236 * MiB, WS_END = 244 * MiB;
constexpr int LDS_BYTES = 147456;
constexpr int KVROW = 144, KVT = 64 * KVROW;
constexpr int VROW = 192, VT = 64 * VROW, BUFB = KVT + VT;
constexpr float SC_LOG2E = 0.125f * 1.4426950408889634f;

struct Args { const float* in[16]; float* out; unsigned char* ws; };

struct Frame {
    LAS unsigned char* lds; int tid, lane, wave, G, bid;
    const float *x, *g_mix, *w_in, *pos_k, *w1_k, *w2_k, *pos_v, *w1_v, *w2_v, *w_a, *w_b, *w_out, *g_mlp, *w_up, *w_down, *g_fin;
    float* out; unsigned char* ws;
    DI bf16* WIN() const { return (bf16*)(ws + (WS_WIN)); }
    DI bf16* WA() const { return (bf16*)(ws + (WS_WA)); }
    DI bf16* WB() const { return (bf16*)(ws + (WS_WB)); }
    DI bf16* WO() const { return (bf16*)(ws + (WS_WO)); }
    DI bf16* W1K() const { return (bf16*)(ws + (WS_W1K)); }
    DI bf16* W1V() const { return (bf16*)(ws + (WS_W1V)); }
    DI bf16* W2K() const { return (bf16*)(ws + (WS_SMALL)); }
    DI bf16* W2V() const { return (bf16*)(ws + (WS_SMALL + 32768)); }
    DI bf16* KC() const { return (bf16*)(ws + (WS_KC)); }
    DI bf16* VC() const { return (bf16*)(ws + (WS_KC + 262144)); }
    DI bf16* GB() const { return (bf16*)(ws + (WS_GB)); }
    DI bf16* QB() const { return (bf16*)(ws + (WS_QB)); }
    DI bf16* KVB() const { return (bf16*)(ws + (WS_KVB)); }
    DI bf16* U() const { return (bf16*)(ws + (WS_R2)); }
    DI bf16* OG0() const { return (bf16*)(ws + (WS_R2)); }
    DI bf16* OG1() const { return (bf16*)(ws + (WS_R2 + 16 * MiB)); }
    DI bf16* OG2() const { return (bf16*)(ws + (WS_WIN)); }
    DI bf16* QKVA() const { return (bf16*)(ws + (WS_R1)); }
    DI bf16* YA() const { return (bf16*)(ws + (WS_R1)); }
    DI bf16* YB() const { return (bf16*)(ws + (WS_R1 + 16 * MiB)); }
    DI bf16* MERGED() const { return (bf16*)(ws + (WS_R1 + 96 * MiB)); }
    DI bf16* H() const { return (bf16*)(ws + (WS_R1)); }
    DI bf16* WUP() const { return (bf16*)(ws + (WS_WUP)); }
    DI bf16* WDN() const { return (bf16*)(ws + (WS_WDN)); }
    DI float* BIASK() const { return (float*)(ws + (WS_SMALL + 65536)); }
    DI float* BIASV() const { return (float*)(ws + (WS_SMALL + 81920)); }
    DI float* CS() const { return (float*)(ws + (WS_SMALL + 131072)); }
    DI float* LSE() const { return (float*)(ws + (WS_LSE)); }
    DI float* TMP() const { return (float*)(ws + (WS_R1 + 32 * MiB)); }
    DI bf16* GM() const { return (bf16*)out; }
    DI float* SSP() const { return (float*)(ws + WS_LSE + 1 * MiB); }
    DI bf16* X1B() const { return (bf16*)(ws + WS_QB); }
};

DI float wave_sum(float v) {
#pragma unroll
    for (int o = 1; o < 64; o <<= 1) v += __shfl_xor(v, o);
    return v;
}
DI unsigned f2bf(float f) { unsigned u = __builtin_bit_cast(unsigned, f); return (u + 0x7fffu + ((u >> 16) & 1u)) >> 16; }
DI unsigned pk2(float lo, float hi) { return f2bf(lo) | (f2bf(hi) << 16); }
DI float bf2f(bf16 v) { return __builtin_bit_cast(float, (unsigned)v << 16); }
DI float sigm(float x) { return 1.f / (1.f + __expf(-x)); }
DI f32x16 zero16() { f32x16 z;
#pragma unroll
    for (int i = 0; i < 16; ++i) z[i] = 0.f;
    return z; }

DI void transpose_item(const float* W, int ldw, int col0, int ncols, int k0, bf16* WT, int K, int drow0, LAS float* scr, int lane) {
    const int cl = lane & 31;
#pragma unroll 8
    for (int i = 0; i < 32; ++i) { const int kk = 2 * i + (lane >> 5); scr[kk * 33 + cl] = (cl < ncols) ? W[(size_t)(k0 + kk) * ldw + col0 + cl] : 0.f; }
    LDS_WAIT();
    const int c = lane & 7;
#pragma unroll
    for (int j = 0; j < 4; ++j) { const int n = (lane >> 3) + 8 * j; const LAS float* s = scr + (8 * c) * 33 + n;
        u32x4 o; o.x = pk2(s[0 * 33], s[1 * 33]); o.y = pk2(s[2 * 33], s[3 * 33]); o.z = pk2(s[4 * 33], s[5 * 33]); o.w = pk2(s[6 * 33], s[7 * 33]);
        if (n < ncols) *(u32x4*)(WT + (size_t)(drow0 + n) * K + k0 + 8 * c) = o; }
    LDS_WAIT();
}
DI bool transpose_job(int& item, const float* W, int ldw, int scol0, int ncols, int K, bf16* WT, int drow0, LAS float* scr, int lane) {
    const int nblk = (ncols + 31) >> 5, nitems = (K >> 6) * nblk;
    if (item >= nitems) { item -= nitems; return false; }
    const int kb = item / nblk, nb = item - kb * nblk;
    const int rem = ncols - 32 * nb;
    transpose_item(W, ldw, scol0 + 32 * nb, rem < 32 ? rem : 32, 64 * kb, WT, K, drow0 + 32 * nb, scr, lane);
    return true;
}
DI void transpose_tile256(const float* W, int ldw, int col0, int k0, bf16* WT, int K, int drow0, LAS unsigned char* lds, int tid) {
    const int w = tid >> 6, l = tid & 63;
    LAS float* tile = (LAS float*)lds;
    f32x4 v[8];
#pragma unroll
    for (int i = 0; i < 8; ++i) v[i] = __builtin_nontemporal_load((const f32x4*)(W + (size_t)(k0 + w + 8 * i) * ldw + col0 + 4 * l));
#pragma unroll
    for (int i = 0; i < 8; ++i) *(LAS f32x4*)(tile + (w + 8 * i) * 260 + 4 * l) = v[i];
    __syncthreads();
    const int n = tid & 255;
#pragma unroll
    for (int q = 0; q < 4; ++q) { const int c = (tid >> 8) + 2 * q; const LAS float* sp = tile + (8 * c) * 260 + n;
        u32x4 o; o.x = pk2(sp[0], sp[260]); o.y = pk2(sp[2 * 260], sp[3 * 260]); o.z = pk2(sp[4 * 260], sp[5 * 260]); o.w = pk2(sp[6 * 260], sp[7 * 260]);
        *(u32x4*)(WT + (size_t)(drow0 + n) * K + k0 + 8 * c) = o; }
    __syncthreads();
}
DI bool ttile_job(int& item, const float* W, int ldw, int scol0, int ncols, int K, bf16* WT, int drow0, LAS unsigned char* lds, int tid) {
    const int nblk = ncols >> 8, nitems = (K >> 6) * nblk;
    if (item >= nitems) { item -= nitems; return false; }
    const int kb = item / nblk, nb = item - kb * nblk;
    transpose_tile256(W, ldw, scol0 + 256 * nb, 64 * kb, WT, K, drow0 + 256 * nb, lds, tid);
    return true;
}
DI void rms_row_bf16(const float* xrow, const float* g, bf16* orow, int lane) {
    const f32x4* xr = (const f32x4*)xrow + lane; const f32x4* gr = (const f32x4*)g + lane;
    f32x4 v[4]; float s = 0.f;
#pragma unroll
    for (int j = 0; j < 4; ++j) { v[j] = __builtin_nontemporal_load(xr + 64 * j); s += (v[j].x * v[j].x + v[j].y * v[j].y) + (v[j].z * v[j].z + v[j].w * v[j].w); }
    const float rstd = 1.f / sqrtf(wave_sum(s) * (1.f / DM) + 1e-6f);
    unsigned long long* o8 = (unsigned long long*)orow + lane;
#pragma unroll
    for (int j = 0; j < 4; ++j) { const f32x4 gg = gr[64 * j];
        o8[64 * j] = (unsigned long long)pk2(v[j].x * rstd * gg.x, v[j].y * rstd * gg.y) | ((unsigned long long)pk2(v[j].z * rstd * gg.z, v[j].w * rstd * gg.w) << 32); }
}
DI void rms_row_f32_inplace(float* xrow, const float* g, int lane) {
    f32x4* xr = (f32x4*)xrow + lane; const f32x4* gr = (const f32x4*)g + lane;
    f32x4 v[4]; float s = 0.f;
#pragma unroll
    for (int j = 0; j < 4; ++j) { v[j] = xr[64 * j]; s += (v[j].x * v[j].x + v[j].y * v[j].y) + (v[j].z * v[j].z + v[j].w * v[j].w); }
    const float rstd = 1.f / sqrtf(wave_sum(s) * (1.f / DM) + 1e-6f);
#pragma unroll
    for (int j = 0; j < 4; ++j) xr[64 * j] = v[j] * rstd * gr[64 * j];
}

DI void rms_row_bf16_to_f32(const bf16* xrow, const float* g, float* orow, int lane) {
    const u32x2* xr = (const u32x2*)xrow + lane; const f32x4* gr = (const f32x4*)g + lane;
    f32x4 v[4]; float s = 0.f;
#pragma unroll
    for (int j = 0; j < 4; ++j) { const u32x2 w = __builtin_nontemporal_load(xr + 64 * j); v[j] = (f32x4){pg8::bf_lo(w.x), pg8::bf_hi(w.x), pg8::bf_lo(w.y), pg8::bf_hi(w.y)};
        s += (v[j].x * v[j].x + v[j].y * v[j].y) + (v[j].z * v[j].z + v[j].w * v[j].w); }
    const float rstd = 1.f / sqrtf(wave_sum(s) * (1.f / DM) + 1e-6f);
    f32x4* o4 = (f32x4*)orow + lane;
#pragma unroll
    for (int j = 0; j < 4; ++j) { const f32x4 r = v[j] * rstd * gr[64 * j]; __builtin_nontemporal_store(r, o4 + 64 * j); }
}
DI void rms_row_bf16_to_bf16(const bf16* xrow, const float* g, bf16* orow, int lane) {
    const u32x2* xr = (const u32x2*)xrow + lane; const f32x4* gr = (const f32x4*)g + lane;
    f32x4 v[4]; float s = 0.f;
#pragma unroll
    for (int j = 0; j < 4; ++j) { const u32x2 w = __builtin_nontemporal_load(xr + 64 * j); v[j] = (f32x4){pg8::bf_lo(w.x), pg8::bf_hi(w.x), pg8::bf_lo(w.y), pg8::bf_hi(w.y)};
        s += (v[j].x * v[j].x + v[j].y * v[j].y) + (v[j].z * v[j].z + v[j].w * v[j].w); }
    const float rstd = 1.f / sqrtf(wave_sum(s) * (1.f / DM) + 1e-6f);
    unsigned long long* o8 = (unsigned long long*)orow + lane;
#pragma unroll
    for (int j = 0; j < 4; ++j) { const f32x4 gg = gr[64 * j];
        o8[64 * j] = (unsigned long long)pk2(v[j].x * rstd * gg.x, v[j].y * rstd * gg.y) | ((unsigned long long)pk2(v[j].z * rstd * gg.z, v[j].w * rstd * gg.w) << 32); }
}
DI void p0_prologue(const Frame& F) {
    LAS float* scr = (LAS float*)(F.lds + F.wave * 16384);
    const int gw = F.bid * 8 + F.wave, NGW = F.G * 8;
    constexpr int NTILES = 16 * 23 + 16 * 8 + 32 + 32;
    for (int it = F.bid; it < NTILES; it += F.G) {
        int r = it;
        if (ttile_job(r, F.w_in, 7960, 0, 5888, DM, F.WIN(), 0, F.lds, F.tid)) continue;
        if (ttile_job(r, F.w_in, 7960, 5912, 2048, DM, F.WIN(), 5888, F.lds, F.tid)) continue;
        if (ttile_job(r, F.w1_k, 256, 0, 256, 2048, F.W1K(), 0, F.lds, F.tid)) continue;
        ttile_job(r, F.w1_v, 256, 0, 256, 2048, F.W1V(), 0, F.lds, F.tid);
    }
    constexpr int NITEMS = 16 + 8 + 8;
    for (int it = gw; it < NITEMS; it += NGW) {
        int r = it;
        if (transpose_job(r, F.w_in, 7960, 5888, 24, DM, F.WIN(), 7936, scr, F.lane)) continue;
        if (transpose_job(r, F.w2_k, 64, 0, 64, 256, F.W2K(), 0, scr, F.lane)) continue;
        transpose_job(r, F.w2_v, 64, 0, 64, 256, F.W2V(), 0, scr, F.lane);
    }
    __syncthreads();
    const int gt = F.bid * NTHR + F.tid, NGT = F.G * NTHR;
    for (int i = gt; i < 232 * 1024 / 8; i += NGT) *(u32x4*)(F.WIN() + (size_t)7960 * 1024 + (size_t)i * 8) = (u32x4){0u, 0u, 0u, 0u};
    for (int i = gt; i < SEQ * 8; i += NGT) {
        const int s = i >> 3, k = i & 7;
        const double inv[8] = {1.0, 0.19392274474868576, 0.03760603093086393, 0.007292664737217109, 0.001414213562373095, 0.0002742481756762073, 5.318295896944988e-05, 1.031338537721246e-05};
        double iv = inv[0];
#pragma unroll
        for (int q = 1; q < 8; ++q) iv = (k == q) ? inv[q] : iv;
        const double rev = (double)s * iv * 0.15915494309189535;
        const float fr = (float)(rev - __builtin_rint(rev));
        F.CS()[s * 16 + k] = __builtin_amdgcn_cosf(fr); F.CS()[s * 16 + 8 + k] = __builtin_amdgcn_sinf(fr);
    }
    for (int m = gw; m < TOK; m += NGW) rms_row_bf16(F.x + (size_t)m * DM, F.g_mix, F.U() + (size_t)m * DM, F.lane);
    if (F.bid < 32) {
        const int mat = F.bid >> 4, part = F.bid & 15, col = F.tid & 255, kh = F.tid >> 8;
        const float* pe = mat ? F.pos_v : F.pos_k; const float* W1 = mat ? F.w1_v : F.w1_k; float acc = 0.f;
        const int kb = part * 128 + kh * 64;
#pragma unroll 8
        for (int k = 0; k < 64; ++k) acc += pe[kb + k] * W1[(size_t)(kb + k) * 256 + col];
        LAS float* red = (LAS float*)F.lds;
        __syncthreads();
        if (kh) red[col] = acc;
        __syncthreads();
        if (!kh) (mat ? F.BIASV() : F.BIASK())[part * 256 + col] = acc + red[col];
        __syncthreads();
    }
    if (F.bid == 2) { const int kv = F.tid >> 8, bg = (F.tid >> 6) & 3, d = F.tid & 63; (kv ? F.VC() : F.KC())[((bg * 512 + 511) << 6) + d] = 0; }
}

struct Stg { u32x4 k, v; };
DI void stage_load(Stg& s, const bf16* Kg, const bf16* Vg, int row0, int tid) {
    s.k = *(const u32x4*)(Kg + ((size_t)row0 << 6) + tid * 8); s.v = *(const u32x4*)(Vg + ((size_t)row0 << 6) + tid * 8);
}
DI void stage_store(const Stg& s, LAS unsigned char* lds, int buf, int tid) {
    *(LAS u32x4*)(lds + buf * BUFB + (tid >> 3) * KVROW + (tid & 7) * 16) = s.k; *(LAS u32x4*)(lds + buf * BUFB + KVT + (tid >> 3) * VROW + (tid & 7) * 16) = s.v;
}
DI unsigned pkbf(float a, float b) {
    typedef __bf16 bf2 __attribute__((ext_vector_type(2))); typedef float f2 __attribute__((ext_vector_type(2)));
    f2 v = {a, b}; bf2 r = __builtin_convertvector(v, bf2); return __builtin_bit_cast(unsigned, r);
}
DI void qk_tile(LAS const unsigned char* kt, const bf16x8 (&qf)[4], f32x16 (&s)[2], int lane) {
    const int r = lane & 31, h = lane >> 5;
    const int sr = (r & 19) | ((r & 4) << 1) | ((r & 8) >> 1);
    LAS const unsigned char* kp = kt + sr * KVROW + h * 16;
    bf16x8 ka[8];
#pragma unroll
    for (int kh = 0; kh < 2; ++kh)
#pragma unroll
        for (int ks = 0; ks < 4; ++ks) ka[kh * 4 + ks] = *(LAS const bf16x8*)(kp + kh * 32 * KVROW + ks * 32);
    s[0] = zero16(); s[1] = zero16();
    __builtin_amdgcn_s_setprio(1);
#pragma unroll
    for (int ks = 0; ks < 4; ++ks) { s[0] = MFMA32(ka[ks], qf[ks], s[0]); s[1] = MFMA32(ka[4 + ks], qf[ks], s[1]); }
    __builtin_amdgcn_s_setprio(0);
}
DI float xhalf_max(float v) { auto rr = __builtin_amdgcn_permlane32_swap(__float_as_uint(v), __float_as_uint(v), false, false); return fmaxf(__uint_as_float(rr[0]), __uint_as_float(rr[1])); }
DI float xhalf_sum(float v) { auto rr = __builtin_amdgcn_permlane32_swap(__float_as_uint(v), __float_as_uint(v), false, false); return __uint_as_float(rr[0]) + __uint_as_float(rr[1]); }
typedef float f32x2 __attribute__((ext_vector_type(2)));
#define OPQ(x) asm("" : "+v"(x))
DI void flash_tile(LAS const unsigned char* kt, LAS const unsigned char* vt, const bf16x8 (&qf)[4], f32x16 (&o)[2], float& m, float& l, int dq, unsigned maxoff, bool sel, int lane) {
    const int h = lane >> 5;
    f32x16 s[2];
    qk_tile(kt, qf, s, lane);
    bf16x8 vf[2][2][2];
    {
        const int q4 = (lane & 15) >> 2, p4 = lane & 3, blk = (lane >> 4) & 1;
        LAS const unsigned char* vb = vt + (8 * h + q4) * VROW + 8 * (4 * blk + p4);
#pragma unroll
        for (int kh = 0; kh < 2; ++kh)
#pragma unroll
            for (int s2 = 0; s2 < 2; ++s2)
#pragma unroll
                for (int db = 0; db < 2; ++db) {
                    LAS const unsigned char* vp = vb + (32 * kh + 16 * s2) * VROW + db * 64;
                    const s16x4 lo = __builtin_amdgcn_ds_read_tr16_b64_v4i16((LAS s16x4*)(vp));
                    const s16x4 hi = __builtin_amdgcn_ds_read_tr16_b64_v4i16((LAS s16x4*)(vp + 4 * VROW));
                    vf[kh][s2][db] = __builtin_shufflevector(lo, hi, 0, 1, 2, 3, 4, 5, 6, 7);
                }
    }
    const bool lane_full = (dq >= 55) && ((unsigned)dq <= maxoff);
    if (__ballot(!lane_full) != 0ull) {
#pragma unroll
        for (int kh = 0; kh < 2; ++kh)
#pragma unroll
            for (int i = 0; i < 16; ++i) { const int kk = 32 * kh + 16 * (i >> 3) + (i & 7); s[kh][i] = ((unsigned)(dq - kk) <= maxoff) ? s[kh][i] : -1e30f; }
    }
    asm volatile("s_nop 15\n\ts_nop 15" : "+v"(s[0]), "+v"(s[1]));
#define MAX3(d, a, b, c) asm("v_max3_f32 %0, %1, %2, %3" : "=v"(d) : "v"(a), "v"(b), "v"(c))
    float ma[10], mc2[4], mx;
#pragma unroll
    for (int i = 0; i < 5; ++i) { MAX3(ma[i], s[0][3 * i], s[0][3 * i + 1], s[0][3 * i + 2]); MAX3(ma[5 + i], s[1][3 * i], s[1][3 * i + 1], s[1][3 * i + 2]); }
    MAX3(mc2[0], ma[0], ma[1], ma[2]); MAX3(mc2[1], ma[3], ma[4], ma[5]); MAX3(mc2[2], ma[6], ma[7], ma[8]); MAX3(mc2[3], ma[9], s[0][15], s[1][15]);
    { float t0, t1; MAX3(t0, mc2[0], mc2[1], mc2[2]); MAX3(t1, mc2[3], t0, t0); mx = t1; }
#undef MAX3
    mx = xhalf_max(mx);
    mx = sel ? mx : -1e30f;
    const bool need = mx > m + 40.f;
    if (__ballot(need) != 0ull) {
        const float mn = need ? mx : m;
        const float alpha = need ? __builtin_amdgcn_exp2f((m - mn) * SC_LOG2E) : 1.f;
        m = mn; l *= alpha;
#pragma unroll
        for (int i = 0; i < 16; ++i) { float a = o[0][i] * alpha, b = o[1][i] * alpha; OPQ(a); OPQ(b); o[0][i] = a; o[1][i] = b; }
    }
    const float nmb = sel ? -fmaxf(m, -1e20f) * SC_LOG2E : -1e30f;
    float pa[4] = {0.f, 0.f, 0.f, 0.f};
#pragma unroll
    for (int kh = 0; kh < 2; ++kh)
#pragma unroll
        for (int i = 0; i < 16; ++i) {
            float x = __builtin_fmaf(s[kh][i], SC_LOG2E, nmb); OPQ(x);
            const float p = __builtin_amdgcn_exp2f(x);
            float a = pa[i & 3] + p; OPQ(a); pa[i & 3] = a;
            s[kh][i] = p; }
    l += (pa[0] + pa[1]) + (pa[2] + pa[3]);
#pragma unroll
    for (int kh = 0; kh < 2; ++kh)
#pragma unroll
        for (int s2 = 0; s2 < 2; ++s2) {
            u32x4 pw; pw.x = pkbf(s[kh][8 * s2 + 0], s[kh][8 * s2 + 1]); pw.y = pkbf(s[kh][8 * s2 + 2], s[kh][8 * s2 + 3]);
            pw.z = pkbf(s[kh][8 * s2 + 4], s[kh][8 * s2 + 5]); pw.w = pkbf(s[kh][8 * s2 + 6], s[kh][8 * s2 + 7]);
            const bf16x8 pf = __builtin_bit_cast(bf16x8, pw);
            o[0] = MFMA32(vf[kh][s2][0], pf, o[0]); o[1] = MFMA32(vf[kh][s2][1], pf, o[1]);
        }
}
#define TILE_LOOP(T0, T1, ROWOF, KPTR, VPTR, BODY) do { \
    Stg sA_, sB_; const int t1_ = (T1); int t_ = (T0); \
    if (t_ < t1_) stage_load(sA_, KPTR, VPTR, ROWOF(t_), tid); \
    if (t_ + 1 < t1_) stage_load(sB_, KPTR, VPTR, ROWOF(t_ + 1), tid); \
    for (; t_ < t1_; t_ += 2) { \
        { const int ct = t_; const int buf = 0; stage_store(sA_, F.lds, 0, tid); __syncthreads(); if (ct + 2 < t1_) stage_load(sA_, KPTR, VPTR, ROWOF(ct + 2), tid); BODY } \
        if (t_ + 1 < t1_) { const int ct = t_ + 1; const int buf = 1; stage_store(sB_, F.lds, 1, tid); __syncthreads(); if (ct + 2 < t1_) stage_load(sB_, KPTR, VPTR, ROWOF(ct + 2), tid); BODY } \
    } \
    __syncthreads(); } while (0)
DI void write_o_row(bf16* dst, const f32x16 (&o)[2], float scale, int h) {
#pragma unroll
    for (int db = 0; db < 2; ++db)
#pragma unroll
        for (int i4 = 0; i4 < 4; ++i4) {
            u32x2 w; w.x = pkbf(o[db][4 * i4] * scale, o[db][4 * i4 + 1] * scale); w.y = pkbf(o[db][4 * i4 + 2] * scale, o[db][4 * i4 + 3] * scale);
            *(u32x2*)(dst + 32 * db + 8 * i4 + 4 * h) = w;
        }
}

DI void mixa_task(const Frame& F, int task) {
    const int tile32 = task & 31, hb = task >> 5, b = hb & 1, head = hb >> 1;
    const int g = head >> 3, slot = head & 7, lg = 2 * g;
    const int prow0 = tile32 * 256, L = SEQ >> lg, res = prow0 >> (13 - lg), p0 = prow0 & (L - 1);
    const bf16* Q = F.QKVA() + ((size_t)((head) * 2 + b) << 19);
    const bf16* K = F.QKVA() + ((size_t)((24 + head) * 2 + b) << 19);
    const bf16* V = F.QKVA() + ((size_t)((48 + head) * 2 + b) << 19);
    const int w = F.wave, lane = F.lane, r = lane & 31, h = lane >> 5;
    bf16x8 qf[4];
    { const bf16* qr = Q + ((size_t)(prow0 + 32 * w + r) << 6) + 8 * h;
#pragma unroll
      for (int ks = 0; ks < 4; ++ks) qf[ks] = *(const bf16x8*)(qr + 16 * ks); }
    f32x16 o[2] = {zero16(), zero16()}; float m = -1e30f, l = 0.f;
    const int kt0 = (p0 == 0) ? 2 : 0;
    const int tid = F.tid;
#define ROWOF_A(kt) (prow0 - 128 + 64 * (kt))
    TILE_LOOP(kt0, 6, ROWOF_A, K, V, {
        if (ct >= (w >> 1) && ct <= (w >> 1) + 2)
            flash_tile(F.lds + buf * BUFB, F.lds + buf * BUFB + KVT, qf, o, m, l, 128 + 32 * w + r - 64 * ct - 8 * h, 128u, true, lane);
    });
#undef ROWOF_A
    const float lt = xhalf_sum(l);
    const float inv = 1.f / lt;
    const int s = ((p0 + 32 * w + r) << lg) | res;
    const size_t row = (size_t)b * SEQ + s;
    bf16* og = (bf16*)(F.ws + ((g == 0) ? WS_R2 : (g == 1) ? (WS_R2 + 16 * MiB) : WS_WIN));
    write_o_row(og + row * 512 + slot * 64, o, inv, h);
    if (h == 0) F.LSE()[((size_t)g * TOK + row) * 8 + slot] = m * 0.125f + __logf(lt);
}

DI float gelu_tanh(float x) { const float u = 0.7978845608028654f * (x + 0.044715f * x * x * x); const float e = __expf(2.f * u); const float t = 1.f - 2.f / (e + 1.f); return 0.5f * x * (1.f + t); }
DI void compress_task(const Frame& F, int task) {
    const int kv = task >> 5, bg = (task >> 3) & 3, it = task & 7;
    const bf16* A = F.KVB() + ((size_t)(kv * 4 + bg) << 19);
    const bf16* W1T = kv ? F.W1V() : F.W1K(); const bf16* W2T = kv ? F.W2V() : F.W2K(); const float* bias = kv ? F.BIASV() : F.BIASK();
    bf16* OUT = (kv ? F.VC() : F.KC()) + ((size_t)bg << 15);
    const int w = F.wave, lane = F.lane, r = lane & 31, h = lane >> 5;
    LAS unsigned char* hid = F.lds;
    f32x16 acc[2] = {zero16(), zero16()};
    int i0 = 64 * it + r, i1 = i0 + 32; i0 = i0 > 510 ? 510 : i0; i1 = i1 > 510 ? 510 : i1;
    const bf16* a0p = A + (size_t)i0 * 1024 + 8 * h; const bf16* a1p = A + (size_t)i1 * 1024 + 8 * h;
    const bf16* bp = W1T + (size_t)(32 * w + r) * 2048 + 8 * h;
#pragma unroll 4
    for (int k0 = 0; k0 < 2048; k0 += 16) {
        const bf16x8 bfr = *(const bf16x8*)(bp + k0), a0 = *(const bf16x8*)(a0p + k0), a1 = *(const bf16x8*)(a1p + k0);
        acc[0] = MFMA32(a0, bfr, acc[0]); acc[1] = MFMA32(a1, bfr, acc[1]);
    }
    float bs = 0.f;
#pragma unroll
    for (int j = 0; j < 16; ++j) bs += bias[j * 256 + 32 * w + r];
#pragma unroll
    for (int rb = 0; rb < 2; ++rb)
#pragma unroll
        for (int i = 0; i < 16; ++i) { const int row = 32 * rb + (i & 3) + 8 * (i >> 2) + 4 * h;
            *(LAS bf16*)(hid + row * 528 + (32 * w + r) * 2) = (bf16)f2bf(gelu_tanh(acc[rb][i] + bs)); }
    __syncthreads();
    if (w < 4) {
        const int rb = w & 1, cb = w >> 1; f32x16 c = zero16();
        const bf16* b2 = W2T + (size_t)(32 * cb + r) * 256 + 8 * h;
#pragma unroll
        for (int k0 = 0; k0 < 256; k0 += 16) { const bf16x8 a = *(LAS const bf16x8*)(hid + (32 * rb + r) * 528 + (k0 + 8 * h) * 2); const bf16x8 bb = *(const bf16x8*)(b2 + k0); c = MFMA32(a, bb, c); }
#pragma unroll
        for (int i = 0; i < 16; ++i) { const int row = 64 * it + 32 * rb + (i & 3) + 8 * (i >> 2) + 4 * h;
            if (row < 511) OUT[((size_t)row << 6) + 32 * cb + r] = (bf16)f2bf(c[i]); }
    }
    __syncthreads();
}

DI float dpp_quad_sum(float p) {
    p += __builtin_bit_cast(float, __builtin_amdgcn_update_dpp(0, __builtin_bit_cast(int, p), 0xB1, 0xF, 0xF, true));
    p += __builtin_bit_cast(float, __builtin_amdgcn_update_dpp(0, __builtin_bit_cast(int, p), 0x4E, 0xF, 0xF, true));
    return p;
}
DI void imp_tile(LAS const unsigned char* kt, const bf16x8 (&qf)[4], LAS float* ipb, int dq, float mb, float invc, int lane) {
    f32x16 s[2];
    qk_tile(kt, qf, s, lane);
#pragma unroll
    for (int kh = 0; kh < 2; ++kh)
#pragma unroll
        for (int s2 = 0; s2 < 2; ++s2) {
            float ps[8];
#pragma unroll
            for (int j = 0; j < 8; ++j) { const int kk = 32 * kh + 16 * s2 + j; const bool v = (dq - kk) >= 0;
                const float p = v ? __builtin_amdgcn_exp2f(s[kh][8 * s2 + j] * SC_LOG2E - mb) * invc : 0.f; ps[j] = dpp_quad_sum(p); }
            const float sa = (ps[0] + ps[1]) + (ps[2] + ps[3]), sb = (ps[4] + ps[5]) + (ps[6] + ps[7]);
            LAS float* ip = ipb + 8 * kh + 4 * s2;
            if ((lane & 3) == 0) {
                __hip_atomic_fetch_add(ip, sa, __ATOMIC_RELAXED, __HIP_MEMORY_SCOPE_WORKGROUP);
                __hip_atomic_fetch_add(ip + 1, sb + ps[3], __ATOMIC_RELAXED, __HIP_MEMORY_SCOPE_WORKGROUP);
                __hip_atomic_fetch_add(ip + 2, ps[7], __ATOMIC_RELAXED, __HIP_MEMORY_SCOPE_WORKGROUP);
            }
        }
}
DI unsigned wave_umax(unsigned v) {
#define WUM_STEP(ctrl) { const unsigned t = (unsigned)__builtin_amdgcn_update_dpp((int)v, (int)v, (ctrl), 0xF, 0xF, false); v = v > t ? v : t; }
    WUM_STEP(0xB1) WUM_STEP(0x4E) WUM_STEP(0x141) WUM_STEP(0x140)
#undef WUM_STEP
    const unsigned r0 = (unsigned)__builtin_amdgcn_readlane((int)v, 0), r1 = (unsigned)__builtin_amdgcn_readlane((int)v, 16), r2 = (unsigned)__builtin_amdgcn_readlane((int)v, 32), r3 = (unsigned)__builtin_amdgcn_readlane((int)v, 48);
    const unsigned a = r0 > r1 ? r0 : r1, b = r2 > r3 ? r2 : r3;
    return a > b ? a : b;
}
DI void stash_put(LAS f32x4* st, const f32x16 (&y)[2], int tid) {
#pragma unroll
    for (int i = 0; i < 8; ++i) { const f32x16& v = y[i >> 2]; const int q = (i & 3) * 4; st[i * 512 + tid] = (f32x4){v[q], v[q + 1], v[q + 2], v[q + 3]}; }
}
DI void stash_add(LAS const f32x4* st, f32x16 (&y)[2], int tid) {
#pragma unroll
    for (int i = 0; i < 8; ++i) { const f32x4 a = st[i * 512 + tid]; const int q = (i & 3) * 4; f32x16& v = y[i >> 2]; v[q] += a[0]; v[q + 1] += a[1]; v[q + 2] += a[2]; v[q + 3] += a[3]; }
}
DI void nsa_task(const Frame& F, int b, int g, int tt) {
    const int w = F.wave, lane = F.lane, r = lane & 31, h = lane >> 5, tid = F.tid;
    const int t0 = tt * 64, tok = 8 * w + (r >> 2), t = t0 + tok, head = 4 * g + (r & 3);
    const size_t row = (size_t)b * SEQ + t;
    const int bg = b * 2 + g;
    bf16x8 qf[4];
    { const bf16* qr = F.QB() + row * 512 + head * 64 + 8 * h;
#pragma unroll
      for (int ks = 0; ks < 4; ++ks) qf[ks] = *(const bf16x8*)(qr + 16 * ks); }
    float g0, g1, g2;
    { const bf16* gp = F.GB() + row * 32 + head * 3; g0 = sigm(bf2f(gp[0])); g1 = sigm(bf2f(gp[1])); g2 = sigm(bf2f(gp[2])); }
    LAS float* imp = (LAS float*)(F.lds + 2 * BUFB);
    for (int i = tid; i < 64 * 132; i += NTHR) imp[i] = 0.f;
    LAS f32x4* ystash = (LAS f32x4*)(F.lds + 2 * BUFB + 64 * 132 * 4);
    const int nvis = (4 * tt + 3) < 511 ? (4 * tt + 3) : 511, nct = (NSA_SKIP == 3) ? 1 : (nvis + 63) >> 6;
    const bf16* Kc = F.KC() + ((size_t)bg << 15); const bf16* Vc = F.VC() + ((size_t)bg << 15);
    const int lim = (t - 31) >> 4;
    float mc, invc;
    {
        f32x16 o[2] = {zero16(), zero16()}; float m = -1e30f, l = 0.f;
#define ROWOF_T(ct_) (64 * (ct_))
        TILE_LOOP(0, nct, ROWOF_T, Kc, Vc, {
            flash_tile(F.lds + buf * BUFB, F.lds + buf * BUFB + KVT, qf, o, m, l, lim - 64 * ct - 8 * h, 0x7fffffffu, true, lane);
        });
        const float lt = xhalf_sum(l);
        invc = lt > 0.f ? 1.f / lt : 0.f; mc = m;
        o[0] *= (g0 * invc); o[1] *= (g0 * invc); stash_put(ystash, o, tid);
    }
    {
        const float mb = mc * SC_LOG2E;
        TILE_LOOP(0, nct, ROWOF_T, Kc, Vc, { imp_tile(F.lds + buf * BUFB, qf, imp + tok * 132 + 16 * ct + 2 * h, lim - 64 * ct - 8 * h, mb, invc, lane); });
        LDS_WAIT();
        __syncthreads();
    }
    unsigned long long mlo = 0ull, mhi = 0ull;
    if (tt <= 15 || NSA_SKIP == 3) { mlo = (2ull << (tt & 63)) - 1ull; mhi = mlo; }
    else {
        for (int tk = 0; tk < 8; ++tk) {
            LAS const float* rowp = imp + (8 * w + tk) * 132;
            const int ma = lane, mb2 = lane + 64;
            const bool ca = (ma >= 1 && ma <= tt - 2), cb = (mb2 <= tt - 2);
            unsigned ka = ca ? __float_as_uint(rowp[ma]) + 1u : 0u, kb = cb ? __float_as_uint(rowp[mb2]) + 1u : 0u;
            bool sa = false, sb = false;
            for (int it = 0; it < 13; ++it) {
                const unsigned mxk = wave_umax(ka > kb ? ka : kb);
                const unsigned long long ea = __ballot(ka == mxk);
                if (ea != 0ull) { if (lane == (int)__builtin_ctzll(ea)) { sa = true; ka = 0u; } }
                else { const unsigned long long eb = __ballot(kb == mxk); if (lane == (int)__builtin_ctzll(eb)) { sb = true; kb = 0u; } }
            }
            unsigned long long ba = __ballot(sa), bb = __ballot(sb);
            ba |= 1ull;
            if (tt < 64) ba |= 1ull << tt; else bb |= 1ull << (tt - 64);
            if (tt - 1 < 64) ba |= 1ull << (tt - 1); else bb |= 1ull << (tt - 1 - 64);
            if ((r >> 2) == tk) { mlo = ba; mhi = bb; }
        }
    }
    {
        const bf16* Ks = F.KVB() + ((size_t)(2 * 4 + bg) << 19); const bf16* Vs = F.KVB() + ((size_t)(3 * 4 + bg) << 19);
        f32x16 o[2] = {zero16(), zero16()}; float m = -1e30f, l = 0.f;
        TILE_LOOP(0, (NSA_SKIP == 1) ? 1 : tt + 1, ROWOF_T, Ks, Vs, {
            const bool sel = ((ct < 64 ? (mlo >> ct) : (mhi >> (ct - 64))) & 1ull) != 0ull;
            if (__ballot(sel) != 0ull)
                flash_tile(F.lds + buf * BUFB, F.lds + buf * BUFB + KVT, qf, o, m, l, t - 64 * ct - 8 * h, 0x7fffffffu, sel, lane);
        });
        const float lt = xhalf_sum(l); const float sc = g1 / lt;
        o[0] *= sc; o[1] *= sc; stash_add(ystash, o, tid); stash_put(ystash, o, tid);
    }
    {
        const bf16* Kw = F.KVB() + ((size_t)(4 * 4 + bg) << 19); const bf16* Vw = F.KVB() + ((size_t)(5 * 4 + bg) << 19);
        f32x16 o[2] = {zero16(), zero16()}; float m = -1e30f, l = 0.f;
        const int c0 = tt > 8 ? tt - 8 : 0;
        TILE_LOOP((NSA_SKIP == 2) ? tt : c0, tt + 1, ROWOF_T, Kw, Vw, {
            flash_tile(F.lds + buf * BUFB, F.lds + buf * BUFB + KVT, qf, o, m, l, t - 64 * ct - 8 * h, 511u, true, lane);
        });
#undef ROWOF_T
        const float lt = xhalf_sum(l); const float sc = g2 / lt;
        o[0] *= sc; o[1] *= sc; stash_add(ystash, o, tid);
        write_o_row(F.YB() + row * 512 + head * 64, o, 1.f, h);
    }
}

DI void combine_ya_task(const Frame& F, int task) {
    for (int i = task * 4096 + F.tid; i < (task + 1) * 4096; i += NTHR) {
        const int row = i >> 6, ch = i & 63, slot = ch >> 3;
        const float l0 = F.LSE()[((size_t)0 * TOK + row) * 8 + slot], l1 = F.LSE()[((size_t)1 * TOK + row) * 8 + slot], l2 = F.LSE()[((size_t)2 * TOK + row) * 8 + slot];
        const float mx = fmaxf(l0, fmaxf(l1, l2)); float w0 = __expf(l0 - mx), w1 = __expf(l1 - mx), w2 = __expf(l2 - mx);
        const float inv = 1.f / (w0 + w1 + w2); w0 *= inv; w1 *= inv; w2 *= inv;
        const size_t off = (size_t)row * 512 + ch * 8;
        const u32x4 a = __builtin_nontemporal_load((const u32x4*)(F.OG0() + off)), bb = __builtin_nontemporal_load((const u32x4*)(F.OG1() + off)), c = __builtin_nontemporal_load((const u32x4*)(F.OG2() + off));
        u32x4 o;
#pragma unroll
        for (int e = 0; e < 4; ++e) {
            const float lo = w0 * pg8::bf_lo(a[e]) + w1 * pg8::bf_lo(bb[e]) + w2 * pg8::bf_lo(c[e]);
            const float hi = w0 * pg8::bf_hi(a[e]) + w1 * pg8::bf_hi(bb[e]) + w2 * pg8::bf_hi(c[e]);
            o[e] = pk2(lo, hi);
        }
        *(u32x4*)(F.YA() + off) = o;
    }
}

#define XB_TMO      128
#define XB_XCNT(j)  (256  + 64 * (j))
#define XB_XSUB(j)  (1280 + 64 * (j))
#define XB_XGEN(j)  (2304 + 64 * (j))
#define XB_TOP      3328
#define XB_TOPGEN   3392
#define XCD_BAR_WORDS 3456
#define XB_SPIN_CAP (1u << 18)

__device__ __forceinline__ unsigned xb_ld(unsigned* p)              { return __hip_atomic_load(p, __ATOMIC_RELAXED, __HIP_MEMORY_SCOPE_AGENT); }
__device__ __forceinline__ unsigned xb_add(unsigned* p, unsigned v) { return __hip_atomic_fetch_add(p, v, __ATOMIC_RELAXED, __HIP_MEMORY_SCOPE_AGENT); }
__device__ __forceinline__ unsigned xb_xcc_id() { return (unsigned)__builtin_amdgcn_s_getreg((3 << 11) | 20) & 0xFu; }
#define XB_SPIN(cond, bar) do { unsigned _sp = 0; while (cond) { __builtin_amdgcn_s_sleep(1); \
    if ((++_sp & 255u) == 0u) { if (xb_ld(&(bar)[XB_TMO])) break; if (_sp > XB_SPIN_CAP) { atomicAdd(&(bar)[XB_TMO], 1u); break; } } } } while (0)
struct XcdBarrier {
    unsigned* bar; unsigned x;
    volatile LAS unsigned* st;
};

__device__ __forceinline__ XcdBarrier xcd_barrier_post(unsigned* bar, volatile LAS unsigned* st) {
    XcdBarrier b; b.bar = bar; b.x = xb_xcc_id(); b.st = st;
    if (threadIdx.x == 0) (void)xb_add(&bar[XB_XCNT(b.x)], 1u);
    return b;
}
__device__ __forceinline__ void xcd_barrier_complete(unsigned* bar, unsigned x, unsigned& nloc, unsigned& nx) {
    const unsigned G = gridDim.x * gridDim.y * gridDim.z;
    unsigned sum, cnt, mine, sp = 0u;
    for (;;) {
        sum = 0u; cnt = 0u; mine = 0u;
#pragma unroll
        for (unsigned j = 0; j < 16; ++j) { const unsigned c = xb_ld(&bar[XB_XCNT(j)]); sum += c; cnt += (c > 0u) ? 1u : 0u; mine = (j == x) ? c : mine; }
        if (sum == G) break;
        __builtin_amdgcn_s_sleep(1);
        if ((++sp & 255u) == 0u) { if (xb_ld(&bar[XB_TMO])) break; if (sp > XB_SPIN_CAP) { atomicAdd(&bar[XB_TMO], 1u); break; } }
    }
    nloc = mine > 0u ? mine : 1u; nx = cnt > 0u ? cnt : 1u;
}

__device__ __forceinline__ void xcd_barrier(const XcdBarrier& b) {
    asm volatile("s_waitcnt vmcnt(0)" ::: "memory");
    __syncthreads();
    if (threadIdx.x == 0) {
        unsigned* bar = b.bar;
        __builtin_amdgcn_s_waitcnt(0);
        unsigned nloc = b.st[0], nx = b.st[1];
        if (nloc == 0u) { xcd_barrier_complete(bar, b.x, nloc, nx); b.st[0] = nloc; b.st[1] = nx; }
        const unsigned old = xb_add(&bar[XB_XSUB(b.x)], 1u);
        const unsigned gen = old / nloc;
        if (old + 1u == (gen + 1u) * nloc) {
            __builtin_amdgcn_fence(__ATOMIC_RELEASE, "agent");
            asm volatile("s_waitcnt vmcnt(0)" ::: "memory");
            const unsigned og = xb_add(&bar[XB_TOP], 1u);
            const unsigned tg = og / nx;
            if (og + 1u == (tg + 1u) * nx) xb_add(&bar[XB_TOPGEN], 1u);
            else XB_SPIN(xb_ld(&bar[XB_TOPGEN]) == tg, bar);
            __builtin_amdgcn_fence(__ATOMIC_ACQUIRE, "agent");
            xb_add(&bar[XB_XGEN(b.x)], 1u);
            asm volatile("s_waitcnt vmcnt(0)" ::: "memory");
        } else {
            XB_SPIN(xb_ld(&bar[XB_XGEN(b.x)]) == gen, bar);
            __builtin_amdgcn_fence(__ATOMIC_ACQUIRE, "agent");
            asm volatile("s_waitcnt vmcnt(0)" ::: "memory");
        }
    }
    __syncthreads();
}

#ifndef PH_MAX
#define PH_MAX 99
#endif
#ifndef P3_TTILES
#define P3_TTILES 512
#endif
#ifndef PROBE_PH
#define PROBE_PH 0
#endif
#ifndef REPEAT_PH
#define REPEAT_PH 0
#endif
#define REP(k) for (int rep_ = 0; rep_ < ((REPEAT_PH == (k)) ? 2 : 1); ++rep_)
__global__ void __launch_bounds__(NTHR) fwd_mega(Args args) {
    extern __shared__ __attribute__((aligned(16))) unsigned char lds_raw[];
    cg::grid_group grid = cg::this_grid();
    Frame F;
    F.lds = (LAS unsigned char*)lds_raw; F.tid = threadIdx.x; F.lane = F.tid & 63; F.wave = __builtin_amdgcn_readfirstlane(F.tid >> 6); F.G = gridDim.x; F.bid = blockIdx.x;
    F.x = args.in[0]; F.g_mix = args.in[1]; F.w_in = args.in[2]; F.pos_k = args.in[3]; F.w1_k = args.in[4]; F.w2_k = args.in[5]; F.pos_v = args.in[6]; F.w1_v = args.in[7]; F.w2_v = args.in[8];
    F.w_a = args.in[9]; F.w_b = args.in[10]; F.w_out = args.in[11]; F.g_mlp = args.in[12]; F.w_up = args.in[13]; F.w_down = args.in[14]; F.g_fin = args.in[15];
    F.out = args.out; F.ws = args.ws;
    unsigned char* ws = args.ws;
    PG8_LAS unsigned char* glds = (PG8_LAS unsigned char*)lds_raw;
    volatile LAS unsigned* xst = (volatile LAS unsigned*)(F.lds + LDS_BYTES - 16);
    if (F.tid < 4) xst[F.tid] = 0u;
    __syncthreads();
    XcdBarrier xbar = xcd_barrier_post((unsigned*)ws, xst);
    if (args.ws == nullptr) grid.sync();
    const int gw = F.bid * 8 + F.wave, NGW = F.G * 8;

#if PROBE_PH
    unsigned long long stamp_[16]; int ns_ = 1; stamp_[0] = __builtin_amdgcn_s_memrealtime();
#endif
    REP(9) p0_prologue(F);
#if REPEAT_PH == 10
    for (int q_ = 0; q_ < 10; ++q_) grid.sync();
#endif
    xcd_barrier(xbar);
#if PROBE_PH
    stamp_[ns_ < 15 ? ns_ : 15] = __builtin_amdgcn_s_memrealtime(); ++ns_;
#endif
    asm volatile("" : "+v"(F.tid), "+v"(F.lane));
    if (PH_MAX >= 1) REP(1) {
        pg8::Gemm gm{F.U(), F.WIN(), TOK, NIN, DM}; pg8::StaticOrder S; S.init(TOK, NIN, F.G, F.bid);
        pg8::EpiInProj E{F.QKVA(), F.QB(), F.KVB(), F.GM(), F.GB(), F.CS()};
        pg8::gemm_phase<pg8::EpiInProj, pg8::StaticOrder, true, true>(glds, gm, S, E);
    }
    xcd_barrier(xbar);
#if PROBE_PH
    stamp_[ns_ < 15 ? ns_ : 15] = __builtin_amdgcn_s_memrealtime(); ++ns_;
#endif
    asm volatile("" : "+v"(F.tid), "+v"(F.lane));
    if (PH_MAX >= 2) REP(2) {
        unsigned* qctr = (unsigned*)ws + 3520 + 64 * rep_;
        volatile LAS int* qslot = (volatile LAS int*)(F.lds + LDS_BYTES - 8);
        for (;;) {
            if (F.tid == 0) *qslot = (int)__hip_atomic_fetch_add(qctr, 1u, __ATOMIC_RELAXED, __HIP_MEMORY_SCOPE_AGENT);
            __syncthreads();
            const int task = *qslot;
            __syncthreads();
            if (task >= 1600 + 128) break;
            if (task < 64) compress_task(F, task);
            else if (task < 1600) mixa_task(F, task - 64);
            else { int r = task - 1600;
                if (!ttile_job(r, F.w_a, 1024, 0, 1024, 512, F.WA(), 0, F.lds, F.tid)) if (!ttile_job(r, F.w_b, 1024, 0, 1024, 512, F.WB(), 0, F.lds, F.tid)) ttile_job(r, F.w_out, 1024, 0, 1024, 1024, F.WO(), 0, F.lds, F.tid); }
        }
    }
    xcd_barrier(xbar);
#if PROBE_PH
    stamp_[ns_ < 15 ? ns_ : 15] = __builtin_amdgcn_s_memrealtime(); ++ns_;
#endif
    asm volatile("" : "+v"(F.tid), "+v"(F.lane));
    if (PH_MAX >= 3) REP(3) {
        unsigned* qctr = (unsigned*)ws + 3520 + 128 + 64 * rep_;
        volatile LAS int* qslot = (volatile LAS int*)(F.lds + LDS_BYTES - 8);
        for (;;) {
            if (F.tid == 0) *qslot = (int)__hip_atomic_fetch_add(qctr, 1u, __ATOMIC_RELAXED, __HIP_MEMORY_SCOPE_AGENT);
            __syncthreads();
            const int task = *qslot;
            __syncthreads();
            if (task >= 512 + 256 + P3_TTILES) break;
            if (task < 512) { const int bg = task & 3; nsa_task(F, bg >> 1, bg & 1, 127 - (task >> 2)); }
            else if (task < 768) combine_ya_task(F, task - 512);
            else { int r = task - 768;
                if (!ttile_job(r, F.w_up, 4096, 0, 4096, DM, F.WUP(), 0, F.lds, F.tid)) ttile_job(r, F.w_down, 1024, 0, 1024, FF, F.WDN(), 0, F.lds, F.tid); }
        }
    }
    xcd_barrier(xbar);
#if PROBE_PH
    stamp_[ns_ < 15 ? ns_ : 15] = __builtin_amdgcn_s_memrealtime(); ++ns_;
#endif
    asm volatile("" : "+v"(F.tid), "+v"(F.lane));
    if (PH_MAX >= 4) REP(4) {
        pg8::StaticOrder S; S.init(TOK, DM, F.G, F.bid);
        { pg8::Gemm gm{F.YA(), F.WA(), TOK, DM, 512}; pg8::EpiMerge<1> E{F.GM(), F.TMP(), F.MERGED()}; pg8::gemm_phase<pg8::EpiMerge<1>, pg8::StaticOrder, true, true>(glds, gm, S, E); }
        { pg8::Gemm gm{F.YB(), F.WB(), TOK, DM, 512}; pg8::EpiMerge<2> E{F.GM(), F.TMP(), F.MERGED()}; pg8::gemm_phase<pg8::EpiMerge<2>, pg8::StaticOrder, true, true>(glds, gm, S, E); }
    }
    xcd_barrier(xbar);
#if PROBE_PH
    stamp_[ns_ < 15 ? ns_ : 15] = __builtin_amdgcn_s_memrealtime(); ++ns_;
#endif
    asm volatile("" : "+v"(F.tid), "+v"(F.lane));
    if (PH_MAX >= 5) REP(5) {
        pg8::StaticOrder S; S.init(TOK, DM, F.G, F.bid);
        pg8::Gemm gm{F.MERGED(), F.WO(), TOK, DM, DM}; pg8::EpiResNormPrep E{F.x, F.X1B(), F.U(), F.g_mlp, F.SSP()}; pg8::gemm_phase<pg8::EpiResNormPrep, pg8::StaticOrder, true, true>(glds, gm, S, E);
    }
    xcd_barrier(xbar);
#if PROBE_PH
    stamp_[ns_ < 15 ? ns_ : 15] = __builtin_amdgcn_s_memrealtime(); ++ns_;
#endif
    asm volatile("" : "+v"(F.tid), "+v"(F.lane));
    if (PH_MAX >= 7) REP(7) {
        pg8::StaticOrder S; S.init(TOK, FF, F.G, F.bid);
        pg8::Gemm gm{F.U(), F.WUP(), TOK, FF, DM}; pg8::EpiRelu2 E{F.H(), FF, F.SSP()}; pg8::gemm_phase<pg8::EpiRelu2, pg8::StaticOrder, true, true>(glds, gm, S, E);
    }
    xcd_barrier(xbar);
#if PROBE_PH
    stamp_[ns_ < 15 ? ns_ : 15] = __builtin_amdgcn_s_memrealtime(); ++ns_;
#endif
    asm volatile("" : "+v"(F.tid), "+v"(F.lane));
    if (PH_MAX >= 8) REP(8) {
        pg8::StaticOrder S; S.init(TOK, DM, F.G, F.bid);
        pg8::Gemm gm{F.H(), F.WDN(), TOK, DM, FF}; pg8::EpiResBf16In E{F.X1B(), F.U(), DM}; pg8::gemm_phase<pg8::EpiResBf16In, pg8::StaticOrder, true, true>(glds, gm, S, E);
    }
    xcd_barrier(xbar);
#if PROBE_PH
    stamp_[ns_ < 15 ? ns_ : 15] = __builtin_amdgcn_s_memrealtime(); ++ns_;
#endif
    asm volatile("" : "+v"(F.tid), "+v"(F.lane));
    for (int m = gw; m < TOK; m += NGW) rms_row_bf16_to_f32(F.U() + (size_t)m * DM, F.g_fin, F.out + (size_t)m * DM, F.lane);
#if PROBE_PH
    xcd_barrier(xbar);
    stamp_[ns_ < 15 ? ns_ : 15] = __builtin_amdgcn_s_memrealtime();
    if (F.bid == 0 && F.tid == 0) { const float us_ = (float)(unsigned)(stamp_[PROBE_PH] - stamp_[PROBE_PH - 1]) * 0.01f; F.out[0] = 1000.f * __builtin_amdgcn_exp2f(__builtin_rintf(6.f * __builtin_amdgcn_logf(us_)) * (1.f / 6.f)); }
#endif
}

extern "C" void kernel_launch(void* const* d_in, const int* in_sizes, int n_in, void* d_out, int out_size, void* d_ws, size_t ws_size, hipStream_t stream) {
    static int grid = 0;
    if (grid == 0) {
        if (n_in != 16 || out_size != TOK * DM || ws_size < WS_END) { fprintf(stderr, "kernel_launch: unexpected shapes (n_in %d out %d ws %zu)\n", n_in, out_size, ws_size); grid = -1; return; }
        int dev = 0, cus = 0, per_cu = 0;
        hipGetDevice(&dev); hipDeviceGetAttribute(&cus, hipDeviceAttributeMultiprocessorCount, dev);
        hipFuncSetAttribute((const void*)fwd_mega, hipFuncAttributeMaxDynamicSharedMemorySize, LDS_BYTES);
        if (hipOccupancyMaxActiveBlocksPerMultiprocessor(&per_cu, (const void*)fwd_mega, NTHR, LDS_BYTES) != hipSuccess || per_cu < 1) { fprintf(stderr, "kernel_launch: occupancy query gave %d\n", per_cu); per_cu = 1; }
        (void)hipGetLastError();
        grid = cus * 1;
    }
    if (grid < 0) return;
    if (hipMemsetAsync(d_ws, 0, 16384, stream) != hipSuccess) { fprintf(stderr, "kernel_launch: memset of barrier words failed\n"); return; }
    Args a{};
    for (int i = 0; i < 16; ++i) a.in[i] = (const float*)d_in[i];
    a.out = (float*)d_out; a.ws = (unsigned char*)d_ws;
    void* kargs[] = {&a};
    hipError_t e = hipLaunchCooperativeKernel((const void*)fwd_mega, dim3(grid), dim3(NTHR), kargs, LDS_BYTES, stream);
    if (e != hipSuccess) fprintf(stderr, "cooperative launch failed: %s (grid %d)\n", hipGetErrorString(e), grid);
}
```

```cpp
#include <hip/hip_runtime.h>
#include <hip/hip_cooperative_groups.h>
#include <cstdio>
#include <cstdint>
namespace cg = cooperative_groups;

namespace pg8 {
#define PG8_LAS __attribute__((address_space(3)))
typedef unsigned short bf16_t;
typedef short bf16x8 __attribute__((ext_vector_type(8)));
typedef float f32x4 __attribute__((ext_vector_type(4)));
typedef unsigned u32x4 __attribute__((ext_vector_type(4)));
constexpr int BM = 256, BK = 64, HALF = 128, HTB = HALF * BK * 2  , STAGE_BYTES = 8 * HTB, NXCD = 8, WGM = 8;

__host__ __device__ __forceinline__ int lds_byte(int r, int c) { const int st = (r >> 4) * 2 + (c >> 5), rr = r & 15, cc = c & 31, ob = rr * 64 + cc * 2; return st * 1024 + (ob ^ (((ob >> 9) & 1) << 5)); }
__host__ __device__ __forceinline__ void stage_rc(int b, int& R, int& C) { const int st = b / 1024, sb = b % 1024, swz = sb ^ (((sb >> 9) & 1) << 5); R = (st >> 1) * 16 + swz / 64; C = (st & 1) * 32 + (swz % 64) / 2; }
__host__ __device__ __forceinline__ int perm32(int rho) { const int n = rho >> 4, i = rho & 15; return 8 * (i >> 2) + 4 * n + (i & 3); }

struct Unit { int pm, pn; };
struct Gemm { const bf16_t* A; const bf16_t* Bt; int M, N, K; };

struct StaticOrder {
    int nM, nN, nwg, G, c;
    __host__ __device__ void init(int M, int N, int G_, int c_) { nM = M / BM; nN = N / BM; nwg = nM * nN; G = G_; c = c_; }
    __host__ __device__ bool next(int i, Unit& u) const {
        const long L = (long)i * G + c; if (L >= nwg) return false;
        int wgid = (int)L; { const int q = nwg / NXCD, r = nwg % NXCD, xcd = wgid % NXCD, off = wgid / NXCD; wgid = (xcd < r ? xcd * (q + 1) : r * (q + 1) + (xcd - r) * q) + off; }
        const int nig = WGM * nN, gid = wgid / nig, fm = gid * WGM, gsz = (nM - fm) < WGM ? (nM - fm) : WGM;
        u.pm = fm + ((wgid % nig) % gsz); u.pn = (wgid % nig) / gsz; return true;
    }
    __device__ __forceinline__ void a_ready(const Unit&) const {}
    __device__ __forceinline__ void done(const Unit&) const {}
};

__device__ __forceinline__ unsigned cvt_pk_bf16(float lo, float hi) { unsigned r; asm volatile("v_cvt_pk_bf16_f32 %0, %1, %2" : "=v"(r) : "v"(lo), "v"(hi)); return r; }
__device__ __forceinline__ float bf_lo(unsigned w) { return __builtin_bit_cast(float, w << 16); }
__device__ __forceinline__ float bf_hi(unsigned w) { return __builtin_bit_cast(float, w & 0xffff0000u); }
__device__ __forceinline__ float sigmoidf_(float x) { return __builtin_amdgcn_rcpf(1.f + __expf(-x)); }

struct EpiInProj {
    static constexpr bool PERM = true, AFTER_DRAIN = false;
    bf16_t* qkva; bf16_t* qb; bf16_t* kvb; bf16_t* gm; bf16_t* gb; const float* cs;
    __device__ __forceinline__ void operator()(const f32x4 (&acc)[2][2][4][2], const Unit& u, int wr, int wc, int fr, int fq) const {
        const int pn = u.pn;
        const int row0 = u.pm * BM + wr * 64 + fr;
        const bool rope_wave = !(wc & 1);
#pragma unroll
        for (int ai = 0; ai < 2; ++ai)
#pragma unroll
            for (int m = 0; m < 4; ++m) {
                const int row = row0 + ai * HALF + m * 16; const int b = row >> 13, s = row & 8191;
                f32x4 c0, c1, s0, s1;
                { const f32x4* t = (const f32x4*)(cs + (size_t)s * 16); c0 = t[0]; c1 = t[1]; s0 = t[2]; s1 = t[3]; }
#pragma unroll
                for (int bj = 0; bj < 2; ++bj) {
                    const int c = pn * BM + bj * HALF + wc * 32 + 8 * fq;
                    f32x4 v0 = acc[ai][bj][m][0], v1 = acc[ai][bj][m][1];
                    bool rope; bf16_t* dst;
                    if (pn < 18) { const int which = c / 1536, hc = c - which * 1536, head = hc >> 6, d0 = hc & 63, lg = (head >> 3) * 2;
                        const int prow = ((s & ((1 << lg) - 1)) << (13 - lg)) | (s >> lg);
                        dst = qkva + ((size_t)((((which * 24 + head) * 2 + b) << 13) + prow) << 6) + d0; rope = (pn < 12); }
                    else if (pn < 20) { dst = qb + (size_t)row * 512 + (c - 4608); rope = true; }
                    else if (pn < 23) { const int cc = c - 5120, j = cc >> 7, g = (cc >> 6) & 1, d0 = cc & 63;
                        dst = kvb + ((size_t)((((j * 4 + b * 2 + g)) << 13) + s) << 6) + d0; rope = (bj == 0); }
                    else if (pn < 31) { dst = gm + (size_t)row * 2048 + (c - 5888); rope = false; }
                    else { dst = gb + (size_t)row * 32 + (c - 7936); rope = false; }
                    if (rope && rope_wave) {
                        f32x4 p0, p1;
#pragma unroll
                        for (int e = 0; e < 4; ++e) { p0[e] = __shfl_xor(v0[e], 16); p1[e] = __shfl_xor(v1[e], 16); }
                        if (fq == 0) { v0 = v0 * c0 - p0 * s0; v1 = v1 * c1 - p1 * s1; }
                        else if (fq == 1) { v0 = v0 * c0 + p0 * s0; v1 = v1 * c1 + p1 * s1; }
                    }
                    if (pn < 31 || (bj == 0 && wc == 0)) {
                        u32x4 w; w.x = cvt_pk_bf16(v0[0], v0[1]); w.y = cvt_pk_bf16(v0[2], v0[3]); w.z = cvt_pk_bf16(v1[0], v1[1]); w.w = cvt_pk_bf16(v1[2], v1[3]);
                        *(u32x4*)dst = w; }
                }
            }
    }
};
template <int STEP> struct EpiMerge {
    static constexpr bool PERM = true, AFTER_DRAIN = false;
    const bf16_t* gm; float* tmp; bf16_t* merged;
    __device__ __forceinline__ void operator()(const f32x4 (&acc)[2][2][4][2], const Unit& u, int wr, int wc, int fr, int fq) const {
        const int row0 = u.pm * BM + wr * 64 + fr, col0 = u.pn * BM + wc * 32 + 8 * fq;
#pragma unroll
        for (int ai = 0; ai < 2; ++ai)
#pragma unroll
            for (int m = 0; m < 4; ++m)
#pragma unroll
                for (int bj = 0; bj < 2; ++bj) {
                    const int row = row0 + ai * HALF + m * 16, c = col0 + bj * HALF;
                    const u32x4 g = __builtin_nontemporal_load((const u32x4*)(gm + (size_t)row * 2048 + (STEP - 1) * 1024 + c));
                    f32x4 v0 = acc[ai][bj][m][0], v1 = acc[ai][bj][m][1];
                    v0[0] *= sigmoidf_(bf_lo(g.x)); v0[1] *= sigmoidf_(bf_hi(g.x)); v0[2] *= sigmoidf_(bf_lo(g.y)); v0[3] *= sigmoidf_(bf_hi(g.y));
                    v1[0] *= sigmoidf_(bf_lo(g.z)); v1[1] *= sigmoidf_(bf_hi(g.z)); v1[2] *= sigmoidf_(bf_lo(g.w)); v1[3] *= sigmoidf_(bf_hi(g.w));
                    bf16_t* tp = (bf16_t*)tmp + (size_t)row * 1024 + c;
                    if (STEP == 1) { u32x4 w; w.x = cvt_pk_bf16(v0[0], v0[1]); w.y = cvt_pk_bf16(v0[2], v0[3]); w.z = cvt_pk_bf16(v1[0], v1[1]); w.w = cvt_pk_bf16(v1[2], v1[3]); *(u32x4*)tp = w; }
                    else { const u32x4 t = __builtin_nontemporal_load((const u32x4*)tp); v0[0] += bf_lo(t.x); v0[1] += bf_hi(t.x); v0[2] += bf_lo(t.y); v0[3] += bf_hi(t.y); v1[0] += bf_lo(t.z); v1[1] += bf_hi(t.z); v1[2] += bf_lo(t.w); v1[3] += bf_hi(t.w);
                        u32x4 w; w.x = cvt_pk_bf16(v0[0], v0[1]); w.y = cvt_pk_bf16(v0[2], v0[3]); w.z = cvt_pk_bf16(v1[0], v1[1]); w.w = cvt_pk_bf16(v1[2], v1[3]);
                        *(u32x4*)(merged + (size_t)row * 1024 + c) = w; }
                    __builtin_amdgcn_sched_barrier(0);
                }
    }
};
struct EpiResF32 {
    static constexpr bool PERM = true, AFTER_DRAIN = false;
    const float* res; float* out; int ldc;
    __device__ __forceinline__ void operator()(const f32x4 (&acc)[2][2][4][2], const Unit& u, int wr, int wc, int fr, int fq) const {
        const int row0 = u.pm * BM + wr * 64 + fr, col0 = u.pn * BM + wc * 32 + 8 * fq;
#pragma unroll
        for (int ai = 0; ai < 2; ++ai)
#pragma unroll
            for (int m = 0; m < 4; ++m)
#pragma unroll
                for (int bj = 0; bj < 2; ++bj) {
                    const size_t off = (size_t)(row0 + ai * HALF + m * 16) * ldc + col0 + bj * HALF;
                    const f32x4 r0 = *(const f32x4*)(res + off), r1 = *(const f32x4*)(res + off + 4);
                    *(f32x4*)(out + off) = r0 + acc[ai][bj][m][0]; *(f32x4*)(out + off + 4) = r1 + acc[ai][bj][m][1];
                    __builtin_amdgcn_sched_barrier(0);
                }
    }
};
struct EpiResBf16 {
    static constexpr bool PERM = true, AFTER_DRAIN = false;
    const float* res; bf16_t* O; int ldc;
    __device__ __forceinline__ void operator()(const f32x4 (&acc)[2][2][4][2], const Unit& u, int wr, int wc, int fr, int fq) const {
        const int row0 = u.pm * BM + wr * 64 + fr, col0 = u.pn * BM + wc * 32 + 8 * fq;
#pragma unroll
        for (int ai = 0; ai < 2; ++ai)
#pragma unroll
            for (int m = 0; m < 4; ++m)
#pragma unroll
                for (int bj = 0; bj < 2; ++bj) {
                    const size_t off = (size_t)(row0 + ai * HALF + m * 16) * ldc + col0 + bj * HALF;
                    const f32x4 v0 = *(const f32x4*)(res + off) + acc[ai][bj][m][0], v1 = *(const f32x4*)(res + off + 4) + acc[ai][bj][m][1];
                    u32x4 w; w.x = cvt_pk_bf16(v0[0], v0[1]); w.y = cvt_pk_bf16(v0[2], v0[3]); w.z = cvt_pk_bf16(v1[0], v1[1]); w.w = cvt_pk_bf16(v1[2], v1[3]);
                    *(u32x4*)(O + off) = w;
                    __builtin_amdgcn_sched_barrier(0);
                }
    }
};
struct EpiResBf16In {
    static constexpr bool PERM = true, AFTER_DRAIN = false;
    const bf16_t* res; bf16_t* O; int ldc;
    __device__ __forceinline__ void operator()(const f32x4 (&acc)[2][2][4][2], const Unit& u, int wr, int wc, int fr, int fq) const {
        const int row0 = u.pm * BM + wr * 64 + fr, col0 = u.pn * BM + wc * 32 + 8 * fq;
#pragma unroll
        for (int ai = 0; ai < 2; ++ai)
#pragma unroll
            for (int m = 0; m < 4; ++m)
#pragma unroll
                for (int bj = 0; bj < 2; ++bj) {
                    const size_t off = (size_t)(row0 + ai * HALF + m * 16) * ldc + col0 + bj * HALF;
                    const u32x4 r = __builtin_nontemporal_load((const u32x4*)(res + off));
                    f32x4 v0 = acc[ai][bj][m][0], v1 = acc[ai][bj][m][1];
                    v0[0] += bf_lo(r.x); v0[1] += bf_hi(r.x); v0[2] += bf_lo(r.y); v0[3] += bf_hi(r.y); v1[0] += bf_lo(r.z); v1[1] += bf_hi(r.z); v1[2] += bf_lo(r.w); v1[3] += bf_hi(r.w);
                    u32x4 w; w.x = cvt_pk_bf16(v0[0], v0[1]); w.y = cvt_pk_bf16(v0[2], v0[3]); w.z = cvt_pk_bf16(v1[0], v1[1]); w.w = cvt_pk_bf16(v1[2], v1[3]);
                    *(u32x4*)(O + off) = w;
                    __builtin_amdgcn_sched_barrier(0);
                }
    }
};
struct EpiResNormPrep {
    static constexpr bool PERM = true, AFTER_DRAIN = false;
    const float* res; bf16_t* X1; bf16_t* U; const float* g; float* part;
    __device__ __forceinline__ void operator()(const f32x4 (&acc)[2][2][4][2], const Unit& u, int wr, int wc, int fr, int fq) const {
        const int row0 = u.pm * BM + wr * 64 + fr, col0 = u.pn * BM + wc * 32 + 8 * fq;
#pragma unroll
        for (int ai = 0; ai < 2; ++ai)
#pragma unroll
            for (int m = 0; m < 4; ++m) {
                const int row = row0 + ai * HALF + m * 16; float ss = 0.f;
#pragma unroll
                for (int bj = 0; bj < 2; ++bj) {
                    const size_t off = (size_t)row * 1024 + col0 + bj * HALF;
                    const f32x4 v0 = __builtin_nontemporal_load((const f32x4*)(res + off)) + acc[ai][bj][m][0], v1 = __builtin_nontemporal_load((const f32x4*)(res + off + 4)) + acc[ai][bj][m][1];
                    const f32x4 g0 = *(const f32x4*)(g + col0 + bj * HALF), g1 = *(const f32x4*)(g + col0 + bj * HALF + 4);
                    ss += (v0[0] * v0[0] + v0[1] * v0[1]) + (v0[2] * v0[2] + v0[3] * v0[3]) + (v1[0] * v1[0] + v1[1] * v1[1]) + (v1[2] * v1[2] + v1[3] * v1[3]);
                    u32x4 w; w.x = cvt_pk_bf16(v0[0], v0[1]); w.y = cvt_pk_bf16(v0[2], v0[3]); w.z = cvt_pk_bf16(v1[0], v1[1]); w.w = cvt_pk_bf16(v1[2], v1[3]);
                    *(u32x4*)(X1 + off) = w;
                    u32x4 y; y.x = cvt_pk_bf16(v0[0] * g0[0], v0[1] * g0[1]); y.y = cvt_pk_bf16(v0[2] * g0[2], v0[3] * g0[3]); y.z = cvt_pk_bf16(v1[0] * g1[0], v1[1] * g1[1]); y.w = cvt_pk_bf16(v1[2] * g1[2], v1[3] * g1[3]);
                    *(u32x4*)(U + off) = y;
                }
                ss += __shfl_xor(ss, 16); ss += __shfl_xor(ss, 32);
                if (fq == 0) part[(size_t)row * 16 + u.pn * 4 + wc] = ss;
                __builtin_amdgcn_sched_barrier(0);
            }
    }
};
struct EpiRelu2 {
    static constexpr bool PERM = true, AFTER_DRAIN = false;
    bf16_t* O; int ldc; const float* part;
    __device__ __forceinline__ void operator()(const f32x4 (&acc)[2][2][4][2], const Unit& u, int wr, int wc, int fr, int fq) const {
        const int row0 = u.pm * BM + wr * 64 + fr, col0 = u.pn * BM + wc * 32 + 8 * fq;
#pragma unroll
        for (int ai = 0; ai < 2; ++ai)
#pragma unroll
            for (int m = 0; m < 4; ++m) {
                const f32x4* pp = (const f32x4*)(part + (size_t)(row0 + ai * HALF + m * 16) * 16);
                const f32x4 s4 = (pp[0] + pp[1]) + (pp[2] + pp[3]);
                const float rstd = 1.f / sqrtf(((s4[0] + s4[1]) + (s4[2] + s4[3])) * (1.f / 1024.f) + 1e-6f);
#pragma unroll
                for (int bj = 0; bj < 2; ++bj) {
                    f32x4 v0 = acc[ai][bj][m][0], v1 = acc[ai][bj][m][1];
#pragma unroll
                    for (int e = 0; e < 4; ++e) { const float a = fmaxf(v0[e] * rstd, 0.f), b = fmaxf(v1[e] * rstd, 0.f); v0[e] = a * a; v1[e] = b * b; }
                    u32x4 w; w.x = cvt_pk_bf16(v0[0], v0[1]); w.y = cvt_pk_bf16(v0[2], v0[3]); w.z = cvt_pk_bf16(v1[0], v1[1]); w.w = cvt_pk_bf16(v1[2], v1[3]);
                    *(u32x4*)(O + (size_t)(row0 + ai * HALF + m * 16) * ldc + col0 + bj * HALF) = w;
                    __builtin_amdgcn_sched_barrier(0);
                }
            }
    }
};

template <class Epi, class Sched, bool ALIGN_EPI = false, bool SP2 = false>
__device__ __forceinline__ void gemm_phase(PG8_LAS unsigned char* lds, const Gemm g, const Sched& S, const Epi& E) {
    int tid_ = threadIdx.x; asm volatile("" : "+v"(tid_));
    const int tid = tid_, wid = __builtin_amdgcn_readfirstlane(tid >> 6), lane = tid & 63, wr = wid >> 2, wc = wid & 3, fr = lane & 15, fq = lane >> 4;
    const int K = g.K, nt = K / BK;
    unsigned voffA[2], voffB[2];
#pragma unroll
    for (int i = 0; i < 2; ++i) { int R, C; stage_rc(tid * 16 + i * 8192, R, C); const int Rb = Epi::PERM ? ((R & ~31) + perm32(R & 31)) : R;
        voffA[i] = (unsigned)(R * K + C) * 2u; voffB[i] = (unsigned)(Rb * K + C) * 2u; }
    const size_t kstep = (size_t)(BK * 2);
    const size_t hstep = (size_t)HALF * K * 2;
    const size_t tstep = 2 * hstep;
    const unsigned ldsw = (unsigned)wid * 1024u;
    const int aoff = lds_byte(wr * 64 + fr, fq * 8), boff = lds_byte(wc * 32 + fr, fq * 8);
#define PG8_SA(b, h) (((b) * 2 + (h)) * HTB)
#define PG8_SB(b, h) ((4 + (b) * 2 + (h)) * HTB)
#define PG8_STAGE(bufoff, gbase, voff) do { _Pragma("unroll") for (int _i = 0; _i < 2; ++_i) \
        __builtin_amdgcn_global_load_lds((const unsigned*)((const char*)(gbase) + (voff)[_i]), (PG8_LAS unsigned*)(lds + (bufoff) + ldsw + _i * 8192), 16, 0, 0); } while (0)
#define PG8_LDA(dst, b, h) do { _Pragma("unroll") for (int m = 0; m < 4; ++m) _Pragma("unroll") for (int k = 0; k < 2; ++k) dst[m][k] = *(const PG8_LAS bf16x8*)(lds + PG8_SA(b, h) + aoff + m * 2048 + k * 1024); } while (0)
#define PG8_LDB(dst, b, h) do { _Pragma("unroll") for (int n = 0; n < 2; ++n) _Pragma("unroll") for (int k = 0; k < 2; ++k) dst[n][k] = *(const PG8_LAS bf16x8*)(lds + PG8_SB(b, h) + boff + n * 2048 + k * 1024); } while (0)
#define PG8_MMA(ai, bj, At, Bt) do { __builtin_amdgcn_s_setprio(1); _Pragma("unroll") for (int m = 0; m < 4; ++m) _Pragma("unroll") for (int n = 0; n < 2; ++n) _Pragma("unroll") for (int k = 0; k < 2; ++k) \
        acc[ai][bj][m][n] = __builtin_amdgcn_mfma_f32_16x16x32_bf16(Bt[n][k], At[m][k], acc[ai][bj][m][n], 0, 0, 0); __builtin_amdgcn_s_setprio(0); } while (0)
#define PG8_WAIT_V(n) asm volatile("s_waitcnt vmcnt(" #n ")" ::: "memory")
#define PG8_WAIT_L(n) asm volatile("s_waitcnt lgkmcnt(" #n ")" ::: "memory")
#define PG8_BAR __builtin_amdgcn_s_barrier()
#define PG8_SCHED __builtin_amdgcn_sched_barrier(0)
    Unit cur, nxt; int ui = 0;
    if (!S.next(0, cur)) return;
    f32x4 acc[2][2][4][2];
#pragma unroll
    for (int a = 0; a < 2; ++a)
#pragma unroll
        for (int b = 0; b < 2; ++b)
#pragma unroll
            for (int m = 0; m < 4; ++m)
#pragma unroll
                for (int n = 0; n < 2; ++n) acc[a][b][m][n] = (f32x4){0.f, 0.f, 0.f, 0.f};
    bf16x8 At[4][2], B0[2][2], B1[2][2];
    const char* cA = (const char*)g.A + (size_t)cur.pm * tstep; const char* cB = (const char*)g.Bt + (size_t)cur.pn * tstep;
    S.a_ready(cur);
    if constexpr (SP2) {
        PG8_STAGE(PG8_SB(0, 0), cB, voffB); PG8_STAGE(PG8_SB(0, 1), cB + hstep, voffB); PG8_STAGE(PG8_SA(0, 0), cA, voffA); PG8_STAGE(PG8_SA(0, 1), cA + hstep, voffA);
        if (wr == 1) PG8_BAR;
        PG8_WAIT_V(2); PG8_BAR;
        PG8_STAGE(PG8_SB(1, 0), cB + kstep, voffB); PG8_STAGE(PG8_SA(1, 0), cA + kstep, voffA); PG8_STAGE(PG8_SB(1, 1), cB + hstep + kstep, voffB);
        PG8_WAIT_V(6); PG8_BAR;
    } else {
        PG8_STAGE(PG8_SB(0, 0), cB, voffB); PG8_STAGE(PG8_SA(0, 0), cA, voffA); PG8_STAGE(PG8_SB(0, 1), cB + hstep, voffB); PG8_STAGE(PG8_SA(0, 1), cA + hstep, voffA);
        if (wr == 1) PG8_BAR;
        PG8_WAIT_V(4); PG8_BAR;
        PG8_STAGE(PG8_SB(1, 0), cB + kstep, voffB); PG8_STAGE(PG8_SA(1, 0), cA + kstep, voffA); PG8_STAGE(PG8_SB(1, 1), cB + hstep + kstep, voffB);
        PG8_WAIT_V(6); PG8_BAR;
    }
    for (;;) {
        const bool has_next = S.next(ui + 1, nxt);
        const char* nA = has_next ? (const char*)g.A + (size_t)nxt.pm * tstep : cA; const char* nB = has_next ? (const char*)g.Bt + (size_t)nxt.pn * tstep : cB;
        for (int t = 0; t < nt; t += 2) {
            const bool last = (t == nt - 2);
            const char* a1 = cA + (size_t)(t + 1) * kstep;
            const char* a2 = last ? nA : cA + (size_t)(t + 2) * kstep; const char* b2 = last ? nB : cB + (size_t)(t + 2) * kstep;
            const char* a3 = a2 + kstep; const char* b3 = b2 + kstep;
            if (last && has_next) S.a_ready(nxt);
            if constexpr (SP2) {
            PG8_LDB(B0, 0, 0); PG8_LDB(B1, 0, 1); PG8_SCHED; PG8_LDA(At, 0, 0); PG8_STAGE(PG8_SA(1, 1), a1 + hstep, voffA);
            PG8_WAIT_V(8); PG8_WAIT_L(0); PG8_BAR; PG8_MMA(0, 0, At, B0); PG8_MMA(0, 1, At, B1); PG8_BAR; PG8_SCHED;
            PG8_LDA(At, 0, 1); PG8_STAGE(PG8_SB(0, 0), b2, voffB); PG8_STAGE(PG8_SB(0, 1), b2 + hstep, voffB); PG8_STAGE(PG8_SA(0, 0), a2, voffA);
            PG8_WAIT_V(8); PG8_WAIT_L(0); PG8_BAR; PG8_MMA(1, 0, At, B0); PG8_MMA(1, 1, At, B1); PG8_BAR; PG8_SCHED;
            PG8_LDB(B0, 1, 0); PG8_LDB(B1, 1, 1); PG8_SCHED; PG8_LDA(At, 1, 0); PG8_STAGE(PG8_SA(0, 1), a2 + hstep, voffA);
            PG8_WAIT_V(8); PG8_WAIT_L(0); PG8_BAR; PG8_MMA(0, 0, At, B0); PG8_MMA(0, 1, At, B1); PG8_BAR; PG8_SCHED;
            PG8_LDA(At, 1, 1); PG8_STAGE(PG8_SB(1, 0), b3, voffB); PG8_STAGE(PG8_SB(1, 1), b3 + hstep, voffB); PG8_STAGE(PG8_SA(1, 0), a3, voffA);
            PG8_WAIT_V(8); PG8_WAIT_L(0); PG8_BAR; PG8_MMA(1, 0, At, B0); PG8_MMA(1, 1, At, B1); PG8_BAR; PG8_SCHED;
            } else {
            PG8_LDB(B0, 0, 0); PG8_SCHED; PG8_LDA(At, 0, 0); PG8_STAGE(PG8_SA(1, 1), a1 + hstep, voffA);
            PG8_WAIT_L(8); PG8_BAR; PG8_WAIT_L(0); PG8_MMA(0, 0, At, B0); PG8_BAR; PG8_SCHED;
            PG8_LDB(B1, 0, 1); PG8_STAGE(PG8_SB(0, 0), b2, voffB);
            PG8_BAR; PG8_WAIT_L(0); PG8_MMA(0, 1, At, B1); PG8_BAR;
            PG8_LDA(At, 0, 1); PG8_STAGE(PG8_SA(0, 0), a2, voffA);
            PG8_BAR; PG8_WAIT_L(0); PG8_MMA(1, 0, At, B0); PG8_BAR; PG8_SCHED;
            PG8_STAGE(PG8_SB(0, 1), b2 + hstep, voffB);
            PG8_WAIT_V(6); PG8_BAR; PG8_MMA(1, 1, At, B1); PG8_BAR;
            PG8_LDB(B0, 1, 0); PG8_SCHED; PG8_LDA(At, 1, 0); PG8_STAGE(PG8_SA(0, 1), a2 + hstep, voffA);
            PG8_WAIT_L(8); PG8_BAR; PG8_WAIT_L(0); PG8_MMA(0, 0, At, B0); PG8_BAR; PG8_SCHED;
            PG8_LDB(B1, 1, 1); PG8_STAGE(PG8_SB(1, 0), b3, voffB);
            PG8_BAR; PG8_WAIT_L(0); PG8_MMA(0, 1, At, B1); PG8_BAR;
            PG8_LDA(At, 1, 1); PG8_STAGE(PG8_SA(1, 0), a3, voffA);
            PG8_BAR; PG8_WAIT_L(0); PG8_MMA(1, 0, At, B0); PG8_BAR; PG8_SCHED;
            PG8_STAGE(PG8_SB(1, 1), b3 + hstep, voffB);
            PG8_WAIT_V(6); PG8_BAR; PG8_MMA(1, 1, At, B1); PG8_BAR;
            }
        }
        if constexpr (ALIGN_EPI) { if (wr == 0) PG8_BAR; }
        if constexpr (!Epi::AFTER_DRAIN) { E(acc, cur, wr, wc, fr, fq); S.done(cur); }
        if (!has_next) break;
#pragma unroll
        for (int a = 0; a < 2; ++a)
#pragma unroll
            for (int b = 0; b < 2; ++b)
#pragma unroll
                for (int m = 0; m < 4; ++m)
#pragma unroll
                    for (int n = 0; n < 2; ++n) acc[a][b][m][n] = (f32x4){0.f, 0.f, 0.f, 0.f};
        cur = nxt; cA = nA; cB = nB; ++ui;
        if constexpr (ALIGN_EPI) { if (wr == 1) PG8_BAR; }
    }
    PG8_WAIT_V(0);
    if constexpr (!ALIGN_EPI) { if (wr == 0) PG8_BAR; }
    PG8_BAR;
    if constexpr (Epi::AFTER_DRAIN) { E.fused(acc, cur, wr, wc, fr, fq, lds, wid, lane); S.done(cur); }
#undef PG8_SA
#undef PG8_SB
#undef PG8_STAGE
#undef PG8_LDA
#undef PG8_LDB
#undef PG8_MMA
#undef PG8_WAIT_V
#undef PG8_WAIT_L
#undef PG8_BAR
#undef PG8_SCHED
}
}

#define DI __device__ __forceinline__
#ifndef NSA_SKIP
#define NSA_SKIP 0
#endif
#define LAS __attribute__((address_space(3)))
typedef unsigned short bf16;
typedef short bf16x8 __attribute__((ext_vector_type(8)));
typedef short s16x4 __attribute__((ext_vector_type(4)));
typedef float f32x4 __attribute__((ext_vector_type(4)));
typedef float f32x16 __attribute__((ext_vector_type(16)));
typedef unsigned u32x4 __attribute__((ext_vector_type(4)));
typedef unsigned u32x2 __attribute__((ext_vector_type(2)));
#define MFMA32(a, b, c) __builtin_amdgcn_mfma_f32_32x32x16_bf16((a), (b), (c), 0, 0, 0)
#define LDS_WAIT() asm volatile("s_waitcnt lgkmcnt(0)" ::: "memory")

constexpr int SEQ = 8192, TOK = 16384, DM = 1024, FF = 4096, NIN = 8192, NTHR = 512;
constexpr size_t MiB = 1u << 20;
constexpr size_t WS_WIN = 1 * MiB, WS_WA = 17 * MiB, WS_WB = 18 * MiB, WS_WO = 19 * MiB, WS_W1K = 21 * MiB, WS_W1V = 22 * MiB, WS_SMALL = 23 * MiB,
                 WS_KC = 24 * MiB, WS_LSE = 25 * MiB, WS_GB = 27 * MiB, WS_QB = 28 * MiB, WS_KVB = 44 * MiB, WS_R2 = 68 * MiB, WS_R1 = 100 * MiB,
                 WS_WUP = 228 * MiB, WS_WDN = 236 * MiB, WS_END = 244 * MiB;
constexpr int LDS_BYTES = 147456;
constexpr int KVROW = 144, KVT = 64 * KVROW;
constexpr int VROW = 192, VT = 64 * VROW, BUFB = KVT + VT;
constexpr float SC_LOG2E = 0.125f * 1.4426950408889634f;

struct Args { const float* in[16]; float* out; unsigned char* ws; };

struct Frame {
    LAS unsigned char* lds; int tid, lane, wave, G, bid;
    const float *x, *g_mix, *w_in, *pos_k, *w1_k, *w2_k, *pos_v, *w1_v, *w2_v, *w_a, *w_b, *w_out, *g_mlp, *w_up, *w_down, *g_fin;
    float* out; unsigned char* ws;
    DI bf16* WIN() const { return (bf16*)(ws + (WS_WIN)); }
    DI bf16* WA() const { return (bf16*)(ws + (WS_WA)); }
    DI bf16* WB() const { return (bf16*)(ws + (WS_WB)); }
    DI bf16* WO() const { return (bf16*)(ws + (WS_WO)); }
    DI bf16* W1K() const { return (bf16*)(ws + (WS_W1K)); }
    DI bf16* W1V() const { return (bf16*)(ws + (WS_W1V)); }
    DI bf16* W2K() const { return (bf16*)(ws + (WS_SMALL)); }
    DI bf16* W2V() const { return (bf16*)(ws + (WS_SMALL + 32768)); }
    DI bf16* KC() const { return (bf16*)(ws + (WS_KC)); }
    DI bf16* VC() const { return (bf16*)(ws + (WS_KC + 262144)); }
    DI bf16* GB() const { return (bf16*)(ws + (WS_GB)); }
    DI bf16* QB() const { return (bf16*)(ws + (WS_QB)); }
    DI bf16* KVB() const { return (bf16*)(ws + (WS_KVB)); }
    DI bf16* U() const { return (bf16*)(ws + (WS_R2)); }
    DI bf16* OG0() const { return (bf16*)(ws + (WS_R2)); }
    DI bf16* OG1() const { return (bf16*)(ws + (WS_R2 + 16 * MiB)); }
    DI bf16* OG2() const { return (bf16*)(ws + (WS_WIN)); }
    DI bf16* QKVA() const { return (bf16*)(ws + (WS_R1)); }
    DI bf16* YA() const { return (bf16*)(ws + (WS_R1)); }
    DI bf16* YB() const { return (bf16*)(ws + (WS_R1 + 16 * MiB)); }
    DI bf16* MERGED() const { return (bf16*)(ws + (WS_R1 + 96 * MiB)); }
    DI bf16* H() const { return (bf16*)(ws + (WS_R1)); }
    DI bf16* WUP() const { return (bf16*)(ws + (WS_WUP)); }
    DI bf16* WDN() const { return (bf16*)(ws + (WS_WDN)); }
    DI float* BIASK() const { return (float*)(ws + (WS_SMALL + 65536)); }
    DI float* BIASV() const { return (float*)(ws + (WS_SMALL + 81920)); }
    DI float* CS() const { return (float*)(ws + (WS_SMALL + 131072)); }
    DI float* LSE() const { return (float*)(ws + (WS_LSE)); }
    DI float* TMP() const { return (float*)(ws + (WS_R1 + 32 * MiB)); }
    DI bf16* GM() const { return (bf16*)out; }
    DI float* SSP() const { return (float*)(ws + WS_LSE + 1 * MiB); }
    DI bf16* X1B() const { return (bf16*)(ws + WS_QB); }
};

DI float wave_sum(float v) {
#pragma unroll
    for (int o = 1; o < 64; o <<= 1) v += __shfl_xor(v, o);
    return v;
}
DI unsigned f2bf(float f) { unsigned u = __builtin_bit_cast(unsigned, f); return (u + 0x7fffu + ((u >> 16) & 1u)) >> 16; }
DI unsigned pk2(float lo, float hi) { return f2bf(lo) | (f2bf(hi) << 16); }
DI float bf2f(bf16 v) { return __builtin_bit_cast(float, (unsigned)v << 16); }
DI float sigm(float x) { return 1.f / (1.f + __expf(-x)); }
DI f32x16 zero16() { f32x16 z;
#pragma unroll
    for (int i = 0; i < 16; ++i) z[i] = 0.f;
    return z; }

DI void transpose_item(const float* W, int ldw, int col0, int ncols, int k0, bf16* WT, int K, int drow0, LAS float* scr, int lane) {
    const int cl = lane & 31;
#pragma unroll 8
    for (int i = 0; i < 32; ++i) { const int kk = 2 * i + (lane >> 5); scr[kk * 33 + cl] = (cl < ncols) ? W[(size_t)(k0 + kk) * ldw + col0 + cl] : 0.f; }
    LDS_WAIT();
    const int c = lane & 7;
#pragma unroll
    for (int j = 0; j < 4; ++j) { const int n = (lane >> 3) + 8 * j; const LAS float* s = scr + (8 * c) * 33 + n;
        u32x4 o; o.x = pk2(s[0 * 33], s[1 * 33]); o.y = pk2(s[2 * 33], s[3 * 33]); o.z = pk2(s[4 * 33], s[5 * 33]); o.w = pk2(s[6 * 33], s[7 * 33]);
        if (n < ncols) *(u32x4*)(WT + (size_t)(drow0 + n) * K + k0 + 8 * c) = o; }
    LDS_WAIT();
}
DI bool transpose_job(int& item, const float* W, int ldw, int scol0, int ncols, int K, bf16* WT, int drow0, LAS float* scr, int lane) {
    const int nblk = (ncols + 31) >> 5, nitems = (K >> 6) * nblk;
    if (item >= nitems) { item -= nitems; return false; }
    const int kb = item / nblk, nb = item - kb * nblk;
    const int rem = ncols - 32 * nb;
    transpose_item(W, ldw, scol0 + 32 * nb, rem < 32 ? rem : 32, 64 * kb, WT, K, drow0 + 32 * nb, scr, lane);
    return true;
}
DI void transpose_tile256(const float* W, int ldw, int col0, int k0, bf16* WT, int K, int drow0, LAS unsigned char* lds, int tid) {
    const int w = tid >> 6, l = tid & 63;
    LAS float* tile = (LAS float*)lds;
    f32x4 v[8];
#pragma unroll
    for (int i = 0; i < 8; ++i) v[i] = __builtin_nontemporal_load((const f32x4*)(W + (size_t)(k0 + w + 8 * i) * ldw + col0 + 4 * l));
#pragma unroll
    for (int i = 0; i < 8; ++i) *(LAS f32x4*)(tile + (w + 8 * i) * 260 + 4 * l) = v[i];
    __syncthreads();
    const int n = tid & 255;
#pragma unroll
    for (int q = 0; q < 4; ++q) { const int c = (tid >> 8) + 2 * q; const LAS float* sp = tile + (8 * c) * 260 + n;
        u32x4 o; o.x = pk2(sp[0], sp[260]); o.y = pk2(sp[2 * 260], sp[3 * 260]); o.z = pk2(sp[4 * 260], sp[5 * 260]); o.w = pk2(sp[6 * 260], sp[7 * 260]);
        *(u32x4*)(WT + (size_t)(drow0 + n) * K + k0 + 8 * c) = o; }
    __syncthreads();
}
DI bool ttile_job(int& item, const float* W, int ldw, int scol0, int ncols, int K, bf16* WT, int drow0, LAS unsigned char* lds, int tid) {
    const int nblk = ncols >> 8, nitems = (K >> 6) * nblk;
    if (item >= nitems) { item -= nitems; return false; }
    const int kb = item / nblk, nb = item - kb * nblk;
    transpose_tile256(W, ldw, scol0 + 256 * nb, 64 * kb, WT, K, drow0 + 256 * nb, lds, tid);
    return true;
}
DI void rms_row_bf16(const float* xrow, const float* g, bf16* orow, int lane) {
    const f32x4* xr = (const f32x4*)xrow + lane; const f32x4* gr = (const f32x4*)g + lane;
    f32x4 v[4]; float s = 0.f;
#pragma unroll
    for (int j = 0; j < 4; ++j) { v[j] = __builtin_nontemporal_load(xr + 64 * j); s += (v[j].x * v[j].x + v[j].y * v[j].y) + (v[j].z * v[j].z + v[j].w * v[j].w); }
    const float rstd = 1.f / sqrtf(wave_sum(s) * (1.f / DM) + 1e-6f);
    unsigned long long* o8 = (unsigned long long*)orow + lane;
#pragma unroll
    for (int j = 0; j < 4; ++j) { const f32x4 gg = gr[64 * j];
        o8[64 * j] = (unsigned long long)pk2(v[j].x * rstd * gg.x, v[j].y * rstd * gg.y) | ((unsigned long long)pk2(v[j].z * rstd * gg.z, v[j].w * rstd * gg.w) << 32); }
}
DI void rms_row_f32_inplace(float* xrow, const float* g, int lane) {
    f32x4* xr = (f32x4*)xrow + lane; const f32x4* gr = (const f32x4*)g + lane;
    f32x4 v[4]; float s = 0.f;
#pragma unroll
    for (int j = 0; j < 4; ++j) { v[j] = xr[64 * j]; s += (v[j].x * v[j].x + v[j].y * v[j].y) + (v[j].z * v[j].z + v[j].w * v[j].w); }
    const float rstd = 1.f / sqrtf(wave_sum(s) * (1.f / DM) + 1e-6f);
#pragma unroll
    for (int j = 0; j < 4; ++j) xr[64 * j] = v[j] * rstd * gr[64 * j];
}

DI void rms_row_bf16_to_f32(const bf16* xrow, const float* g, float* orow, int lane) {
    const u32x2* xr = (const u32x2*)xrow + lane; const f32x4* gr = (const f32x4*)g + lane;
    f32x4 v[4]; float s = 0.f;
#pragma unroll
    for (int j = 0; j < 4; ++j) { const u32x2 w = __builtin_nontemporal_load(xr + 64 * j); v[j] = (f32x4){pg8::bf_lo(w.x), pg8::bf_hi(w.x), pg8::bf_lo(w.y), pg8::bf_hi(w.y)};
        s += (v[j].x * v[j].x + v[j].y * v[j].y) + (v[j].z * v[j].z + v[j].w * v[j].w); }
    const float rstd = 1.f / sqrtf(wave_sum(s) * (1.f / DM) + 1e-6f);
    f32x4* o4 = (f32x4*)orow + lane;
#pragma unroll
    for (int j = 0; j < 4; ++j) { const f32x4 r = v[j] * rstd * gr[64 * j]; __builtin_nontemporal_store(r, o4 + 64 * j); }
}
DI void rms_row_bf16_to_bf16(const bf16* xrow, const float* g, bf16* orow, int lane) {
    const u32x2* xr = (const u32x2*)xrow + lane; const f32x4* gr = (const f32x4*)g + lane;
    f32x4 v[4]; float s = 0.f;
#pragma unroll
    for (int j = 0; j < 4; ++j) { const u32x2 w = __builtin_nontemporal_load(xr + 64 * j); v[j] = (f32x4){pg8::bf_lo(w.x), pg8::bf_hi(w.x), pg8::bf_lo(w.y), pg8::bf_hi(w.y)};
        s += (v[j].x * v[j].x + v[j].y * v[j].y) + (v[j].z * v[j].z + v[j].w * v[j].w); }
    const float rstd = 1.f / sqrtf(wave_sum(s) * (1.f / DM) + 1e-6f);
    unsigned long long* o8 = (unsigned long long*)orow + lane;
#pragma unroll
    for (int j = 0; j < 4; ++j) { const f32x4 gg = gr[64 * j];
        o8[64 * j] = (unsigned long long)pk2(v[j].x * rstd * gg.x, v[j].y * rstd * gg.y) | ((unsigned long long)pk2(v[j].z * rstd * gg.z, v[j].w * rstd * gg.w) << 32); }
}
DI void p0_prologue(const Frame& F) {
    LAS float* scr = (LAS float*)(F.lds + F.wave * 16384);
    const int gw = F.bid * 8 + F.wave, NGW = F.G * 8;
    constexpr int NTILES = 16 * 23 + 16 * 8 + 32 + 32;
    for (int it = F.bid; it < NTILES; it += F.G) {
        int r = it;
        if (ttile_job(r, F.w_in, 7960, 0, 5888, DM, F.WIN(), 0, F.lds, F.tid)) continue;
        if (ttile_job(r, F.w_in, 7960, 5912, 2048, DM, F.WIN(), 5888, F.lds, F.tid)) continue;
        if (ttile_job(r, F.w1_k, 256, 0, 256, 2048, F.W1K(), 0, F.lds, F.tid)) continue;
        ttile_job(r, F.w1_v, 256, 0, 256, 2048, F.W1V(), 0, F.lds, F.tid);
    }
    constexpr int NITEMS = 16 + 8 + 8;
    for (int it = gw; it < NITEMS; it += NGW) {
        int r = it;
        if (transpose_job(r, F.w_in, 7960, 5888, 24, DM, F.WIN(), 7936, scr, F.lane)) continue;
        if (transpose_job(r, F.w2_k, 64, 0, 64, 256, F.W2K(), 0, scr, F.lane)) continue;
        transpose_job(r, F.w2_v, 64, 0, 64, 256, F.W2V(), 0, scr, F.lane);
    }
    __syncthreads();
    const int gt = F.bid * NTHR + F.tid, NGT = F.G * NTHR;
    for (int i = gt; i < 232 * 1024 / 8; i += NGT) *(u32x4*)(F.WIN() + (size_t)7960 * 1024 + (size_t)i * 8) = (u32x4){0u, 0u, 0u, 0u};
    for (int i = gt; i < SEQ * 8; i += NGT) {
        const int s = i >> 3, k = i & 7;
        const double inv[8] = {1.0, 0.19392274474868576, 0.03760603093086393, 0.007292664737217109, 0.001414213562373095, 0.0002742481756762073, 5.318295896944988e-05, 1.031338537721246e-05};
        double iv = inv[0];
#pragma unroll
        for (int q = 1; q < 8; ++q) iv = (k == q) ? inv[q] : iv;
        const double rev = (double)s * iv * 0.15915494309189535;
        const float fr = (float)(rev - __builtin_rint(rev));
        F.CS()[s * 16 + k] = __builtin_amdgcn_cosf(fr); F.CS()[s * 16 + 8 + k] = __builtin_amdgcn_sinf(fr);
    }
    for (int m = gw; m < TOK; m += NGW) rms_row_bf16(F.x + (size_t)m * DM, F.g_mix, F.U() + (size_t)m * DM, F.lane);
    if (F.bid < 32) {
        const int mat = F.bid >> 4, part = F.bid & 15, col = F.tid & 255, kh = F.tid >> 8;
        const float* pe = mat ? F.pos_v : F.pos_k; const float* W1 = mat ? F.w1_v : F.w1_k; float acc = 0.f;
        const int kb = part * 128 + kh * 64;
#pragma unroll 8
        for (int k = 0; k < 64; ++k) acc += pe[kb + k] * W1[(size_t)(kb + k) * 256 + col];
        LAS float* red = (LAS float*)F.lds;
        __syncthreads();
        if (kh) red[col] = acc;
        __syncthreads();
        if (!kh) (mat ? F.BIASV() : F.BIASK())[part * 256 + col] = acc + red[col];
        __syncthreads();
    }
    if (F.bid == 2) { const int kv = F.tid >> 8, bg = (F.tid >> 6) & 3, d = F.tid & 63; (kv ? F.VC() : F.KC())[((bg * 512 + 511) << 6) + d] = 0; }
}

struct Stg { u32x4 k, v; };
DI void stage_load(Stg& s, const bf16* Kg, const bf16* Vg, int row0, int tid) {
    s.k = *(const u32x4*)(Kg + ((size_t)row0 << 6) + tid * 8); s.v = *(const u32x4*)(Vg + ((size_t)row0 << 6) + tid * 8);
}
DI void stage_store(const Stg& s, LAS unsigned char* lds, int buf, int tid) {
    *(LAS u32x4*)(lds + buf * BUFB + (tid >> 3) * KVROW + (tid & 7) * 16) = s.k; *(LAS u32x4*)(lds + buf * BUFB + KVT + (tid >> 3) * VROW + (tid & 7) * 16) = s.v;
}
DI unsigned pkbf(float a, float b) {
    typedef __bf16 bf2 __attribute__((ext_vector_type(2))); typedef float f2 __attribute__((ext_vector_type(2)));
    f2 v = {a, b}; bf2 r = __builtin_convertvector(v, bf2); return __builtin_bit_cast(unsigned, r);
}
DI void qk_tile(LAS const unsigned char* kt, const bf16x8 (&qf)[4], f32x16 (&s)[2], int lane) {
    const int r = lane & 31, h = lane >> 5;
    const int sr = (r & 19) | ((r & 4) << 1) | ((r & 8) >> 1);
    LAS const unsigned char* kp = kt + sr * KVROW + h * 16;
    bf16x8 ka[8];
#pragma unroll
    for (int kh = 0; kh < 2; ++kh)
#pragma unroll
        for (int ks = 0; ks < 4; ++ks) ka[kh * 4 + ks] = *(LAS const bf16x8*)(kp + kh * 32 * KVROW + ks * 32);
    s[0] = zero16(); s[1] = zero16();
    __builtin_amdgcn_s_setprio(1);
#pragma unroll
    for (int ks = 0; ks < 4; ++ks) { s[0] = MFMA32(ka[ks], qf[ks], s[0]); s[1] = MFMA32(ka[4 + ks], qf[ks], s[1]); }
    __builtin_amdgcn_s_setprio(0);
}
DI float xhalf_max(float v) { auto rr = __builtin_amdgcn_permlane32_swap(__float_as_uint(v), __float_as_uint(v), false, false); return fmaxf(__uint_as_float(rr[0]), __uint_as_float(rr[1])); }
DI float xhalf_sum(float v) { auto rr = __builtin_amdgcn_permlane32_swap(__float_as_uint(v), __float_as_uint(v), false, false); return __uint_as_float(rr[0]) + __uint_as_float(rr[1]); }
typedef float f32x2 __attribute__((ext_vector_type(2)));
#define OPQ(x) asm("" : "+v"(x))
DI void flash_tile(LAS const unsigned char* kt, LAS const unsigned char* vt, const bf16x8 (&qf)[4], f32x16 (&o)[2], float& m, float& l, int dq, unsigned maxoff, bool sel, int lane) {
    const int h = lane >> 5;
    f32x16 s[2];
    qk_tile(kt, qf, s, lane);
    bf16x8 vf[2][2][2];
    {
        const int q4 = (lane & 15) >> 2, p4 = lane & 3, blk = (lane >> 4) & 1;
        LAS const unsigned char* vb = vt + (8 * h + q4) * VROW + 8 * (4 * blk + p4);
#pragma unroll
        for (int kh = 0; kh < 2; ++kh)
#pragma unroll
            for (int s2 = 0; s2 < 2; ++s2)
#pragma unroll
                for (int db = 0; db < 2; ++db) {
                    LAS const unsigned char* vp = vb + (32 * kh + 16 * s2) * VROW + db * 64;
                    const s16x4 lo = __builtin_amdgcn_ds_read_tr16_b64_v4i16((LAS s16x4*)(vp));
                    const s16x4 hi = __builtin_amdgcn_ds_read_tr16_b64_v4i16((LAS s16x4*)(vp + 4 * VROW));
                    vf[kh][s2][db] = __builtin_shufflevector(lo, hi, 0, 1, 2, 3, 4, 5, 6, 7);
                }
    }
    const bool lane_full = (dq >= 55) && ((unsigned)dq <= maxoff);
    if (__ballot(!lane_full) != 0ull) {
#pragma unroll
        for (int kh = 0; kh < 2; ++kh)
#pragma unroll
            for (int i = 0; i < 16; ++i) { const int kk = 32 * kh + 16 * (i >> 3) + (i & 7); s[kh][i] = ((unsigned)(dq - kk) <= maxoff) ? s[kh][i] : -1e30f; }
    }
    asm volatile("s_nop 15\n\ts_nop 15" : "+v"(s[0]), "+v"(s[1]));
#define MAX3(d, a, b, c) asm("v_max3_f32 %0, %1, %2, %3" : "=v"(d) : "v"(a), "v"(b), "v"(c))
    float ma[10], mc2[4], mx;
#pragma unroll
    for (int i = 0; i < 5; ++i) { MAX3(ma[i], s[0][3 * i], s[0][3 * i + 1], s[0][3 * i + 2]); MAX3(ma[5 + i], s[1][3 * i], s[1][3 * i + 1], s[1][3 * i + 2]); }
    MAX3(mc2[0], ma[0], ma[1], ma[2]); MAX3(mc2[1], ma[3], ma[4], ma[5]); MAX3(mc2[2], ma[6], ma[7], ma[8]); MAX3(mc2[3], ma[9], s[0][15], s[1][15]);
    { float t0, t1; MAX3(t0, mc2[0], mc2[1], mc2[2]); MAX3(t1, mc2[3], t0, t0); mx = t1; }
#undef MAX3
    mx = xhalf_max(mx);
    mx = sel ? mx : -1e30f;
    const bool need = mx > m + 40.f;
    if (__ballot(need) != 0ull) {
        const float mn = need ? mx : m;
        const float alpha = need ? __builtin_amdgcn_exp2f((m - mn) * SC_LOG2E) : 1.f;
        m = mn; l *= alpha;
#pragma unroll
        for (int i = 0; i < 16; ++i) { float a = o[0][i] * alpha, b = o[1][i] * alpha; OPQ(a); OPQ(b); o[0][i] = a; o[1][i] = b; }
    }
    const float nmb = sel ? -fmaxf(m, -1e20f) * SC_LOG2E : -1e30f;
    float pa[4] = {0.f, 0.f, 0.f, 0.f};
#pragma unroll
    for (int kh = 0; kh < 2; ++kh)
#pragma unroll
        for (int i = 0; i < 16; ++i) {
            float x = __builtin_fmaf(s[kh][i], SC_LOG2E, nmb); OPQ(x);
            const float p = __builtin_amdgcn_exp2f(x);
            float a = pa[i & 3] + p; OPQ(a); pa[i & 3] = a;
            s[kh][i] = p; }
    l += (pa[0] + pa[1]) + (pa[2] + pa[3]);
#pragma unroll
    for (int kh = 0; kh < 2; ++kh)
#pragma unroll
        for (int s2 = 0; s2 < 2; ++s2) {
            u32x4 pw; pw.x = pkbf(s[kh][8 * s2 + 0], s[kh][8 * s2 + 1]); pw.y = pkbf(s[kh][8 * s2 + 2], s[kh][8 * s2 + 3]);
            pw.z = pkbf(s[kh][8 * s2 + 4], s[kh][8 * s2 + 5]); pw.w = pkbf(s[kh][8 * s2 + 6], s[kh][8 * s2 + 7]);
            const bf16x8 pf = __builtin_bit_cast(bf16x8, pw);
            o[0] = MFMA32(vf[kh][s2][0], pf, o[0]); o[1] = MFMA32(vf[kh][s2][1], pf, o[1]);
        }
}
#define TILE_LOOP(T0, T1, ROWOF, KPTR, VPTR, BODY) do { \
    Stg sA_, sB_; const int t1_ = (T1); int t_ = (T0); \
    if (t_ < t1_) stage_load(sA_, KPTR, VPTR, ROWOF(t_), tid); \
    if (t_ + 1 < t1_) stage_load(sB_, KPTR, VPTR, ROWOF(t_ + 1), tid); \
    for (; t_ < t1_; t_ += 2) { \
        { const int ct = t_; const int buf = 0; stage_store(sA_, F.lds, 0, tid); __syncthreads(); if (ct + 2 < t1_) stage_load(sA_, KPTR, VPTR, ROWOF(ct + 2), tid); BODY } \
        if (t_ + 1 < t1_) { const int ct = t_ + 1; const int buf = 1; stage_store(sB_, F.lds, 1, tid); __syncthreads(); if (ct + 2 < t1_) stage_load(sB_, KPTR, VPTR, ROWOF(ct + 2), tid); BODY } \
    } \
    __syncthreads(); } while (0)
DI void write_o_row(bf16* dst, const f32x16 (&o)[2], float scale, int h) {
#pragma unroll
    for (int db = 0; db < 2; ++db)
#pragma unroll
        for (int i4 = 0; i4 < 4; ++i4) {
            u32x2 w; w.x = pkbf(o[db][4 * i4] * scale, o[db][4 * i4 + 1] * scale); w.y = pkbf(o[db][4 * i4 + 2] * scale, o[db][4 * i4 + 3] * scale);
            *(u32x2*)(dst + 32 * db + 8 * i4 + 4 * h) = w;
        }
}

DI void mixa_task(const Frame& F, int task) {
    const int tile32 = task & 31, hb = task >> 5, b = hb & 1, head = hb >> 1;
    const int g = head >> 3, slot = head & 7, lg = 2 * g;
    const int prow0 = tile32 * 256, L = SEQ >> lg, res = prow0 >> (13 - lg), p0 = prow0 & (L - 1);
    const bf16* Q = F.QKVA() + ((size_t)((head) * 2 + b) << 19);
    const bf16* K = F.QKVA() + ((size_t)((24 + head) * 2 + b) << 19);
    const bf16* V = F.QKVA() + ((size_t)((48 + head) * 2 + b) << 19);
    const int w = F.wave, lane = F.lane, r = lane & 31, h = lane >> 5;
    bf16x8 qf[4];
    { const bf16* qr = Q + ((size_t)(prow0 + 32 * w + r) << 6) + 8 * h;
#pragma unroll
      for (int ks = 0; ks < 4; ++ks) qf[ks] = *(const bf16x8*)(qr + 16 * ks); }
    f32x16 o[2] = {zero16(), zero16()}; float m = -1e30f, l = 0.f;
    const int kt0 = (p0 == 0) ? 2 : 0;
    const int tid = F.tid;
#define ROWOF_A(kt) (prow0 - 128 + 64 * (kt))
    TILE_LOOP(kt0, 6, ROWOF_A, K, V, {
        if (ct >= (w >> 1) && ct <= (w >> 1) + 2)
            flash_tile(F.lds + buf * BUFB, F.lds + buf * BUFB + KVT, qf, o, m, l, 128 + 32 * w + r - 64 * ct - 8 * h, 128u, true, lane);
    });
#undef ROWOF_A
    const float lt = xhalf_sum(l);
    const float inv = 1.f / lt;
    const int s = ((p0 + 32 * w + r) << lg) | res;
    const size_t row = (size_t)b * SEQ + s;
    bf16* og = (bf16*)(F.ws + ((g == 0) ? WS_R2 : (g == 1) ? (WS_R2 + 16 * MiB) : WS_WIN));
    write_o_row(og + row * 512 + slot * 64, o, inv, h);
    if (h == 0) F.LSE()[((size_t)g * TOK + row) * 8 + slot] = m * 0.125f + __logf(lt);
}

DI float gelu_tanh(float x) { const float u = 0.7978845608028654f * (x + 0.044715f * x * x * x); const float e = __expf(2.f * u); const float t = 1.f - 2.f / (e + 1.f); return 0.5f * x * (1.f + t); }
DI void compress_task(const Frame& F, int task) {
    const int kv = task >> 5, bg = (task >> 3) & 3, it = task & 7;
    const bf16* A = F.KVB() + ((size_t)(kv * 4 + bg) << 19);
    const bf16* W1T = kv ? F.W1V() : F.W1K(); const bf16* W2T = kv ? F.W2V() : F.W2K(); const float* bias = kv ? F.BIASV() : F.BIASK();
    bf16* OUT = (kv ? F.VC() : F.KC()) + ((size_t)bg << 15);
    const int w = F.wave, lane = F.lane, r = lane & 31, h = lane >> 5;
    LAS unsigned char* hid = F.lds;
    f32x16 acc[2] = {zero16(), zero16()};
    int i0 = 64 * it + r, i1 = i0 + 32; i0 = i0 > 510 ? 510 : i0; i1 = i1 > 510 ? 510 : i1;
    const bf16* a0p = A + (size_t)i0 * 1024 + 8 * h; const bf16* a1p = A + (size_t)i1 * 1024 + 8 * h;
    const bf16* bp = W1T + (size_t)(32 * w + r) * 2048 + 8 * h;
#pragma unroll 4
    for (int k0 = 0; k0 < 2048; k0 += 16) {
        const bf16x8 bfr = *(const bf16x8*)(bp + k0), a0 = *(const bf16x8*)(a0p + k0), a1 = *(const bf16x8*)(a1p + k0);
        acc[0] = MFMA32(a0, bfr, acc[0]); acc[1] = MFMA32(a1, bfr, acc[1]);
    }
    float bs = 0.f;
#pragma unroll
    for (int j = 0; j < 16; ++j) bs += bias[j * 256 + 32 * w + r];
#pragma unroll
    for (int rb = 0; rb < 2; ++rb)
#pragma unroll
        for (int i = 0; i < 16; ++i) { const int row = 32 * rb + (i & 3) + 8 * (i >> 2) + 4 * h;
            *(LAS bf16*)(hid + row * 528 + (32 * w + r) * 2) = (bf16)f2bf(gelu_tanh(acc[rb][i] + bs)); }
    __syncthreads();
    if (w < 4) {
        const int rb = w & 1, cb = w >> 1; f32x16 c = zero16();
        const bf16* b2 = W2T + (size_t)(32 * cb + r) * 256 + 8 * h;
#pragma unroll
        for (int k0 = 0; k0 < 256; k0 += 16) { const bf16x8 a = *(LAS const bf16x8*)(hid + (32 * rb + r) * 528 + (k0 + 8 * h) * 2); const bf16x8 bb = *(const bf16x8*)(b2 + k0); c = MFMA32(a, bb, c); }
#pragma unroll
        for (int i = 0; i < 16; ++i) { const int row = 64 * it + 32 * rb + (i & 3) + 8 * (i >> 2) + 4 * h;
            if (row < 511) OUT[((size_t)row << 6) + 32 * cb + r] = (bf16)f2bf(c[i]); }
    }
    __syncthreads();
}

DI float dpp_quad_sum(float p) {
    p += __builtin_bit_cast(float, __builtin_amdgcn_update_dpp(0, __builtin_bit_cast(int, p), 0xB1, 0xF, 0xF, true));
    p += __builtin_bit_cast(float, __builtin_amdgcn_update_dpp(0, __builtin_bit_cast(int, p), 0x4E, 0xF, 0xF, true));
    return p;
}
DI void imp_tile(LAS const unsigned char* kt, const bf16x8 (&qf)[4], LAS float* ipb, int dq, float mb, float invc, int lane) {
    f32x16 s[2];
    qk_tile(kt, qf, s, lane);
#pragma unroll
    for (int kh = 0; kh < 2; ++kh)
#pragma unroll
        for (int s2 = 0; s2 < 2; ++s2) {
            float ps[8];
#pragma unroll
            for (int j = 0; j < 8; ++j) { const int kk = 32 * kh + 16 * s2 + j; const bool v = (dq - kk) >= 0;
                const float p = v ? __builtin_amdgcn_exp2f(s[kh][8 * s2 + j] * SC_LOG2E - mb) * invc : 0.f; ps[j] = dpp_quad_sum(p); }
            const float sa = (ps[0] + ps[1]) + (ps[2] + ps[3]), sb = (ps[4] + ps[5]) + (ps[6] + ps[7]);
            LAS float* ip = ipb + 8 * kh + 4 * s2;
            if ((lane & 3) == 0) {
                __hip_atomic_fetch_add(ip, sa, __ATOMIC_RELAXED, __HIP_MEMORY_SCOPE_WORKGROUP);
                __hip_atomic_fetch_add(ip + 1, sb + ps[3], __ATOMIC_RELAXED, __HIP_MEMORY_SCOPE_WORKGROUP);
                __hip_atomic_fetch_add(ip + 2, ps[7], __ATOMIC_RELAXED, __HIP_MEMORY_SCOPE_WORKGROUP);
            }
        }
}
DI unsigned wave_umax(unsigned v) {
#define WUM_STEP(ctrl) { const unsigned t = (unsigned)__builtin_amdgcn_update_dpp((int)v, (int)v, (ctrl), 0xF, 0xF, false); v = v > t ? v : t; }
    WUM_STEP(0xB1) WUM_STEP(0x4E) WUM_STEP(0x141) WUM_STEP(0x140)
#undef WUM_STEP
    const unsigned r0 = (unsigned)__builtin_amdgcn_readlane((int)v, 0), r1 = (unsigned)__builtin_amdgcn_readlane((int)v, 16), r2 = (unsigned)__builtin_amdgcn_readlane((int)v, 32), r3 = (unsigned)__builtin_amdgcn_readlane((int)v, 48);
    const unsigned a = r0 > r1 ? r0 : r1, b = r2 > r3 ? r2 : r3;
    return a > b ? a : b;
}
DI void stash_put(LAS f32x4* st, const f32x16 (&y)[2], int tid) {
#pragma unroll
    for (int i = 0; i < 8; ++i) { const f32x16& v = y[i >> 2]; const int q = (i & 3) * 4; st[i * 512 + tid] = (f32x4){v[q], v[q + 1], v[q + 2], v[q + 3]}; }
}
DI void stash_add(LAS const f32x4* st, f32x16 (&y)[2], int tid) {
#pragma unroll
    for (int i = 0; i < 8; ++i) { const f32x4 a = st[i * 512 + tid]; const int q = (i & 3) * 4; f32x16& v = y[i >> 2]; v[q] += a[0]; v[q + 1] += a[1]; v[q + 2] += a[2]; v[q + 3] += a[3]; }
}
DI void nsa_task(const Frame& F, int b, int g, int tt) {
    const int w = F.wave, lane = F.lane, r = lane & 31, h = lane >> 5, tid = F.tid;
    const int t0 = tt * 64, tok = 8 * w + (r >> 2), t = t0 + tok, head = 4 * g + (r & 3);
    const size_t row = (size_t)b * SEQ + t;
    const int bg = b * 2 + g;
    bf16x8 qf[4];
    { const bf16* qr = F.QB() + row * 512 + head * 64 + 8 * h;
#pragma unroll
      for (int ks = 0; ks < 4; ++ks) qf[ks] = *(const bf16x8*)(qr + 16 * ks); }
    float g0, g1, g2;
    { const bf16* gp = F.GB() + row * 32 + head * 3; g0 = sigm(bf2f(gp[0])); g1 = sigm(bf2f(gp[1])); g2 = sigm(bf2f(gp[2])); }
    LAS float* imp = (LAS float*)(F.lds + 2 * BUFB);
    for (int i = tid; i < 64 * 132; i += NTHR) imp[i] = 0.f;
    LAS f32x4* ystash = (LAS f32x4*)(F.lds + 2 * BUFB + 64 * 132 * 4);
    const int nvis = (4 * tt + 3) < 511 ? (4 * tt + 3) : 511, nct = (NSA_SKIP == 3) ? 1 : (nvis + 63) >> 6;
    const bf16* Kc = F.KC() + ((size_t)bg << 15); const bf16* Vc = F.VC() + ((size_t)bg << 15);
    const int lim = (t - 31) >> 4;
    float mc, invc;
    {
        f32x16 o[2] = {zero16(), zero16()}; float m = -1e30f, l = 0.f;
#define ROWOF_T(ct_) (64 * (ct_))
        TILE_LOOP(0, nct, ROWOF_T, Kc, Vc, {
            flash_tile(F.lds + buf * BUFB, F.lds + buf * BUFB + KVT, qf, o, m, l, lim - 64 * ct - 8 * h, 0x7fffffffu, true, lane);
        });
        const float lt = xhalf_sum(l);
        invc = lt > 0.f ? 1.f / lt : 0.f; mc = m;
        o[0] *= (g0 * invc); o[1] *= (g0 * invc); stash_put(ystash, o, tid);
    }
    {
        const float mb = mc * SC_LOG2E;
        TILE_LOOP(0, nct, ROWOF_T, Kc, Vc, { imp_tile(F.lds + buf * BUFB, qf, imp + tok * 132 + 16 * ct + 2 * h, lim - 64 * ct - 8 * h, mb, invc, lane); });
        LDS_WAIT();
        __syncthreads();
    }
    unsigned long long mlo = 0ull, mhi = 0ull;
    if (tt <= 15 || NSA_SKIP == 3) { mlo = (2ull << (tt & 63)) - 1ull; mhi = mlo; }
    else {
        for (int tk = 0; tk < 8; ++tk) {
            LAS const float* rowp = imp + (8 * w + tk) * 132;
            const int ma = lane, mb2 = lane + 64;
            const bool ca = (ma >= 1 && ma <= tt - 2), cb = (mb2 <= tt - 2);
            unsigned ka = ca ? __float_as_uint(rowp[ma]) + 1u : 0u, kb = cb ? __float_as_uint(rowp[mb2]) + 1u : 0u;
            bool sa = false, sb = false;
            for (int it = 0; it < 13; ++it) {
                const unsigned mxk = wave_umax(ka > kb ? ka : kb);
                const unsigned long long ea = __ballot(ka == mxk);
                if (ea != 0ull) { if (lane == (int)__builtin_ctzll(ea)) { sa = true; ka = 0u; } }
                else { const unsigned long long eb = __ballot(kb == mxk); if (lane == (int)__builtin_ctzll(eb)) { sb = true; kb = 0u; } }
            }
            unsigned long long ba = __ballot(sa), bb = __ballot(sb);
            ba |= 1ull;
            if (tt < 64) ba |= 1ull << tt; else bb |= 1ull << (tt - 64);
            if (tt - 1 < 64) ba |= 1ull << (tt - 1); else bb |= 1ull << (tt - 1 - 64);
            if ((r >> 2) == tk) { mlo = ba; mhi = bb; }
        }
    }
    {
        const bf16* Ks = F.KVB() + ((size_t)(2 * 4 + bg) << 19); const bf16* Vs = F.KVB() + ((size_t)(3 * 4 + bg) << 19);
        f32x16 o[2] = {zero16(), zero16()}; float m = -1e30f, l = 0.f;
        TILE_LOOP(0, (NSA_SKIP == 1) ? 1 : tt + 1, ROWOF_T, Ks, Vs, {
            const bool sel = ((ct < 64 ? (mlo >> ct) : (mhi >> (ct - 64))) & 1ull) != 0ull;
            if (__ballot(sel) != 0ull)
                flash_tile(F.lds + buf * BUFB, F.lds + buf * BUFB + KVT, qf, o, m, l, t - 64 * ct - 8 * h, 0x7fffffffu, sel, lane);
        });
        const float lt = xhalf_sum(l); const float sc = g1 / lt;
        o[0] *= sc; o[1] *= sc; stash_add(ystash, o, tid); stash_put(ystash, o, tid);
    }
    {
        const bf16* Kw = F.KVB() + ((size_t)(4 * 4 + bg) << 19); const bf16* Vw = F.KVB() + ((size_t)(5 * 4 + bg) << 19);
        f32x16 o[2] = {zero16(), zero16()}; float m = -1e30f, l = 0.f;
        const int c0 = tt > 8 ? tt - 8 : 0;
        TILE_LOOP((NSA_SKIP == 2) ? tt : c0, tt + 1, ROWOF_T, Kw, Vw, {
            flash_tile(F.lds + buf * BUFB, F.lds + buf * BUFB + KVT, qf, o, m, l, t - 64 * ct - 8 * h, 511u, true, lane);
        });
#undef ROWOF_T
        const float lt = xhalf_sum(l); const float sc = g2 / lt;
        o[0] *= sc; o[1] *= sc; stash_add(ystash, o, tid);
        write_o_row(F.YB() + row * 512 + head * 64, o, 1.f, h);
    }
}

DI void combine_ya_task(const Frame& F, int task) {
    for (int i = task * 4096 + F.tid; i < (task + 1) * 4096; i += NTHR) {
        const int row = i >> 6, ch = i & 63, slot = ch >> 3;
        const float l0 = __builtin_nontemporal_load(F.LSE() + ((size_t)0 * TOK + row) * 8 + slot), l1 = __builtin_nontemporal_load(F.LSE() + ((size_t)1 * TOK + row) * 8 + slot), l2 = __builtin_nontemporal_load(F.LSE() + ((size_t)2 * TOK + row) * 8 + slot);
        const float mx = fmaxf(l0, fmaxf(l1, l2)); float w0 = __expf(l0 - mx), w1 = __expf(l1 - mx), w2 = __expf(l2 - mx);
        const float inv = 1.f / (w0 + w1 + w2); w0 *= inv; w1 *= inv; w2 *= inv;
        const size_t off = (size_t)row * 512 + ch * 8;
        const u32x4 a = __builtin_nontemporal_load((const u32x4*)(F.OG0() + off)), bb = __builtin_nontemporal_load((const u32x4*)(F.OG1() + off)), c = __builtin_nontemporal_load((const u32x4*)(F.OG2() + off));
        u32x4 o;
#pragma unroll
        for (int e = 0; e < 4; ++e) {
            const float lo = w0 * pg8::bf_lo(a[e]) + w1 * pg8::bf_lo(bb[e]) + w2 * pg8::bf_lo(c[e]);
            const float hi = w0 * pg8::bf_hi(a[e]) + w1 * pg8::bf_hi(bb[e]) + w2 * pg8::bf_hi(c[e]);
            o[e] = pk2(lo, hi);
        }
        *(u32x4*)(F.YA() + off) = o;
    }
}

#define XB_TMO      128
#define XB_XCNT(j)  (256  + 64 * (j))
#define XB_XSUB(j)  (1280 + 64 * (j))
#define XB_XGEN(j)  (2304 + 64 * (j))
#define XB_TOP      3328
#define XB_TOPGEN   3392
#define XCD_BAR_WORDS 3456
#define XB_SPIN_CAP (1u << 18)

__device__ __forceinline__ unsigned xb_ld(unsigned* p)              { return __hip_atomic_load(p, __ATOMIC_RELAXED, __HIP_MEMORY_SCOPE_AGENT); }
__device__ __forceinline__ unsigned xb_add(unsigned* p, unsigned v) { return __hip_atomic_fetch_add(p, v, __ATOMIC_RELAXED, __HIP_MEMORY_SCOPE_AGENT); }
__device__ __forceinline__ unsigned xb_xcc_id() { return (unsigned)__builtin_amdgcn_s_getreg((3 << 11) | 20) & 0xFu; }
#define XB_SPIN(cond, bar) do { unsigned _sp = 0; while (cond) { __builtin_amdgcn_s_sleep(1); \
    if ((++_sp & 255u) == 0u) { if (xb_ld(&(bar)[XB_TMO])) break; if (_sp > XB_SPIN_CAP) { atomicAdd(&(bar)[XB_TMO], 1u); break; } } } } while (0)
struct XcdBarrier {
    unsigned* bar; unsigned x;
    volatile LAS unsigned* st;
};

__device__ __forceinline__ XcdBarrier xcd_barrier_post(unsigned* bar, volatile LAS unsigned* st) {
    XcdBarrier b; b.bar = bar; b.x = xb_xcc_id(); b.st = st;
    if (threadIdx.x == 0) (void)xb_add(&bar[XB_XCNT(b.x)], 1u);
    return b;
}
__device__ __forceinline__ void xcd_barrier_complete(unsigned* bar, unsigned x, unsigned& nloc, unsigned& nx) {
    const unsigned G = gridDim.x * gridDim.y * gridDim.z;
    unsigned sum, cnt, mine, sp = 0u;
    for (;;) {
        sum = 0u; cnt = 0u; mine = 0u;
#pragma unroll
        for (unsigned j = 0; j < 16; ++j) { const unsigned c = xb_ld(&bar[XB_XCNT(j)]); sum += c; cnt += (c > 0u) ? 1u : 0u; mine = (j == x) ? c : mine; }
        if (sum == G) break;
        __builtin_amdgcn_s_sleep(1);
        if ((++sp & 255u) == 0u) { if (xb_ld(&bar[XB_TMO])) break; if (sp > XB_SPIN_CAP) { atomicAdd(&bar[XB_TMO], 1u); break; } }
    }
    nloc = mine > 0u ? mine : 1u; nx = cnt > 0u ? cnt : 1u;
}

__device__ __forceinline__ void xcd_barrier(const XcdBarrier& b) {
    asm volatile("s_waitcnt vmcnt(0)" ::: "memory");
    __syncthreads();
    if (threadIdx.x == 0) {
        unsigned* bar = b.bar;
        __builtin_amdgcn_s_waitcnt(0);
        unsigned nloc = b.st[0], nx = b.st[1];
        if (nloc == 0u) { xcd_barrier_complete(bar, b.x, nloc, nx); b.st[0] = nloc; b.st[1] = nx; }
        const unsigned old = xb_add(&bar[XB_XSUB(b.x)], 1u);
        const unsigned gen = old / nloc;
        if (old + 1u == (gen + 1u) * nloc) {
            __builtin_amdgcn_fence(__ATOMIC_RELEASE, "agent");
            asm volatile("s_waitcnt vmcnt(0)" ::: "memory");
            const unsigned og = xb_add(&bar[XB_TOP], 1u);
            const unsigned tg = og / nx;
            if (og + 1u == (tg + 1u) * nx) xb_add(&bar[XB_TOPGEN], 1u);
            else XB_SPIN(xb_ld(&bar[XB_TOPGEN]) == tg, bar);
            __builtin_amdgcn_fence(__ATOMIC_ACQUIRE, "agent");
            xb_add(&bar[XB_XGEN(b.x)], 1u);
            asm volatile("s_waitcnt vmcnt(0)" ::: "memory");
        } else {
            XB_SPIN(xb_ld(&bar[XB_XGEN(b.x)]) == gen, bar);
            __builtin_amdgcn_fence(__ATOMIC_ACQUIRE, "agent");
            asm volatile("s_waitcnt vmcnt(0)" ::: "memory");
        }
    }
    __syncthreads();
}

#ifndef PH_MAX
#define PH_MAX 99
#endif
#ifndef P3_TTILES
#define P3_TTILES 512
#endif
#ifndef PROBE_PH
#define PROBE_PH 0
#endif
#ifndef REPEAT_PH
#define REPEAT_PH 0
#endif
#define REP(k) for (int rep_ = 0; rep_ < ((REPEAT_PH == (k)) ? 2 : 1); ++rep_)
__global__ void __launch_bounds__(NTHR) fwd_mega(Args args) {
    extern __shared__ __attribute__((aligned(16))) unsigned char lds_raw[];
    cg::grid_group grid = cg::this_grid();
    Frame F;
    F.lds = (LAS unsigned char*)lds_raw; F.tid = threadIdx.x; F.lane = F.tid & 63; F.wave = __builtin_amdgcn_readfirstlane(F.tid >> 6); F.G = gridDim.x; F.bid = blockIdx.x;
    F.x = args.in[0]; F.g_mix = args.in[1]; F.w_in = args.in[2]; F.pos_k = args.in[3]; F.w1_k = args.in[4]; F.w2_k = args.in[5]; F.pos_v = args.in[6]; F.w1_v = args.in[7]; F.w2_v = args.in[8];
    F.w_a = args.in[9]; F.w_b = args.in[10]; F.w_out = args.in[11]; F.g_mlp = args.in[12]; F.w_up = args.in[13]; F.w_down = args.in[14]; F.g_fin = args.in[15];
    F.out = args.out; F.ws = args.ws;
    unsigned char* ws = args.ws;
    PG8_LAS unsigned char* glds = (PG8_LAS unsigned char*)lds_raw;
    volatile LAS unsigned* xst = (volatile LAS unsigned*)(F.lds + LDS_BYTES - 16);
    if (F.tid < 4) xst[F.tid] = 0u;
    __syncthreads();
    XcdBarrier xbar = xcd_barrier_post((unsigned*)ws, xst);
    if (args.ws == nullptr) grid.sync();
    const int gw = F.bid * 8 + F.wave, NGW = F.G * 8;

#if PROBE_PH
    unsigned long long stamp_[16]; int ns_ = 1; stamp_[0] = __builtin_amdgcn_s_memrealtime();
#endif
    REP(9) p0_prologue(F);
#if REPEAT_PH == 10
    for (int q_ = 0; q_ < 10; ++q_) grid.sync();
#endif
    xcd_barrier(xbar);
#if PROBE_PH
    stamp_[ns_ < 15 ? ns_ : 15] = __builtin_amdgcn_s_memrealtime(); ++ns_;
#endif
    asm volatile("" : "+v"(F.tid), "+v"(F.lane));
    if (PH_MAX >= 1) REP(1) {
        pg8::Gemm gm{F.U(), F.WIN(), TOK, NIN, DM}; pg8::StaticOrder S; S.init(TOK, NIN, F.G, F.bid);
        pg8::EpiInProj E{F.QKVA(), F.QB(), F.KVB(), F.GM(), F.GB(), F.CS()};
        pg8::gemm_phase<pg8::EpiInProj, pg8::StaticOrder, true, true>(glds, gm, S, E);
    }
    xcd_barrier(xbar);
#if PROBE_PH
    stamp_[ns_ < 15 ? ns_ : 15] = __builtin_amdgcn_s_memrealtime(); ++ns_;
#endif
    asm volatile("" : "+v"(F.tid), "+v"(F.lane));
    if (PH_MAX >= 2) REP(2) {
        unsigned* qctr = (unsigned*)ws + 3520 + 64 * rep_;
        volatile LAS int* qslot = (volatile LAS int*)(F.lds + LDS_BYTES - 8);
        for (;;) {
            if (F.tid == 0) *qslot = (int)__hip_atomic_fetch_add(qctr, 1u, __ATOMIC_RELAXED, __HIP_MEMORY_SCOPE_AGENT);
            __syncthreads();
            const int task = *qslot;
            __syncthreads();
            if (task >= 1600 + 128) break;
            if (task < 64) compress_task(F, task);
            else if (task < 1600) mixa_task(F, task - 64);
            else { int r = task - 1600;
                if (!ttile_job(r, F.w_a, 1024, 0, 1024, 512, F.WA(), 0, F.lds, F.tid)) if (!ttile_job(r, F.w_b, 1024, 0, 1024, 512, F.WB(), 0, F.lds, F.tid)) ttile_job(r, F.w_out, 1024, 0, 1024, 1024, F.WO(), 0, F.lds, F.tid); }
        }
    }
    xcd_barrier(xbar);
#if PROBE_PH
    stamp_[ns_ < 15 ? ns_ : 15] = __builtin_amdgcn_s_memrealtime(); ++ns_;
#endif
    asm volatile("" : "+v"(F.tid), "+v"(F.lane));
    if (PH_MAX >= 3) REP(3) {
        unsigned* qctr = (unsigned*)ws + 3520 + 128 + 64 * rep_;
        volatile LAS int* qslot = (volatile LAS int*)(F.lds + LDS_BYTES - 8);
        for (;;) {
            if (F.tid == 0) *qslot = (int)__hip_atomic_fetch_add(qctr, 1u, __ATOMIC_RELAXED, __HIP_MEMORY_SCOPE_AGENT);
            __syncthreads();
            const int task = *qslot;
            __syncthreads();
            if (task >= 512 + 256 + P3_TTILES) break;
            if (task < 512) { const int bg = task & 3; nsa_task(F, bg >> 1, bg & 1, 127 - (task >> 2)); }
            else if (task < 768) combine_ya_task(F, task - 512);
            else { int r = task - 768;
                if (!ttile_job(r, F.w_up, 4096, 0, 4096, DM, F.WUP(), 0, F.lds, F.tid)) ttile_job(r, F.w_down, 1024, 0, 1024, FF, F.WDN(), 0, F.lds, F.tid); }
        }
    }
    xcd_barrier(xbar);
#if PROBE_PH
    stamp_[ns_ < 15 ? ns_ : 15] = __builtin_amdgcn_s_memrealtime(); ++ns_;
#endif
    asm volatile("" : "+v"(F.tid), "+v"(F.lane));
    if (PH_MAX >= 4) REP(4) {
        pg8::StaticOrder S; S.init(TOK, DM, F.G, F.bid);
        { pg8::Gemm gm{F.YA(), F.WA(), TOK, DM, 512}; pg8::EpiMerge<1> E{F.GM(), F.TMP(), F.MERGED()}; pg8::gemm_phase<pg8::EpiMerge<1>, pg8::StaticOrder, true, true>(glds, gm, S, E); }
        { pg8::Gemm gm{F.YB(), F.WB(), TOK, DM, 512}; pg8::EpiMerge<2> E{F.GM(), F.TMP(), F.MERGED()}; pg8::gemm_phase<pg8::EpiMerge<2>, pg8::StaticOrder, true, true>(glds, gm, S, E); }
    }
    xcd_barrier(xbar);
#if PROBE_PH
    stamp_[ns_ < 15 ? ns_ : 15] = __builtin_amdgcn_s_memrealtime(); ++ns_;
#endif
    asm volatile("" : "+v"(F.tid), "+v"(F.lane));
    if (PH_MAX >= 5) REP(5) {
        pg8::StaticOrder S; S.init(TOK, DM, F.G, F.bid);
        pg8::Gemm gm{F.MERGED(), F.WO(), TOK, DM, DM}; pg8::EpiResNormPrep E{F.x, F.X1B(), F.U(), F.g_mlp, F.SSP()}; pg8::gemm_phase<pg8::EpiResNormPrep, pg8::StaticOrder, true, true>(glds, gm, S, E);
    }
    xcd_barrier(xbar);
#if PROBE_PH
    stamp_[ns_ < 15 ? ns_ : 15] = __builtin_amdgcn_s_memrealtime(); ++ns_;
#endif
    asm volatile("" : "+v"(F.tid), "+v"(F.lane));
    if (PH_MAX >= 7) REP(7) {
        pg8::StaticOrder S; S.init(TOK, FF, F.G, F.bid);
        pg8::Gemm gm{F.U(), F.WUP(), TOK, FF, DM}; pg8::EpiRelu2 E{F.H(), FF, F.SSP()}; pg8::gemm_phase<pg8::EpiRelu2, pg8::StaticOrder, true, true>(glds, gm, S, E);
    }
    xcd_barrier(xbar);
#if PROBE_PH
    stamp_[ns_ < 15 ? ns_ : 15] = __builtin_amdgcn_s_memrealtime(); ++ns_;
#endif
    asm volatile("" : "+v"(F.tid), "+v"(F.lane));
    if (PH_MAX >= 8) REP(8) {
        pg8::StaticOrder S; S.init(TOK, DM, F.G, F.bid);
        pg8::Gemm gm{F.H(), F.WDN(), TOK, DM, FF}; pg8::EpiResBf16In E{F.X1B(), F.U(), DM}; pg8::gemm_phase<pg8::EpiResBf16In, pg8::StaticOrder, true, true>(glds, gm, S, E);
    }
    xcd_barrier(xbar);
#if PROBE_PH
    stamp_[ns_ < 15 ? ns_ : 15] = __builtin_amdgcn_s_memrealtime(); ++ns_;
#endif
    asm volatile("" : "+v"(F.tid), "+v"(F.lane));
    for (int m = gw; m < TOK; m += NGW) rms_row_bf16_to_f32(F.U() + (size_t)m * DM, F.g_fin, F.out + (size_t)m * DM, F.lane);
#if PROBE_PH
    xcd_barrier(xbar);
    stamp_[ns_ < 15 ? ns_ : 15] = __builtin_amdgcn_s_memrealtime();
    if (F.bid == 0 && F.tid == 0) { const float us_ = (float)(unsigned)(stamp_[PROBE_PH] - stamp_[PROBE_PH - 1]) * 0.01f; F.out[0] = 1000.f * __builtin_amdgcn_exp2f(__builtin_rintf(6.f * __builtin_amdgcn_logf(us_)) * (1.f / 6.f)); }
#endif
}

extern "C" void kernel_launch(void* const* d_in, const int* in_sizes, int n_in, void* d_out, int out_size, void* d_ws, size_t ws_size, hipStream_t stream) {
    static int grid = 0;
    if (grid == 0) {
        if (n_in != 16 || out_size != TOK * DM || ws_size < WS_END) { fprintf(stderr, "kernel_launch: unexpected shapes (n_in %d out %d ws %zu)\n", n_in, out_size, ws_size); grid = -1; return; }
        int dev = 0, cus = 0, per_cu = 0;
        hipGetDevice(&dev); hipDeviceGetAttribute(&cus, hipDeviceAttributeMultiprocessorCount, dev);
        hipFuncSetAttribute((const void*)fwd_mega, hipFuncAttributeMaxDynamicSharedMemorySize, LDS_BYTES);
        if (hipOccupancyMaxActiveBlocksPerMultiprocessor(&per_cu, (const void*)fwd_mega, NTHR, LDS_BYTES) != hipSuccess || per_cu < 1) { fprintf(stderr, "kernel_launch: occupancy query gave %d\n", per_cu); per_cu = 1; }
        (void)hipGetLastError();
        grid = cus * 1;
    }
    if (grid < 0) return;
    if (hipMemsetAsync(d_ws, 0, 16384, stream) != hipSuccess) { fprintf(stderr, "kernel_launch: memset of barrier words failed\n"); return; }
    Args a{};
    for (int i = 0; i < 16; ++i) a.in[i] = (const float*)d_in[i];
    a.out = (float*)d_out; a.ws = (unsigned char*)d_ws;
    void* kargs[] = {&a};
    hipError_t e = hipLaunchCooperativeKernel((const void*)fwd_mega, dim3(grid), dim3(NTHR), kargs, LDS_BYTES, stream);
    if (e != hipSuccess) fprintf(stderr, "cooperative launch failed: %s (grid %d)\n", hipGetErrorString(e), grid);
}
```

```cpp
#include <hip/hip_runtime.h>
#include <hip/hip_cooperative_groups.h>
#include <cstdio>
#include <cstdint>
namespace cg = cooperative_groups;

namespace pg8 {
#define PG8_LAS __attribute__((address_space(3)))
typedef unsigned short bf16_t;
typedef short bf16x8 __attribute__((ext_vector_type(8)));
typedef float f32x4 __attribute__((ext_vector_type(4)));
typedef unsigned u32x4 __attribute__((ext_vector_type(4)));
constexpr int BM = 256, BK = 64, HALF = 128, HTB = HALF * BK * 2  , STAGE_BYTES = 8 * HTB, NXCD = 8, WGM = 8;

__host__ __device__ __forceinline__ int lds_byte(int r, int c) { const int st = (r >> 4) * 2 + (c >> 5), rr = r & 15, cc = c & 31, ob = rr * 64 + cc * 2; return st * 1024 + (ob ^ (((ob >> 9) & 1) << 5)); }
__host__ __device__ __forceinline__ void stage_rc(int b, int& R, int& C) { const int st = b / 1024, sb = b % 1024, swz = sb ^ (((sb >> 9) & 1) << 5); R = (st >> 1) * 16 + swz / 64; C = (st & 1) * 32 + (swz % 64) / 2; }
__host__ __device__ __forceinline__ int perm32(int rho) { const int n = rho >> 4, i = rho & 15; return 8 * (i >> 2) + 4 * n + (i & 3); }

struct Unit { int pm, pn; };
struct Gemm { const bf16_t* A; const bf16_t* Bt; int M, N, K; };

struct StaticOrder {
    int nM, nN, nwg, G, c;
    __host__ __device__ void init(int M, int N, int G_, int c_) { nM = M / BM; nN = N / BM; nwg = nM * nN; G = G_; c = c_; }
    __host__ __device__ bool next(int i, Unit& u) const {
        const long L = (long)i * G + c; if (L >= nwg) return false;
        int wgid = (int)L; { const int q = nwg / NXCD, r = nwg % NXCD, xcd = wgid % NXCD, off = wgid / NXCD; wgid = (xcd < r ? xcd * (q + 1) : r * (q + 1) + (xcd - r) * q) + off; }
        const int nig = WGM * nN, gid = wgid / nig, fm = gid * WGM, gsz = (nM - fm) < WGM ? (nM - fm) : WGM;
        u.pm = fm + ((wgid % nig) % gsz); u.pn = (wgid % nig) / gsz; return true;
    }
    __device__ __forceinline__ void a_ready(const Unit&) const {}
    __device__ __forceinline__ void done(const Unit&) const {}
};

__device__ __forceinline__ unsigned cvt_pk_bf16(float lo, float hi) { unsigned r; asm volatile("v_cvt_pk_bf16_f32 %0, %1, %2" : "=v"(r) : "v"(lo), "v"(hi)); return r; }
__device__ __forceinline__ float bf_lo(unsigned w) { return __builtin_bit_cast(float, w << 16); }
__device__ __forceinline__ float bf_hi(unsigned w) { return __builtin_bit_cast(float, w & 0xffff0000u); }
__device__ __forceinline__ float sigmoidf_(float x) { return __builtin_amdgcn_rcpf(1.f + __expf(-x)); }

struct EpiInProj {
    static constexpr bool PERM = true, AFTER_DRAIN = false;
    bf16_t* qkva; bf16_t* qb; bf16_t* kvb; bf16_t* gm; bf16_t* gb; const float* cs;
    __device__ __forceinline__ void operator()(const f32x4 (&acc)[2][2][4][2], const Unit& u, int wr, int wc, int fr, int fq) const {
        const int pn = u.pn;
        const int row0 = u.pm * BM + wr * 64 + fr;
        const bool rope_wave = !(wc & 1);
#pragma unroll
        for (int ai = 0; ai < 2; ++ai)
#pragma unroll
            for (int m = 0; m < 4; ++m) {
                const int row = row0 + ai * HALF + m * 16; const int b = row >> 13, s = row & 8191;
                f32x4 c0, c1, s0, s1;
                { const f32x4* t = (const f32x4*)(cs + (size_t)s * 16); c0 = t[0]; c1 = t[1]; s0 = t[2]; s1 = t[3]; }
#pragma unroll
                for (int bj = 0; bj < 2; ++bj) {
                    const int c = pn * BM + bj * HALF + wc * 32 + 8 * fq;
                    f32x4 v0 = acc[ai][bj][m][0], v1 = acc[ai][bj][m][1];
                    bool rope; bf16_t* dst;
                    if (pn < 18) { const int which = c / 1536, hc = c - which * 1536, head = hc >> 6, d0 = hc & 63, lg = (head >> 3) * 2;
                        const int prow = ((s & ((1 << lg) - 1)) << (13 - lg)) | (s >> lg);
                        dst = qkva + ((size_t)((((which * 24 + head) * 2 + b) << 13) + prow) << 6) + d0; rope = (pn < 12); }
                    else if (pn < 20) { dst = qb + (size_t)row * 512 + (c - 4608); rope = true; }
                    else if (pn < 23) { const int cc = c - 5120, j = cc >> 7, g = (cc >> 6) & 1, d0 = cc & 63;
                        dst = kvb + ((size_t)((((j * 4 + b * 2 + g)) << 13) + s) << 6) + d0; rope = (bj == 0); }
                    else if (pn < 31) { dst = gm + (size_t)row * 2048 + (c - 5888); rope = false; }
                    else { dst = gb + (size_t)row * 32 + (c - 7936); rope = false; }
                    if (rope && rope_wave) {
                        f32x4 p0, p1;
#pragma unroll
                        for (int e = 0; e < 4; ++e) { p0[e] = __shfl_xor(v0[e], 16); p1[e] = __shfl_xor(v1[e], 16); }
                        if (fq == 0) { v0 = v0 * c0 - p0 * s0; v1 = v1 * c1 - p1 * s1; }
                        else if (fq == 1) { v0 = v0 * c0 + p0 * s0; v1 = v1 * c1 + p1 * s1; }
                    }
                    if (pn < 31 || (bj == 0 && wc == 0)) {
                        u32x4 w; w.x = cvt_pk_bf16(v0[0], v0[1]); w.y = cvt_pk_bf16(v0[2], v0[3]); w.z = cvt_pk_bf16(v1[0], v1[1]); w.w = cvt_pk_bf16(v1[2], v1[3]);
                        *(u32x4*)dst = w; }
                }
            }
    }
};
template <int STEP> struct EpiMerge {
    static constexpr bool PERM = true, AFTER_DRAIN = false;
    const bf16_t* gm; float* tmp; bf16_t* merged;
    __device__ __forceinline__ void operator()(const f32x4 (&acc)[2][2][4][2], const Unit& u, int wr, int wc, int fr, int fq) const {
        const int row0 = u.pm * BM + wr * 64 + fr, col0 = u.pn * BM + wc * 32 + 8 * fq;
#pragma unroll
        for (int ai = 0; ai < 2; ++ai)
#pragma unroll
            for (int m = 0; m < 4; ++m)
#pragma unroll
                for (int bj = 0; bj < 2; ++bj) {
                    const int row = row0 + ai * HALF + m * 16, c = col0 + bj * HALF;
                    const u32x4 g = __builtin_nontemporal_load((const u32x4*)(gm + (size_t)row * 2048 + (STEP - 1) * 1024 + c));
                    f32x4 v0 = acc[ai][bj][m][0], v1 = acc[ai][bj][m][1];
                    v0[0] *= sigmoidf_(bf_lo(g.x)); v0[1] *= sigmoidf_(bf_hi(g.x)); v0[2] *= sigmoidf_(bf_lo(g.y)); v0[3] *= sigmoidf_(bf_hi(g.y));
                    v1[0] *= sigmoidf_(bf_lo(g.z)); v1[1] *= sigmoidf_(bf_hi(g.z)); v1[2] *= sigmoidf_(bf_lo(g.w)); v1[3] *= sigmoidf_(bf_hi(g.w));
                    bf16_t* tp = (bf16_t*)tmp + (size_t)row * 1024 + c;
                    if (STEP == 1) { u32x4 w; w.x = cvt_pk_bf16(v0[0], v0[1]); w.y = cvt_pk_bf16(v0[2], v0[3]); w.z = cvt_pk_bf16(v1[0], v1[1]); w.w = cvt_pk_bf16(v1[2], v1[3]); *(u32x4*)tp = w; }
                    else { const u32x4 t = __builtin_nontemporal_load((const u32x4*)tp); v0[0] += bf_lo(t.x); v0[1] += bf_hi(t.x); v0[2] += bf_lo(t.y); v0[3] += bf_hi(t.y); v1[0] += bf_lo(t.z); v1[1] += bf_hi(t.z); v1[2] += bf_lo(t.w); v1[3] += bf_hi(t.w);
                        u32x4 w; w.x = cvt_pk_bf16(v0[0], v0[1]); w.y = cvt_pk_bf16(v0[2], v0[3]); w.z = cvt_pk_bf16(v1[0], v1[1]); w.w = cvt_pk_bf16(v1[2], v1[3]);
                        *(u32x4*)(merged + (size_t)row * 1024 + c) = w; }
                    __builtin_amdgcn_sched_barrier(0);
                }
    }
};
struct EpiResF32 {
    static constexpr bool PERM = true, AFTER_DRAIN = false;
    const float* res; float* out; int ldc;
    __device__ __forceinline__ void operator()(const f32x4 (&acc)[2][2][4][2], const Unit& u, int wr, int wc, int fr, int fq) const {
        const int row0 = u.pm * BM + wr * 64 + fr, col0 = u.pn * BM + wc * 32 + 8 * fq;
#pragma unroll
        for (int ai = 0; ai < 2; ++ai)
#pragma unroll
            for (int m = 0; m < 4; ++m)
#pragma unroll
                for (int bj = 0; bj < 2; ++bj) {
                    const size_t off = (size_t)(row0 + ai * HALF + m * 16) * ldc + col0 + bj * HALF;
                    const f32x4 r0 = *(const f32x4*)(res + off), r1 = *(const f32x4*)(res + off + 4);
                    *(f32x4*)(out + off) = r0 + acc[ai][bj][m][0]; *(f32x4*)(out + off + 4) = r1 + acc[ai][bj][m][1];
                    __builtin_amdgcn_sched_barrier(0);
                }
    }
};
struct EpiResBf16 {
    static constexpr bool PERM = true, AFTER_DRAIN = false;
    const float* res; bf16_t* O; int ldc;
    __device__ __forceinline__ void operator()(const f32x4 (&acc)[2][2][4][2], const Unit& u, int wr, int wc, int fr, int fq) const {
        const int row0 = u.pm * BM + wr * 64 + fr, col0 = u.pn * BM + wc * 32 + 8 * fq;
#pragma unroll
        for (int ai = 0; ai < 2; ++ai)
#pragma unroll
            for (int m = 0; m < 4; ++m)
#pragma unroll
                for (int bj = 0; bj < 2; ++bj) {
                    const size_t off = (size_t)(row0 + ai * HALF + m * 16) * ldc + col0 + bj * HALF;
                    const f32x4 v0 = *(const f32x4*)(res + off) + acc[ai][bj][m][0], v1 = *(const f32x4*)(res + off + 4) + acc[ai][bj][m][1];
                    u32x4 w; w.x = cvt_pk_bf16(v0[0], v0[1]); w.y = cvt_pk_bf16(v0[2], v0[3]); w.z = cvt_pk_bf16(v1[0], v1[1]); w.w = cvt_pk_bf16(v1[2], v1[3]);
                    *(u32x4*)(O + off) = w;
                    __builtin_amdgcn_sched_barrier(0);
                }
    }
};
struct EpiResBf16In {
    static constexpr bool PERM = true, AFTER_DRAIN = false;
    const bf16_t* res; bf16_t* O; int ldc;
    __device__ __forceinline__ void operator()(const f32x4 (&acc)[2][2][4][2], const Unit& u, int wr, int wc, int fr, int fq) const {
        const int row0 = u.pm * BM + wr * 64 + fr, col0 = u.pn * BM + wc * 32 + 8 * fq;
#pragma unroll
        for (int ai = 0; ai < 2; ++ai)
#pragma unroll
            for (int m = 0; m < 4; ++m)
#pragma unroll
                for (int bj = 0; bj < 2; ++bj) {
                    const size_t off = (size_t)(row0 + ai * HALF + m * 16) * ldc + col0 + bj * HALF;
                    const u32x4 r = __builtin_nontemporal_load((const u32x4*)(res + off));
                    f32x4 v0 = acc[ai][bj][m][0], v1 = acc[ai][bj][m][1];
                    v0[0] += bf_lo(r.x); v0[1] += bf_hi(r.x); v0[2] += bf_lo(r.y); v0[3] += bf_hi(r.y); v1[0] += bf_lo(r.z); v1[1] += bf_hi(r.z); v1[2] += bf_lo(r.w); v1[3] += bf_hi(r.w);
                    u32x4 w; w.x = cvt_pk_bf16(v0[0], v0[1]); w.y = cvt_pk_bf16(v0[2], v0[3]); w.z = cvt_pk_bf16(v1[0], v1[1]); w.w = cvt_pk_bf16(v1[2], v1[3]);
                    *(u32x4*)(O + off) = w;
                    __builtin_amdgcn_sched_barrier(0);
                }
    }
};
struct EpiResNormPrep {
    static constexpr bool PERM = true, AFTER_DRAIN = false;
    const float* res; bf16_t* X1; bf16_t* U; const float* g; float* part;
    __device__ __forceinline__ void operator()(const f32x4 (&acc)[2][2][4][2], const Unit& u, int wr, int wc, int fr, int fq) const {
        const int row0 = u.pm * BM + wr * 64 + fr, col0 = u.pn * BM + wc * 32 + 8 * fq;
#pragma unroll
        for (int ai = 0; ai < 2; ++ai)
#pragma unroll
            for (int m = 0; m < 4; ++m) {
                const int row = row0 + ai * HALF + m * 16; float ss = 0.f;
#pragma unroll
                for (int bj = 0; bj < 2; ++bj) {
                    const size_t off = (size_t)row * 1024 + col0 + bj * HALF;
                    const f32x4 v0 = __builtin_nontemporal_load((const f32x4*)(res + off)) + acc[ai][bj][m][0], v1 = __builtin_nontemporal_load((const f32x4*)(res + off + 4)) + acc[ai][bj][m][1];
                    const f32x4 g0 = *(const f32x4*)(g + col0 + bj * HALF), g1 = *(const f32x4*)(g + col0 + bj * HALF + 4);
                    ss += (v0[0] * v0[0] + v0[1] * v0[1]) + (v0[2] * v0[2] + v0[3] * v0[3]) + (v1[0] * v1[0] + v1[1] * v1[1]) + (v1[2] * v1[2] + v1[3] * v1[3]);
                    u32x4 w; w.x = cvt_pk_bf16(v0[0], v0[1]); w.y = cvt_pk_bf16(v0[2], v0[3]); w.z = cvt_pk_bf16(v1[0], v1[1]); w.w = cvt_pk_bf16(v1[2], v1[3]);
                    *(u32x4*)(X1 + off) = w;
                    u32x4 y; y.x = cvt_pk_bf16(v0[0] * g0[0], v0[1] * g0[1]); y.y = cvt_pk_bf16(v0[2] * g0[2], v0[3] * g0[3]); y.z = cvt_pk_bf16(v1[0] * g1[0], v1[1] * g1[1]); y.w = cvt_pk_bf16(v1[2] * g1[2], v1[3] * g1[3]);
                    *(u32x4*)(U + off) = y;
                }
                ss += __shfl_xor(ss, 16); ss += __shfl_xor(ss, 32);
                if (fq == 0) part[(size_t)row * 16 + u.pn * 4 + wc] = ss;
                __builtin_amdgcn_sched_barrier(0);
            }
    }
};
struct EpiRelu2 {
    static constexpr bool PERM = true, AFTER_DRAIN = false;
    bf16_t* O; int ldc; const float* part;
    __device__ __forceinline__ void operator()(const f32x4 (&acc)[2][2][4][2], const Unit& u, int wr, int wc, int fr, int fq) const {
        const int row0 = u.pm * BM + wr * 64 + fr, col0 = u.pn * BM + wc * 32 + 8 * fq;
#pragma unroll
        for (int ai = 0; ai < 2; ++ai)
#pragma unroll
            for (int m = 0; m < 4; ++m) {
                const f32x4* pp = (const f32x4*)(part + (size_t)(row0 + ai * HALF + m * 16) * 16);
                const f32x4 s4 = (pp[0] + pp[1]) + (pp[2] + pp[3]);
                const float rstd = 1.f / sqrtf(((s4[0] + s4[1]) + (s4[2] + s4[3])) * (1.f / 1024.f) + 1e-6f);
#pragma unroll
                for (int bj = 0; bj < 2; ++bj) {
                    f32x4 v0 = acc[ai][bj][m][0], v1 = acc[ai][bj][m][1];
#pragma unroll
                    for (int e = 0; e < 4; ++e) { const float a = fmaxf(v0[e] * rstd, 0.f), b = fmaxf(v1[e] * rstd, 0.f); v0[e] = a * a; v1[e] = b * b; }
                    u32x4 w; w.x = cvt_pk_bf16(v0[0], v0[1]); w.y = cvt_pk_bf16(v0[2], v0[3]); w.z = cvt_pk_bf16(v1[0], v1[1]); w.w = cvt_pk_bf16(v1[2], v1[3]);
                    *(u32x4*)(O + (size_t)(row0 + ai * HALF + m * 16) * ldc + col0 + bj * HALF) = w;
                    __builtin_amdgcn_sched_barrier(0);
                }
            }
    }
};

template <class Epi, class Sched, bool ALIGN_EPI = false, bool SP2 = false>
__device__ __forceinline__ void gemm_phase(PG8_LAS unsigned char* lds, const Gemm g, const Sched& S, const Epi& E) {
    int tid_ = threadIdx.x; asm volatile("" : "+v"(tid_));
    const int tid = tid_, wid = __builtin_amdgcn_readfirstlane(tid >> 6), lane = tid & 63, wr = wid >> 2, wc = wid & 3, fr = lane & 15, fq = lane >> 4;
    const int K = g.K, nt = K / BK;
    unsigned voffA[2], voffB[2];
#pragma unroll
    for (int i = 0; i < 2; ++i) { int R, C; stage_rc(tid * 16 + i * 8192, R, C); const int Rb = Epi::PERM ? ((R & ~31) + perm32(R & 31)) : R;
        voffA[i] = (unsigned)(R * K + C) * 2u; voffB[i] = (unsigned)(Rb * K + C) * 2u; }
    const size_t kstep = (size_t)(BK * 2);
    const size_t hstep = (size_t)HALF * K * 2;
    const size_t tstep = 2 * hstep;
    const unsigned ldsw = (unsigned)wid * 1024u;
    const int aoff = lds_byte(wr * 64 + fr, fq * 8), boff = lds_byte(wc * 32 + fr, fq * 8);
#define PG8_SA(b, h) (((b) * 2 + (h)) * HTB)
#define PG8_SB(b, h) ((4 + (b) * 2 + (h)) * HTB)
#define PG8_STAGE(bufoff, gbase, voff) do { _Pragma("unroll") for (int _i = 0; _i < 2; ++_i) \
        __builtin_amdgcn_global_load_lds((const unsigned*)((const char*)(gbase) + (voff)[_i]), (PG8_LAS unsigned*)(lds + (bufoff) + ldsw + _i * 8192), 16, 0, 0); } while (0)
#define PG8_LDA(dst, b, h) do { _Pragma("unroll") for (int m = 0; m < 4; ++m) _Pragma("unroll") for (int k = 0; k < 2; ++k) dst[m][k] = *(const PG8_LAS bf16x8*)(lds + PG8_SA(b, h) + aoff + m * 2048 + k * 1024); } while (0)
#define PG8_LDB(dst, b, h) do { _Pragma("unroll") for (int n = 0; n < 2; ++n) _Pragma("unroll") for (int k = 0; k < 2; ++k) dst[n][k] = *(const PG8_LAS bf16x8*)(lds + PG8_SB(b, h) + boff + n * 2048 + k * 1024); } while (0)
#define PG8_MMA(ai, bj, At, Bt) do { __builtin_amdgcn_s_setprio(1); _Pragma("unroll") for (int m = 0; m < 4; ++m) _Pragma("unroll") for (int n = 0; n < 2; ++n) _Pragma("unroll") for (int k = 0; k < 2; ++k) \
        acc[ai][bj][m][n] = __builtin_amdgcn_mfma_f32_16x16x32_bf16(Bt[n][k], At[m][k], acc[ai][bj][m][n], 0, 0, 0); __builtin_amdgcn_s_setprio(0); } while (0)
#define PG8_WAIT_V(n) asm volatile("s_waitcnt vmcnt(" #n ")" ::: "memory")
#define PG8_WAIT_L(n) asm volatile("s_waitcnt lgkmcnt(" #n ")" ::: "memory")
#define PG8_BAR __builtin_amdgcn_s_barrier()
#define PG8_SCHED __builtin_amdgcn_sched_barrier(0)
    Unit cur, nxt; int ui = 0;
    if (!S.next(0, cur)) return;
    f32x4 acc[2][2][4][2];
#pragma unroll
    for (int a = 0; a < 2; ++a)
#pragma unroll
        for (int b = 0; b < 2; ++b)
#pragma unroll
            for (int m = 0; m < 4; ++m)
#pragma unroll
                for (int n = 0; n < 2; ++n) acc[a][b][m][n] = (f32x4){0.f, 0.f, 0.f, 0.f};
    bf16x8 At[4][2], B0[2][2], B1[2][2];
    const char* cA = (const char*)g.A + (size_t)cur.pm * tstep; const char* cB = (const char*)g.Bt + (size_t)cur.pn * tstep;
    S.a_ready(cur);
    if constexpr (SP2) {
        PG8_STAGE(PG8_SB(0, 0), cB, voffB); PG8_STAGE(PG8_SB(0, 1), cB + hstep, voffB); PG8_STAGE(PG8_SA(0, 0), cA, voffA); PG8_STAGE(PG8_SA(0, 1), cA + hstep, voffA);
        if (wr == 1) PG8_BAR;
        PG8_WAIT_V(2); PG8_BAR;
        PG8_STAGE(PG8_SB(1, 0), cB + kstep, voffB); PG8_STAGE(PG8_SA(1, 0), cA + kstep, voffA); PG8_STAGE(PG8_SB(1, 1), cB + hstep + kstep, voffB);
        PG8_WAIT_V(6); PG8_BAR;
    } else {
        PG8_STAGE(PG8_SB(0, 0), cB, voffB); PG8_STAGE(PG8_SA(0, 0), cA, voffA); PG8_STAGE(PG8_SB(0, 1), cB + hstep, voffB); PG8_STAGE(PG8_SA(0, 1), cA + hstep, voffA);
        if (wr == 1) PG8_BAR;
        PG8_WAIT_V(4); PG8_BAR;
        PG8_STAGE(PG8_SB(1, 0), cB + kstep, voffB); PG8_STAGE(PG8_SA(1, 0), cA + kstep, voffA); PG8_STAGE(PG8_SB(1, 1), cB + hstep + kstep, voffB);
        PG8_WAIT_V(6); PG8_BAR;
    }
    for (;;) {
        const bool has_next = S.next(ui + 1, nxt);
        const char* nA = has_next ? (const char*)g.A + (size_t)nxt.pm * tstep : cA; const char* nB = has_next ? (const char*)g.Bt + (size_t)nxt.pn * tstep : cB;
        for (int t = 0; t < nt; t += 2) {
            const bool last = (t == nt - 2);
            const char* a1 = cA + (size_t)(t + 1) * kstep;
            const char* a2 = last ? nA : cA + (size_t)(t + 2) * kstep; const char* b2 = last ? nB : cB + (size_t)(t + 2) * kstep;
            const char* a3 = a2 + kstep; const char* b3 = b2 + kstep;
            if (last && has_next) S.a_ready(nxt);
            if constexpr (SP2) {
            PG8_LDB(B0, 0, 0); PG8_LDB(B1, 0, 1); PG8_SCHED; PG8_LDA(At, 0, 0); PG8_STAGE(PG8_SA(1, 1), a1 + hstep, voffA);
            PG8_WAIT_V(8); PG8_WAIT_L(0); PG8_BAR; PG8_MMA(0, 0, At, B0); PG8_MMA(0, 1, At, B1); PG8_BAR; PG8_SCHED;
            PG8_LDA(At, 0, 1); PG8_STAGE(PG8_SB(0, 0), b2, voffB); PG8_STAGE(PG8_SB(0, 1), b2 + hstep, voffB); PG8_STAGE(PG8_SA(0, 0), a2, voffA);
            PG8_WAIT_V(8); PG8_WAIT_L(0); PG8_BAR; PG8_MMA(1, 0, At, B0); PG8_MMA(1, 1, At, B1); PG8_BAR; PG8_SCHED;
            PG8_LDB(B0, 1, 0); PG8_LDB(B1, 1, 1); PG8_SCHED; PG8_LDA(At, 1, 0); PG8_STAGE(PG8_SA(0, 1), a2 + hstep, voffA);
            PG8_WAIT_V(8); PG8_WAIT_L(0); PG8_BAR; PG8_MMA(0, 0, At, B0); PG8_MMA(0, 1, At, B1); PG8_BAR; PG8_SCHED;
            PG8_LDA(At, 1, 1); PG8_STAGE(PG8_SB(1, 0), b3, voffB); PG8_STAGE(PG8_SB(1, 1), b3 + hstep, voffB); PG8_STAGE(PG8_SA(1, 0), a3, voffA);
            PG8_WAIT_V(8); PG8_WAIT_L(0); PG8_BAR; PG8_MMA(1, 0, At, B0); PG8_MMA(1, 1, At, B1); PG8_BAR; PG8_SCHED;
            } else {
            PG8_LDB(B0, 0, 0); PG8_SCHED; PG8_LDA(At, 0, 0); PG8_STAGE(PG8_SA(1, 1), a1 + hstep, voffA);
            PG8_WAIT_L(8); PG8_BAR; PG8_WAIT_L(0); PG8_MMA(0, 0, At, B0); PG8_BAR; PG8_SCHED;
            PG8_LDB(B1, 0, 1); PG8_STAGE(PG8_SB(0, 0), b2, voffB);
            PG8_BAR; PG8_WAIT_L(0); PG8_MMA(0, 1, At, B1); PG8_BAR;
            PG8_LDA(At, 0, 1); PG8_STAGE(PG8_SA(0, 0), a2, voffA);
            PG8_BAR; PG8_WAIT_L(0); PG8_MMA(1, 0, At, B0); PG8_BAR; PG8_SCHED;
            PG8_STAGE(PG8_SB(0, 1), b2 + hstep, voffB);
            PG8_WAIT_V(6); PG8_BAR; PG8_MMA(1, 1, At, B1); PG8_BAR;
            PG8_LDB(B0, 1, 0); PG8_SCHED; PG8_LDA(At, 1, 0); PG8_STAGE(PG8_SA(0, 1), a2 + hstep, voffA);
            PG8_WAIT_L(8); PG8_BAR; PG8_WAIT_L(0); PG8_MMA(0, 0, At, B0); PG8_BAR; PG8_SCHED;
            PG8_LDB(B1, 1, 1); PG8_STAGE(PG8_SB(1, 0), b3, voffB);
            PG8_BAR; PG8_WAIT_L(0); PG8_MMA(0, 1, At, B1); PG8_BAR;
            PG8_LDA(At, 1, 1); PG8_STAGE(PG8_SA(1, 0), a3, voffA);
            PG8_BAR; PG8_WAIT_L(0); PG8_MMA(1, 0, At, B0); PG8_BAR; PG8_SCHED;
            PG8_STAGE(PG8_SB(1, 1), b3 + hstep, voffB);
            PG8_WAIT_V(6); PG8_BAR; PG8_MMA(1, 1, At, B1); PG8_BAR;
            }
        }
        if constexpr (ALIGN_EPI) { if (wr == 0) PG8_BAR; }
        if constexpr (!Epi::AFTER_DRAIN) { E(acc, cur, wr, wc, fr, fq); S.done(cur); }
        if (!has_next) break;
#pragma unroll
        for (int a = 0; a < 2; ++a)
#pragma unroll
            for (int b = 0; b < 2; ++b)
#pragma unroll
                for (int m = 0; m < 4; ++m)
#pragma unroll
                    for (int n = 0; n < 2; ++n) acc[a][b][m][n] = (f32x4){0.f, 0.f, 0.f, 0.f};
        cur = nxt; cA = nA; cB = nB; ++ui;
        if constexpr (ALIGN_EPI) { if (wr == 1) PG8_BAR; }
    }
    PG8_WAIT_V(0);
    if constexpr (!ALIGN_EPI) { if (wr == 0) PG8_BAR; }
    PG8_BAR;
    if constexpr (Epi::AFTER_DRAIN) { E.fused(acc, cur, wr, wc, fr, fq, lds, wid, lane); S.done(cur); }
#undef PG8_SA
#undef PG8_SB
#undef PG8_STAGE
#undef PG8_LDA
#undef PG8_LDB
#undef PG8_MMA
#undef PG8_WAIT_V
#undef PG8_WAIT_L
#undef PG8_BAR
#undef PG8_SCHED
}
}

#define DI __device__ __forceinline__
#ifndef NSA_SKIP
#define NSA_SKIP 0
#endif
#define LAS __attribute__((address_space(3)))
typedef unsigned short bf16;
typedef short bf16x8 __attribute__((ext_vector_type(8)));
typedef short s16x4 __attribute__((ext_vector_type(4)));
typedef float f32x4 __attribute__((ext_vector_type(4)));
typedef float f32x16 __attribute__((ext_vector_type(16)));
typedef unsigned u32x4 __attribute__((ext_vector_type(4)));
typedef unsigned u32x2 __attribute__((ext_vector_type(2)));
#define MFMA32(a, b, c) __builtin_amdgcn_mfma_f32_32x32x16_bf16((a), (b), (c), 0, 0, 0)
#define LDS_WAIT() asm volatile("s_waitcnt lgkmcnt(0)" ::: "memory")

constexpr int SEQ = 8192, TOK = 16384, DM = 1024, FF = 4096, NIN = 8192, NTHR = 512;
constexpr size_t MiB = 1u << 20;
constexpr size_t WS_WIN = 1 * MiB, WS_WA = 17 * MiB, WS_WB = 18 * MiB, WS_WO = 19 * MiB, WS_W1K = 21 * MiB, WS_W1V = 22 * MiB, WS_SMALL = 23 * MiB,
                 WS_KC = 24 * MiB, WS_LSE = 25 * MiB, WS_GB = 27 * MiB, WS_QB = 28 * MiB, WS_KVB = 44 * MiB, WS_R2 = 68 * MiB, WS_R1 = 100 * MiB,
                 WS_WUP = 228 * MiB, WS_WDN = 236 * MiB, WS_END = 244 * MiB;
constexpr int LDS_BYTES = 147456;
constexpr int KVROW = 144, KVT = 64 * KVROW;
constexpr int VROW = 192, VT = 64 * VROW, BUFB = KVT + VT;
constexpr float SC_LOG2E = 0.125f * 1.4426950408889634f;

struct Args { const float* in[16]; float* out; unsigned char* ws; };

struct Frame {
    LAS unsigned char* lds; int tid, lane, wave, G, bid;
    const float *x, *g_mix, *w_in, *pos_k, *w1_k, *w2_k, *pos_v, *w1_v, *w2_v, *w_a, *w_b, *w_out, *g_mlp, *w_up, *w_down, *g_fin;
    float* out; unsigned char* ws;
    DI bf16* WIN() const { return (bf16*)(ws + (WS_WIN)); }
    DI bf16* WA() const { return (bf16*)(ws + (WS_WA)); }
    DI bf16* WB() const { return (bf16*)(ws + (WS_WB)); }
    DI bf16* WO() const { return (bf16*)(ws + (WS_WO)); }
    DI bf16* W1K() const { return (bf16*)(ws + (WS_W1K)); }
    DI bf16* W1V() const { return (bf16*)(ws + (WS_W1V)); }
    DI bf16* W2K() const { return (bf16*)(ws + (WS_SMALL)); }
    DI bf16* W2V() const { return (bf16*)(ws + (WS_SMALL + 32768)); }
    DI bf16* KC() const { return (bf16*)(ws + (WS_KC)); }
    DI bf16* VC() const { return (bf16*)(ws + (WS_KC + 262144)); }
    DI bf16* GB() const { return (bf16*)(ws + (WS_GB)); }
    DI bf16* QB() const { return (bf16*)(ws + (WS_QB)); }
    DI bf16* KVB() const { return (bf16*)(ws + (WS_KVB)); }
    DI bf16* U() const { return (bf16*)(ws + (WS_R2)); }
    DI bf16* OG0() const { return (bf16*)(ws + (WS_R2)); }
    DI bf16* OG1() const { return (bf16*)(ws + (WS_R2 + 16 * MiB)); }
    DI bf16* OG2() const { return (bf16*)(ws + (WS_WIN)); }
    DI bf16* QKVA() const { return (bf16*)(ws + (WS_R1)); }
    DI bf16* YA() const { return (bf16*)(ws + (WS_R1)); }
    DI bf16* YB() const { return (bf16*)(ws + (WS_R1 + 16 * MiB)); }
    DI bf16* MERGED() const { return (bf16*)(ws + (WS_R1 + 96 * MiB)); }
    DI bf16* H() const { return (bf16*)(ws + (WS_R1)); }
    DI bf16* WUP() const { return (bf16*)(ws + (WS_WUP)); }
    DI bf16* WDN() const { return (bf16*)(ws + (WS_WDN)); }
    DI float* BIASK() const { return (float*)(ws + (WS_SMALL + 65536)); }
    DI float* BIASV() const { return (float*)(ws + (WS_SMALL + 81920)); }
    DI float* CS() const { return (float*)(ws + (WS_SMALL + 131072)); }
    DI float* LSE() const { return (float*)(ws + (WS_LSE)); }
    DI float* TMP() const { return (float*)(ws + (WS_R1 + 32 * MiB)); }
    DI bf16* GM() const { return (bf16*)out; }
    DI float* SSP() const { return (float*)(ws + WS_LSE + 1 * MiB); }
    DI bf16* X1B() const { return (bf16*)(ws + WS_QB); }
};

DI float wave_sum(float v) {
#pragma unroll
    for (int o = 1; o < 64; o <<= 1) v += __shfl_xor(v, o);
    return v;
}
DI unsigned f2bf(float f) { unsigned u = __builtin_bit_cast(unsigned, f); return (u + 0x7fffu + ((u >> 16) & 1u)) >> 16; }
DI unsigned pk2(float lo, float hi) { return f2bf(lo) | (f2bf(hi) << 16); }
DI float bf2f(bf16 v) { return __builtin_bit_cast(float, (unsigned)v << 16); }
DI float sigm(float x) { return 1.f / (1.f + __expf(-x)); }
DI f32x16 zero16() { f32x16 z;
#pragma unroll
    for (int i = 0; i < 16; ++i) z[i] = 0.f;
    return z; }

DI void transpose_item(const float* W, int ldw, int col0, int ncols, int k0, bf16* WT, int K, int drow0, LAS float* scr, int lane) {
    const int cl = lane & 31;
#pragma unroll 8
    for (int i = 0; i < 32; ++i) { const int kk = 2 * i + (lane >> 5); scr[kk * 33 + cl] = (cl < ncols) ? W[(size_t)(k0 + kk) * ldw + col0 + cl] : 0.f; }
    LDS_WAIT();
    const int c = lane & 7;
#pragma unroll
    for (int j = 0; j < 4; ++j) { const int n = (lane >> 3) + 8 * j; const LAS float* s = scr + (8 * c) * 33 + n;
        u32x4 o; o.x = pk2(s[0 * 33], s[1 * 33]); o.y = pk2(s[2 * 33], s[3 * 33]); o.z = pk2(s[4 * 33], s[5 * 33]); o.w = pk2(s[6 * 33], s[7 * 33]);
        if (n < ncols) *(u32x4*)(WT + (size_t)(drow0 + n) * K + k0 + 8 * c) = o; }
    LDS_WAIT();
}
DI bool transpose_job(int& item, const float* W, int ldw, int scol0, int ncols, int K, bf16* WT, int drow0, LAS float* scr, int lane) {
    const int nblk = (ncols + 31) >> 5, nitems = (K >> 6) * nblk;
    if (item >= nitems) { item -= nitems; return false; }
    const int kb = item / nblk, nb = item - kb * nblk;
    const int rem = ncols - 32 * nb;
    transpose_item(W, ldw, scol0 + 32 * nb, rem < 32 ? rem : 32, 64 * kb, WT, K, drow0 + 32 * nb, scr, lane);
    return true;
}
DI void transpose_tile256(const float* W, int ldw, int col0, int k0, bf16* WT, int K, int drow0, LAS unsigned char* lds, int tid) {
    const int w = tid >> 6, l = tid & 63;
    LAS float* tile = (LAS float*)lds;
    f32x4 v[8];
#pragma unroll
    for (int i = 0; i < 8; ++i) v[i] = __builtin_nontemporal_load((const f32x4*)(W + (size_t)(k0 + w + 8 * i) * ldw + col0 + 4 * l));
#pragma unroll
    for (int i = 0; i < 8; ++i) *(LAS f32x4*)(tile + (w + 8 * i) * 260 + 4 * l) = v[i];
    __syncthreads();
    const int n = tid & 255;
#pragma unroll
    for (int q = 0; q < 4; ++q) { const int c = (tid >> 8) + 2 * q; const LAS float* sp = tile + (8 * c) * 260 + n;
        u32x4 o; o.x = pk2(sp[0], sp[260]); o.y = pk2(sp[2 * 260], sp[3 * 260]); o.z = pk2(sp[4 * 260], sp[5 * 260]); o.w = pk2(sp[6 * 260], sp[7 * 260]);
        *(u32x4*)(WT + (size_t)(drow0 + n) * K + k0 + 8 * c) = o; }
    __syncthreads();
}
DI bool ttile_job(int& item, const float* W, int ldw, int scol0, int ncols, int K, bf16* WT, int drow0, LAS unsigned char* lds, int tid) {
    const int nblk = ncols >> 8, nitems = (K >> 6) * nblk;
    if (item >= nitems) { item -= nitems; return false; }
    const int kb = item / nblk, nb = item - kb * nblk;
    transpose_tile256(W, ldw, scol0 + 256 * nb, 64 * kb, WT, K, drow0 + 256 * nb, lds, tid);
    return true;
}
DI void rms_row_bf16(const float* xrow, const float* g, bf16* orow, int lane) {
    const f32x4* xr = (const f32x4*)xrow + lane; const f32x4* gr = (const f32x4*)g + lane;
    f32x4 v[4]; float s = 0.f;
#pragma unroll
    for (int j = 0; j < 4; ++j) { v[j] = __builtin_nontemporal_load(xr + 64 * j); s += (v[j].x * v[j].x + v[j].y * v[j].y) + (v[j].z * v[j].z + v[j].w * v[j].w); }
    const float rstd = 1.f / sqrtf(wave_sum(s) * (1.f / DM) + 1e-6f);
    unsigned long long* o8 = (unsigned long long*)orow + lane;
#pragma unroll
    for (int j = 0; j < 4; ++j) { const f32x4 gg = gr[64 * j];
        o8[64 * j] = (unsigned long long)pk2(v[j].x * rstd * gg.x, v[j].y * rstd * gg.y) | ((unsigned long long)pk2(v[j].z * rstd * gg.z, v[j].w * rstd * gg.w) << 32); }
}
DI void rms_row_f32_inplace(float* xrow, const float* g, int lane) {
    f32x4* xr = (f32x4*)xrow + lane; const f32x4* gr = (const f32x4*)g + lane;
    f32x4 v[4]; float s = 0.f;
#pragma unroll
    for (int j = 0; j < 4; ++j) { v[j] = xr[64 * j]; s += (v[j].x * v[j].x + v[j].y * v[j].y) + (v[j].z * v[j].z + v[j].w * v[j].w); }
    const float rstd = 1.f / sqrtf(wave_sum(s) * (1.f / DM) + 1e-6f);
#pragma unroll
    for (int j = 0; j < 4; ++j) xr[64 * j] = v[j] * rstd * gr[64 * j];
}

DI void rms_row_bf16_to_f32(const bf16* xrow, const float* g, float* orow, int lane) {
    const u32x2* xr = (const u32x2*)xrow + lane; const f32x4* gr = (const f32x4*)g + lane;
    f32x4 v[4]; float s = 0.f;
#pragma unroll
    for (int j = 0; j < 4; ++j) { const u32x2 w = __builtin_nontemporal_load(xr + 64 * j); v[j] = (f32x4){pg8::bf_lo(w.x), pg8::bf_hi(w.x), pg8::bf_lo(w.y), pg8::bf_hi(w.y)};
        s += (v[j].x * v[j].x + v[j].y * v[j].y) + (v[j].z * v[j].z + v[j].w * v[j].w); }
    const float rstd = 1.f / sqrtf(wave_sum(s) * (1.f / DM) + 1e-6f);
    f32x4* o4 = (f32x4*)orow + lane;
#pragma unroll
    for (int j = 0; j < 4; ++j) { const f32x4 r = v[j] * rstd * gr[64 * j]; __builtin_nontemporal_store(r, o4 + 64 * j); }
}
DI void rms_row_bf16_to_bf16(const bf16* xrow, const float* g, bf16* orow, int lane) {
    const u32x2* xr = (const u32x2*)xrow + lane; const f32x4* gr = (const f32x4*)g + lane;
    f32x4 v[4]; float s = 0.f;
#pragma unroll
    for (int j = 0; j < 4; ++j) { const u32x2 w = __builtin_nontemporal_load(xr + 64 * j); v[j] = (f32x4){pg8::bf_lo(w.x), pg8::bf_hi(w.x), pg8::bf_lo(w.y), pg8::bf_hi(w.y)};
        s += (v[j].x * v[j].x + v[j].y * v[j].y) + (v[j].z * v[j].z + v[j].w * v[j].w); }
    const float rstd = 1.f / sqrtf(wave_sum(s) * (1.f / DM) + 1e-6f);
    unsigned long long* o8 = (unsigned long long*)orow + lane;
#pragma unroll
    for (int j = 0; j < 4; ++j) { const f32x4 gg = gr[64 * j];
        o8[64 * j] = (unsigned long long)pk2(v[j].x * rstd * gg.x, v[j].y * rstd * gg.y) | ((unsigned long long)pk2(v[j].z * rstd * gg.z, v[j].w * rstd * gg.w) << 32); }
}
DI void p0_prologue(const Frame& F) {
    LAS float* scr = (LAS float*)(F.lds + F.wave * 16384);
    const int gw = F.bid * 8 + F.wave, NGW = F.G * 8;
    constexpr int NTILES = 16 * 23 + 16 * 8 + 32 + 32;
    for (int it = F.bid; it < NTILES; it += F.G) {
        int r = it;
        if (ttile_job(r, F.w_in, 7960, 0, 5888, DM, F.WIN(), 0, F.lds, F.tid)) continue;
        if (ttile_job(r, F.w_in, 7960, 5912, 2048, DM, F.WIN(), 5888, F.lds, F.tid)) continue;
        if (ttile_job(r, F.w1_k, 256, 0, 256, 2048, F.W1K(), 0, F.lds, F.tid)) continue;
        ttile_job(r, F.w1_v, 256, 0, 256, 2048, F.W1V(), 0, F.lds, F.tid);
    }
    constexpr int NITEMS = 16 + 8 + 8;
    for (int it = gw; it < NITEMS; it += NGW) {
        int r = it;
        if (transpose_job(r, F.w_in, 7960, 5888, 24, DM, F.WIN(), 7936, scr, F.lane)) continue;
        if (transpose_job(r, F.w2_k, 64, 0, 64, 256, F.W2K(), 0, scr, F.lane)) continue;
        transpose_job(r, F.w2_v, 64, 0, 64, 256, F.W2V(), 0, scr, F.lane);
    }
    __syncthreads();
    const int gt = F.bid * NTHR + F.tid, NGT = F.G * NTHR;
    for (int i = gt; i < 232 * 1024 / 8; i += NGT) *(u32x4*)(F.WIN() + (size_t)7960 * 1024 + (size_t)i * 8) = (u32x4){0u, 0u, 0u, 0u};
    for (int i = gt; i < SEQ * 8; i += NGT) {
        const int s = i >> 3, k = i & 7;
        const double inv[8] = {1.0, 0.19392274474868576, 0.03760603093086393, 0.007292664737217109, 0.001414213562373095, 0.0002742481756762073, 5.318295896944988e-05, 1.031338537721246e-05};
        double iv = inv[0];
#pragma unroll
        for (int q = 1; q < 8; ++q) iv = (k == q) ? inv[q] : iv;
        const double rev = (double)s * iv * 0.15915494309189535;
        const float fr = (float)(rev - __builtin_rint(rev));
        F.CS()[s * 16 + k] = __builtin_amdgcn_cosf(fr); F.CS()[s * 16 + 8 + k] = __builtin_amdgcn_sinf(fr);
    }
    for (int m = gw; m < TOK; m += NGW) rms_row_bf16(F.x + (size_t)m * DM, F.g_mix, F.U() + (size_t)m * DM, F.lane);
    if (F.bid < 32) {
        const int mat = F.bid >> 4, part = F.bid & 15, col = F.tid & 255, kh = F.tid >> 8;
        const float* pe = mat ? F.pos_v : F.pos_k; const float* W1 = mat ? F.w1_v : F.w1_k; float acc = 0.f;
        const int kb = part * 128 + kh * 64;
#pragma unroll 8
        for (int k = 0; k < 64; ++k) acc += pe[kb + k] * W1[(size_t)(kb + k) * 256 + col];
        LAS float* red = (LAS float*)F.lds;
        __syncthreads();
        if (kh) red[col] = acc;
        __syncthreads();
        if (!kh) (mat ? F.BIASV() : F.BIASK())[part * 256 + col] = acc + red[col];
        __syncthreads();
    }
    if (F.bid == 2) { const int kv = F.tid >> 8, bg = (F.tid >> 6) & 3, d = F.tid & 63; (kv ? F.VC() : F.KC())[((bg * 512 + 511) << 6) + d] = 0; }
}

struct Stg { u32x4 k, v; };
DI void stage_load(Stg& s, const bf16* Kg, const bf16* Vg, int row0, int tid) {
    s.k = *(const u32x4*)(Kg + ((size_t)row0 << 6) + tid * 8); s.v = *(const u32x4*)(Vg + ((size_t)row0 << 6) + tid * 8);
}
DI void stage_store(const Stg& s, LAS unsigned char* lds, int buf, int tid) {
    *(LAS u32x4*)(lds + buf * BUFB + (tid >> 3) * KVROW + (tid & 7) * 16) = s.k; *(LAS u32x4*)(lds + buf * BUFB + KVT + (tid >> 3) * VROW + (tid & 7) * 16) = s.v;
}
DI unsigned pkbf(float a, float b) {
    typedef __bf16 bf2 __attribute__((ext_vector_type(2))); typedef float f2 __attribute__((ext_vector_type(2)));
    f2 v = {a, b}; bf2 r = __builtin_convertvector(v, bf2); return __builtin_bit_cast(unsigned, r);
}
DI void qk_tile(LAS const unsigned char* kt, const bf16x8 (&qf)[4], f32x16 (&s)[2], int lane) {
    const int r = lane & 31, h = lane >> 5;
    const int sr = (r & 19) | ((r & 4) << 1) | ((r & 8) >> 1);
    LAS const unsigned char* kp = kt + sr * KVROW + h * 16;
    bf16x8 ka[8];
#pragma unroll
    for (int kh = 0; kh < 2; ++kh)
#pragma unroll
        for (int ks = 0; ks < 4; ++ks) ka[kh * 4 + ks] = *(LAS const bf16x8*)(kp + kh * 32 * KVROW + ks * 32);
    s[0] = zero16(); s[1] = zero16();
    __builtin_amdgcn_s_setprio(1);
#pragma unroll
    for (int ks = 0; ks < 4; ++ks) { s[0] = MFMA32(ka[ks], qf[ks], s[0]); s[1] = MFMA32(ka[4 + ks], qf[ks], s[1]); }
    __builtin_amdgcn_s_setprio(0);
}
DI float xhalf_max(float v) { auto rr = __builtin_amdgcn_permlane32_swap(__float_as_uint(v), __float_as_uint(v), false, false); return fmaxf(__uint_as_float(rr[0]), __uint_as_float(rr[1])); }
DI float xhalf_sum(float v) { auto rr = __builtin_amdgcn_permlane32_swap(__float_as_uint(v), __float_as_uint(v), false, false); return __uint_as_float(rr[0]) + __uint_as_float(rr[1]); }
typedef float f32x2 __attribute__((ext_vector_type(2)));
#define OPQ(x) asm("" : "+v"(x))
DI void flash_tile(LAS const unsigned char* kt, LAS const unsigned char* vt, const bf16x8 (&qf)[4], f32x16 (&o)[2], float& m, float& l, int dq, unsigned maxoff, bool sel, int lane) {
    const int h = lane >> 5;
    f32x16 s[2];
    qk_tile(kt, qf, s, lane);
    bf16x8 vf[2][2][2];
    {
        const int q4 = (lane & 15) >> 2, p4 = lane & 3, blk = (lane >> 4) & 1;
        LAS const unsigned char* vb = vt + (8 * h + q4) * VROW + 8 * (4 * blk + p4);
#pragma unroll
        for (int kh = 0; kh < 2; ++kh)
#pragma unroll
            for (int s2 = 0; s2 < 2; ++s2)
#pragma unroll
                for (int db = 0; db < 2; ++db) {
                    LAS const unsigned char* vp = vb + (32 * kh + 16 * s2) * VROW + db * 64;
                    const s16x4 lo = __builtin_amdgcn_ds_read_tr16_b64_v4i16((LAS s16x4*)(vp));
                    const s16x4 hi = __builtin_amdgcn_ds_read_tr16_b64_v4i16((LAS s16x4*)(vp + 4 * VROW));
                    vf[kh][s2][db] = __builtin_shufflevector(lo, hi, 0, 1, 2, 3, 4, 5, 6, 7);
                }
    }
    const bool lane_full = (dq >= 55) && ((unsigned)dq <= maxoff);
    if (__ballot(!lane_full) != 0ull) {
#pragma unroll
        for (int kh = 0; kh < 2; ++kh)
#pragma unroll
            for (int i = 0; i < 16; ++i) { const int kk = 32 * kh + 16 * (i >> 3) + (i & 7); s[kh][i] = ((unsigned)(dq - kk) <= maxoff) ? s[kh][i] : -1e30f; }
    }
    asm volatile("s_nop 15\n\ts_nop 15" : "+v"(s[0]), "+v"(s[1]));
#define MAX3(d, a, b, c) asm("v_max3_f32 %0, %1, %2, %3" : "=v"(d) : "v"(a), "v"(b), "v"(c))
    float ma[10], mc2[4], mx;
#pragma unroll
    for (int i = 0; i < 5; ++i) { MAX3(ma[i], s[0][3 * i], s[0][3 * i + 1], s[0][3 * i + 2]); MAX3(ma[5 + i], s[1][3 * i], s[1][3 * i + 1], s[1][3 * i + 2]); }
    MAX3(mc2[0], ma[0], ma[1], ma[2]); MAX3(mc2[1], ma[3], ma[4], ma[5]); MAX3(mc2[2], ma[6], ma[7], ma[8]); MAX3(mc2[3], ma[9], s[0][15], s[1][15]);
    { float t0, t1; MAX3(t0, mc2[0], mc2[1], mc2[2]); MAX3(t1, mc2[3], t0, t0); mx = t1; }
#undef MAX3
    mx = xhalf_max(mx);
    mx = sel ? mx : -1e30f;
    const bool need = mx > m + 40.f;
    if (__ballot(need) != 0ull) {
        const float mn = need ? mx : m;
        const float alpha = need ? __builtin_amdgcn_exp2f((m - mn) * SC_LOG2E) : 1.f;
        m = mn; l *= alpha;
#pragma unroll
        for (int i = 0; i < 16; ++i) { float a = o[0][i] * alpha, b = o[1][i] * alpha; OPQ(a); OPQ(b); o[0][i] = a; o[1][i] = b; }
    }
    const float nmb = sel ? -fmaxf(m, -1e20f) * SC_LOG2E : -1e30f;
    float pa[4] = {0.f, 0.f, 0.f, 0.f};
#pragma unroll
    for (int kh = 0; kh < 2; ++kh)
#pragma unroll
        for (int i = 0; i < 16; ++i) {
            float x = __builtin_fmaf(s[kh][i], SC_LOG2E, nmb); OPQ(x);
            const float p = __builtin_amdgcn_exp2f(x);
            float a = pa[i & 3] + p; OPQ(a); pa[i & 3] = a;
            s[kh][i] = p; }
    l += (pa[0] + pa[1]) + (pa[2] + pa[3]);
#pragma unroll
    for (int kh = 0; kh < 2; ++kh)
#pragma unroll
        for (int s2 = 0; s2 < 2; ++s2) {
            u32x4 pw; pw.x = pkbf(s[kh][8 * s2 + 0], s[kh][8 * s2 + 1]); pw.y = pkbf(s[kh][8 * s2 + 2], s[kh][8 * s2 + 3]);
            pw.z = pkbf(s[kh][8 * s2 + 4], s[kh][8 * s2 + 5]); pw.w = pkbf(s[kh][8 * s2 + 6], s[kh][8 * s2 + 7]);
            const bf16x8 pf = __builtin_bit_cast(bf16x8, pw);
            o[0] = MFMA32(vf[kh][s2][0], pf, o[0]); o[1] = MFMA32(vf[kh][s2][1], pf, o[1]);
        }
}
#define TILE_LOOP(T0, T1, ROWOF, KPTR, VPTR, BODY) do { \
    Stg sA_, sB_; const int t1_ = (T1); int t_ = (T0); \
    if (t_ < t1_) stage_load(sA_, KPTR, VPTR, ROWOF(t_), tid); \
    if (t_ + 1 < t1_) stage_load(sB_, KPTR, VPTR, ROWOF(t_ + 1), tid); \
    for (; t_ < t1_; t_ += 2) { \
        { const int ct = t_; const int buf = 0; stage_store(sA_, F.lds, 0, tid); __syncthreads(); if (ct + 2 < t1_) stage_load(sA_, KPTR, VPTR, ROWOF(ct + 2), tid); BODY } \
        if (t_ + 1 < t1_) { const int ct = t_ + 1; const int buf = 1; stage_store(sB_, F.lds, 1, tid); __syncthreads(); if (ct + 2 < t1_) stage_load(sB_, KPTR, VPTR, ROWOF(ct + 2), tid); BODY } \
    } \
    __syncthreads(); } while (0)
DI void write_o_row(bf16* dst, const f32x16 (&o)[2], float scale, int h) {
#pragma unroll
    for (int db = 0; db < 2; ++db)
#pragma unroll
        for (int i4 = 0; i4 < 4; ++i4) {
            u32x2 w; w.x = pkbf(o[db][4 * i4] * scale, o[db][4 * i4 + 1] * scale); w.y = pkbf(o[db][4 * i4 + 2] * scale, o[db][4 * i4 + 3] * scale);
            *(u32x2*)(dst + 32 * db + 8 * i4 + 4 * h) = w;
        }
}

DI void mixa_task(const Frame& F, int task) {
    const int tile32 = task & 31, hb = task >> 5, b = hb & 1, head = hb >> 1;
    const int g = head >> 3, slot = head & 7, lg = 2 * g;
    const int prow0 = tile32 * 256, L = SEQ >> lg, res = prow0 >> (13 - lg), p0 = prow0 & (L - 1);
    const bf16* Q = F.QKVA() + ((size_t)((head) * 2 + b) << 19);
    const bf16* K = F.QKVA() + ((size_t)((24 + head) * 2 + b) << 19);
    const bf16* V = F.QKVA() + ((size_t)((48 + head) * 2 + b) << 19);
    const int w = F.wave, lane = F.lane, r = lane & 31, h = lane >> 5;
    bf16x8 qf[4];
    { const bf16* qr = Q + ((size_t)(prow0 + 32 * w + r) << 6) + 8 * h;
#pragma unroll
      for (int ks = 0; ks < 4; ++ks) qf[ks] = *(const bf16x8*)(qr + 16 * ks); }
    f32x16 o[2] = {zero16(), zero16()}; float m = -1e30f, l = 0.f;
    const int kt0 = (p0 == 0) ? 2 : 0;
    const int tid = F.tid;
#define ROWOF_A(kt) (prow0 - 128 + 64 * (kt))
    TILE_LOOP(kt0, 6, ROWOF_A, K, V, {
        if (ct >= (w >> 1) && ct <= (w >> 1) + 2)
            flash_tile(F.lds + buf * BUFB, F.lds + buf * BUFB + KVT, qf, o, m, l, 128 + 32 * w + r - 64 * ct - 8 * h, 128u, true, lane);
    });
#undef ROWOF_A
    const float lt = xhalf_sum(l);
    const float inv = 1.f / lt;
    const int s = ((p0 + 32 * w + r) << lg) | res;
    const size_t row = (size_t)b * SEQ + s;
    bf16* og = (bf16*)(F.ws + ((g == 0) ? WS_R2 : (g == 1) ? (WS_R2 + 16 * MiB) : WS_WIN));
    write_o_row(og + row * 512 + slot * 64, o, inv, h);
    if (h == 0) F.LSE()[((size_t)g * TOK + row) * 8 + slot] = m * 0.125f + __logf(lt);
}

DI float gelu_tanh(float x) { const float u = 0.7978845608028654f * (x + 0.044715f * x * x * x); const float e = __expf(2.f * u); const float t = 1.f - 2.f / (e + 1.f); return 0.5f * x * (1.f + t); }
DI void compress_task(const Frame& F, int task) {
    const int kv = task >> 5, bg = (task >> 3) & 3, it = task & 7;
    const bf16* A = F.KVB() + ((size_t)(kv * 4 + bg) << 19);
    const bf16* W1T = kv ? F.W1V() : F.W1K(); const bf16* W2T = kv ? F.W2V() : F.W2K(); const float* bias = kv ? F.BIASV() : F.BIASK();
    bf16* OUT = (kv ? F.VC() : F.KC()) + ((size_t)bg << 15);
    const int w = F.wave, lane = F.lane, r = lane & 31, h = lane >> 5;
    LAS unsigned char* hid = F.lds;
    f32x16 acc[2] = {zero16(), zero16()};
    int i0 = 64 * it + r, i1 = i0 + 32; i0 = i0 > 510 ? 510 : i0; i1 = i1 > 510 ? 510 : i1;
    const bf16* a0p = A + (size_t)i0 * 1024 + 8 * h; const bf16* a1p = A + (size_t)i1 * 1024 + 8 * h;
    const bf16* bp = W1T + (size_t)(32 * w + r) * 2048 + 8 * h;
#pragma unroll 4
    for (int k0 = 0; k0 < 2048; k0 += 16) {
        const bf16x8 bfr = *(const bf16x8*)(bp + k0), a0 = *(const bf16x8*)(a0p + k0), a1 = *(const bf16x8*)(a1p + k0);
        acc[0] = MFMA32(a0, bfr, acc[0]); acc[1] = MFMA32(a1, bfr, acc[1]);
    }
    float bs = 0.f;
#pragma unroll
    for (int j = 0; j < 16; ++j) bs += bias[j * 256 + 32 * w + r];
#pragma unroll
    for (int rb = 0; rb < 2; ++rb)
#pragma unroll
        for (int i = 0; i < 16; ++i) { const int row = 32 * rb + (i & 3) + 8 * (i >> 2) + 4 * h;
            *(LAS bf16*)(hid + row * 528 + (32 * w + r) * 2) = (bf16)f2bf(gelu_tanh(acc[rb][i] + bs)); }
    __syncthreads();
    if (w < 4) {
        const int rb = w & 1, cb = w >> 1; f32x16 c = zero16();
        const bf16* b2 = W2T + (size_t)(32 * cb + r) * 256 + 8 * h;
#pragma unroll
        for (int k0 = 0; k0 < 256; k0 += 16) { const bf16x8 a = *(LAS const bf16x8*)(hid + (32 * rb + r) * 528 + (k0 + 8 * h) * 2); const bf16x8 bb = *(const bf16x8*)(b2 + k0); c = MFMA32(a, bb, c); }
#pragma unroll
        for (int i = 0; i < 16; ++i) { const int row = 64 * it + 32 * rb + (i & 3) + 8 * (i >> 2) + 4 * h;
            if (row < 511) OUT[((size_t)row << 6) + 32 * cb + r] = (bf16)f2bf(c[i]); }
    }
    __syncthreads();
}

DI float dpp_quad_sum(float p) {
    p += __builtin_bit_cast(float, __builtin_amdgcn_update_dpp(0, __builtin_bit_cast(int, p), 0xB1, 0xF, 0xF, true));
    p += __builtin_bit_cast(float, __builtin_amdgcn_update_dpp(0, __builtin_bit_cast(int, p), 0x4E, 0xF, 0xF, true));
    return p;
}
DI void imp_tile(LAS const unsigned char* kt, const bf16x8 (&qf)[4], LAS float* ipb, int dq, float mb, float invc, int lane) {
    f32x16 s[2];
    qk_tile(kt, qf, s, lane);
#pragma unroll
    for (int kh = 0; kh < 2; ++kh)
#pragma unroll
        for (int s2 = 0; s2 < 2; ++s2) {
            float ps[8];
#pragma unroll
            for (int j = 0; j < 8; ++j) { const int kk = 32 * kh + 16 * s2 + j; const bool v = (dq - kk) >= 0;
                const float p = v ? __builtin_amdgcn_exp2f(s[kh][8 * s2 + j] * SC_LOG2E - mb) * invc : 0.f; ps[j] = dpp_quad_sum(p); }
            const float sa = (ps[0] + ps[1]) + (ps[2] + ps[3]), sb = (ps[4] + ps[5]) + (ps[6] + ps[7]);
            LAS float* ip = ipb + 8 * kh + 4 * s2;
            if ((lane & 3) == 0) {
                __hip_atomic_fetch_add(ip, sa, __ATOMIC_RELAXED, __HIP_MEMORY_SCOPE_WORKGROUP);
                __hip_atomic_fetch_add(ip + 1, sb + ps[3], __ATOMIC_RELAXED, __HIP_MEMORY_SCOPE_WORKGROUP);
                __hip_atomic_fetch_add(ip + 2, ps[7], __ATOMIC_RELAXED, __HIP_MEMORY_SCOPE_WORKGROUP);
            }
        }
}
DI unsigned wave_umax(unsigned v) {
#define WUM_STEP(ctrl) { const unsigned t = (unsigned)__builtin_amdgcn_update_dpp((int)v, (int)v, (ctrl), 0xF, 0xF, false); v = v > t ? v : t; }
    WUM_STEP(0xB1) WUM_STEP(0x4E) WUM_STEP(0x141) WUM_STEP(0x140)
#undef WUM_STEP
    const unsigned r0 = (unsigned)__builtin_amdgcn_readlane((int)v, 0), r1 = (unsigned)__builtin_amdgcn_readlane((int)v, 16), r2 = (unsigned)__builtin_amdgcn_readlane((int)v, 32), r3 = (unsigned)__builtin_amdgcn_readlane((int)v, 48);
    const unsigned a = r0 > r1 ? r0 : r1, b = r2 > r3 ? r2 : r3;
    return a > b ? a : b;
}
DI void stash_put(LAS f32x4* st, const f32x16 (&y)[2], int tid) {
#pragma unroll
    for (int i = 0; i < 8; ++i) { const f32x16& v = y[i >> 2]; const int q = (i & 3) * 4; st[i * 512 + tid] = (f32x4){v[q], v[q + 1], v[q + 2], v[q + 3]}; }
}
DI void stash_add(LAS const f32x4* st, f32x16 (&y)[2], int tid) {
#pragma unroll
    for (int i = 0; i < 8; ++i) { const f32x4 a = st[i * 512 + tid]; const int q = (i & 3) * 4; f32x16& v = y[i >> 2]; v[q] += a[0]; v[q + 1] += a[1]; v[q + 2] += a[2]; v[q + 3] += a[3]; }
}
DI void nsa_task(const Frame& F, int b, int g, int tt) {
    const int w = F.wave, lane = F.lane, r = lane & 31, h = lane >> 5, tid = F.tid;
    const int t0 = tt * 64, tok = 8 * w + (r >> 2), t = t0 + tok, head = 4 * g + (r & 3);
    const size_t row = (size_t)b * SEQ + t;
    const int bg = b * 2 + g;
    bf16x8 qf[4];
    { const bf16* qr = F.QB() + row * 512 + head * 64 + 8 * h;
#pragma unroll
      for (int ks = 0; ks < 4; ++ks) qf[ks] = *(const bf16x8*)(qr + 16 * ks); }
    float g0, g1, g2;
    { const bf16* gp = F.GB() + row * 32 + head * 3; g0 = sigm(bf2f(gp[0])); g1 = sigm(bf2f(gp[1])); g2 = sigm(bf2f(gp[2])); }
    LAS float* imp = (LAS float*)(F.lds + 2 * BUFB);
    for (int i = tid; i < 64 * 132; i += NTHR) imp[i] = 0.f;
    LAS f32x4* ystash = (LAS f32x4*)(F.lds + 2 * BUFB + 64 * 132 * 4);
    const int nvis = (4 * tt + 3) < 511 ? (4 * tt + 3) : 511, nct = (NSA_SKIP == 3) ? 1 : (nvis + 63) >> 6;
    const bf16* Kc = F.KC() + ((size_t)bg << 15); const bf16* Vc = F.VC() + ((size_t)bg << 15);
    const int lim = (t - 31) >> 4;
    float mc, invc;
    {
        f32x16 o[2] = {zero16(), zero16()}; float m = -1e30f, l = 0.f;
#define ROWOF_T(ct_) (64 * (ct_))
        TILE_LOOP(0, nct, ROWOF_T, Kc, Vc, {
            flash_tile(F.lds + buf * BUFB, F.lds + buf * BUFB + KVT, qf, o, m, l, lim - 64 * ct - 8 * h, 0x7fffffffu, true, lane);
        });
        const float lt = xhalf_sum(l);
        invc = lt > 0.f ? 1.f / lt : 0.f; mc = m;
        o[0] *= (g0 * invc); o[1] *= (g0 * invc); stash_put(ystash, o, tid);
    }
    {
        const float mb = mc * SC_LOG2E;
        TILE_LOOP(0, nct, ROWOF_T, Kc, Vc, { imp_tile(F.lds + buf * BUFB, qf, imp + tok * 132 + 16 * ct + 2 * h, lim - 64 * ct - 8 * h, mb, invc, lane); });
        LDS_WAIT();
        __syncthreads();
    }
    unsigned long long mlo = 0ull, mhi = 0ull;
    if (tt <= 15 || NSA_SKIP == 3) { mlo = (2ull << (tt & 63)) - 1ull; mhi = mlo; }
    else {
        for (int tk = 0; tk < 8; ++tk) {
            LAS const float* rowp = imp + (8 * w + tk) * 132;
            const int ma = lane, mb2 = lane + 64;
            const bool ca = (ma >= 1 && ma <= tt - 2), cb = (mb2 <= tt - 2);
            unsigned ka = ca ? __float_as_uint(rowp[ma]) + 1u : 0u, kb = cb ? __float_as_uint(rowp[mb2]) + 1u : 0u;
            bool sa = false, sb = false;
            for (int it = 0; it < 13; ++it) {
                const unsigned mxk = wave_umax(ka > kb ? ka : kb);
                const unsigned long long ea = __ballot(ka == mxk);
                if (ea != 0ull) { if (lane == (int)__builtin_ctzll(ea)) { sa = true; ka = 0u; } }
                else { const unsigned long long eb = __ballot(kb == mxk); if (lane == (int)__builtin_ctzll(eb)) { sb = true; kb = 0u; } }
            }
            unsigned long long ba = __ballot(sa), bb = __ballot(sb);
            ba |= 1ull;
            if (tt < 64) ba |= 1ull << tt; else bb |= 1ull << (tt - 64);
            if (tt - 1 < 64) ba |= 1ull << (tt - 1); else bb |= 1ull << (tt - 1 - 64);
            if ((r >> 2) == tk) { mlo = ba; mhi = bb; }
        }
    }
    {
        const bf16* Ks = F.KVB() + ((size_t)(2 * 4 + bg) << 19); const bf16* Vs = F.KVB() + ((size_t)(3 * 4 + bg) << 19);
        f32x16 o[2] = {zero16(), zero16()}; float m = -1e30f, l = 0.f;
        TILE_LOOP(0, (NSA_SKIP == 1) ? 1 : tt + 1, ROWOF_T, Ks, Vs, {
            const bool sel = ((ct < 64 ? (mlo >> ct) : (mhi >> (ct - 64))) & 1ull) != 0ull;
            if (__ballot(sel) != 0ull)
                flash_tile(F.lds + buf * BUFB, F.lds + buf * BUFB + KVT, qf, o, m, l, t - 64 * ct - 8 * h, 0x7fffffffu, sel, lane);
        });
        const float lt = xhalf_sum(l); const float sc = g1 / lt;
        o[0] *= sc; o[1] *= sc; stash_add(ystash, o, tid); stash_put(ystash, o, tid);
    }
    {
        const bf16* Kw = F.KVB() + ((size_t)(4 * 4 + bg) << 19); const bf16* Vw = F.KVB() + ((size_t)(5 * 4 + bg) << 19);
        f32x16 o[2] = {zero16(), zero16()}; float m = -1e30f, l = 0.f;
        const int c0 = tt > 8 ? tt - 8 : 0;
        TILE_LOOP((NSA_SKIP == 2) ? tt : c0, tt + 1, ROWOF_T, Kw, Vw, {
            flash_tile(F.lds + buf * BUFB, F.lds + buf * BUFB + KVT, qf, o, m, l, t - 64 * ct - 8 * h, 511u, true, lane);
        });
#undef ROWOF_T
        const float lt = xhalf_sum(l); const float sc = g2 / lt;
        o[0] *= sc; o[1] *= sc; stash_add(ystash, o, tid);
        write_o_row(F.YB() + row * 512 + head * 64, o, 1.f, h);
    }
}

DI void combine_ya_task(const Frame& F, int task) {
    for (int i = task * 4096 + F.tid; i < (task + 1) * 4096; i += NTHR) {
        const int row = i >> 6, ch = i & 63, slot = ch >> 3;
        const float l0 = __builtin_nontemporal_load(F.LSE() + ((size_t)0 * TOK + row) * 8 + slot), l1 = __builtin_nontemporal_load(F.LSE() + ((size_t)1 * TOK + row) * 8 + slot), l2 = __builtin_nontemporal_load(F.LSE() + ((size_t)2 * TOK + row) * 8 + slot);
        const float mx = fmaxf(l0, fmaxf(l1, l2)); float w0 = __expf(l0 - mx), w1 = __expf(l1 - mx), w2 = __expf(l2 - mx);
        const float inv = 1.f / (w0 + w1 + w2); w0 *= inv; w1 *= inv; w2 *= inv;
        const size_t off = (size_t)row * 512 + ch * 8;
        const u32x4 a = __builtin_nontemporal_load((const u32x4*)(F.OG0() + off)), bb = __builtin_nontemporal_load((const u32x4*)(F.OG1() + off)), c = __builtin_nontemporal_load((const u32x4*)(F.OG2() + off));
        u32x4 o;
#pragma unroll
        for (int e = 0; e < 4; ++e) {
            const float lo = w0 * pg8::bf_lo(a[e]) + w1 * pg8::bf_lo(bb[e]) + w2 * pg8::bf_lo(c[e]);
            const float hi = w0 * pg8::bf_hi(a[e]) + w1 * pg8::bf_hi(bb[e]) + w2 * pg8::bf_hi(c[e]);
            o[e] = pk2(lo, hi);
        }
        __builtin_nontemporal_store(o, (u32x4*)(F.YA() + off));
    }
}

#define XB_TMO      128
#define XB_XCNT(j)  (256  + 64 * (j))
#define XB_XSUB(j)  (1280 + 64 * (j))
#define XB_XGEN(j)  (2304 + 64 * (j))
#define XB_TOP      3328
#define XB_TOPGEN   3392
#define XCD_BAR_WORDS 3456
#define XB_SPIN_CAP (1u << 18)

__device__ __forceinline__ unsigned xb_ld(unsigned* p)              { return __hip_atomic_load(p, __ATOMIC_RELAXED, __HIP_MEMORY_SCOPE_AGENT); }
__device__ __forceinline__ unsigned xb_add(unsigned* p, unsigned v) { return __hip_atomic_fetch_add(p, v, __ATOMIC_RELAXED, __HIP_MEMORY_SCOPE_AGENT); }
__device__ __forceinline__ unsigned xb_xcc_id() { return (unsigned)__builtin_amdgcn_s_getreg((3 << 11) | 20) & 0xFu; }
#define XB_SPIN(cond, bar) do { unsigned _sp = 0; while (cond) { __builtin_amdgcn_s_sleep(1); \
    if ((++_sp & 255u) == 0u) { if (xb_ld(&(bar)[XB_TMO])) break; if (_sp > XB_SPIN_CAP) { atomicAdd(&(bar)[XB_TMO], 1u); break; } } } } while (0)
struct XcdBarrier {
    unsigned* bar; unsigned x;
    volatile LAS unsigned* st;
};

__device__ __forceinline__ XcdBarrier xcd_barrier_post(unsigned* bar, volatile LAS unsigned* st) {
    XcdBarrier b; b.bar = bar; b.x = xb_xcc_id(); b.st = st;
    if (threadIdx.x == 0) (void)xb_add(&bar[XB_XCNT(b.x)], 1u);
    return b;
}
__device__ __forceinline__ void xcd_barrier_complete(unsigned* bar, unsigned x, unsigned& nloc, unsigned& nx) {
    const unsigned G = gridDim.x * gridDim.y * gridDim.z;
    unsigned sum, cnt, mine, sp = 0u;
    for (;;) {
        sum = 0u; cnt = 0u; mine = 0u;
#pragma unroll
        for (unsigned j = 0; j < 16; ++j) { const unsigned c = xb_ld(&bar[XB_XCNT(j)]); sum += c; cnt += (c > 0u) ? 1u : 0u; mine = (j == x) ? c : mine; }
        if (sum == G) break;
        __builtin_amdgcn_s_sleep(1);
        if ((++sp & 255u) == 0u) { if (xb_ld(&bar[XB_TMO])) break; if (sp > XB_SPIN_CAP) { atomicAdd(&bar[XB_TMO], 1u); break; } }
    }
    nloc = mine > 0u ? mine : 1u; nx = cnt > 0u ? cnt : 1u;
}

__device__ __forceinline__ void xcd_barrier(const XcdBarrier& b) {
    asm volatile("s_waitcnt vmcnt(0)" ::: "memory");
    __syncthreads();
    if (threadIdx.x == 0) {
        unsigned* bar = b.bar;
        __builtin_amdgcn_s_waitcnt(0);
        unsigned nloc = b.st[0], nx = b.st[1];
        if (nloc == 0u) { xcd_barrier_complete(bar, b.x, nloc, nx); b.st[0] = nloc; b.st[1] = nx; }
        const unsigned old = xb_add(&bar[XB_XSUB(b.x)], 1u);
        const unsigned gen = old / nloc;
        if (old + 1u == (gen + 1u) * nloc) {
            __builtin_amdgcn_fence(__ATOMIC_RELEASE, "agent");
            asm volatile("s_waitcnt vmcnt(0)" ::: "memory");
            const unsigned og = xb_add(&bar[XB_TOP], 1u);
            const unsigned tg = og / nx;
            if (og + 1u == (tg + 1u) * nx) xb_add(&bar[XB_TOPGEN], 1u);
            else XB_SPIN(xb_ld(&bar[XB_TOPGEN]) == tg, bar);
            __builtin_amdgcn_fence(__ATOMIC_ACQUIRE, "agent");
            xb_add(&bar[XB_XGEN(b.x)], 1u);
            asm volatile("s_waitcnt vmcnt(0)" ::: "memory");
        } else {
            XB_SPIN(xb_ld(&bar[XB_XGEN(b.x)]) == gen, bar);
            __builtin_amdgcn_fence(__ATOMIC_ACQUIRE, "agent");
            asm volatile("s_waitcnt vmcnt(0)" ::: "memory");
        }
    }
    __syncthreads();
}

#ifndef PH_MAX
#define PH_MAX 99
#endif
#ifndef P3_TTILES
#define P3_TTILES 512
#endif
#ifndef PROBE_PH
#define PROBE_PH 0
#endif
#ifndef REPEAT_PH
#define REPEAT_PH 0
#endif
#define REP(k) for (int rep_ = 0; rep_ < ((REPEAT_PH == (k)) ? 2 : 1); ++rep_)
__global__ void __launch_bounds__(NTHR) fwd_mega(Args args) {
    extern __shared__ __attribute__((aligned(16))) unsigned char lds_raw[];
    cg::grid_group grid = cg::this_grid();
    Frame F;
    F.lds = (LAS unsigned char*)lds_raw; F.tid = threadIdx.x; F.lane = F.tid & 63; F.wave = __builtin_amdgcn_readfirstlane(F.tid >> 6); F.G = gridDim.x; F.bid = blockIdx.x;
    F.x = args.in[0]; F.g_mix = args.in[1]; F.w_in = args.in[2]; F.pos_k = args.in[3]; F.w1_k = args.in[4]; F.w2_k = args.in[5]; F.pos_v = args.in[6]; F.w1_v = args.in[7]; F.w2_v = args.in[8];
    F.w_a = args.in[9]; F.w_b = args.in[10]; F.w_out = args.in[11]; F.g_mlp = args.in[12]; F.w_up = args.in[13]; F.w_down = args.in[14]; F.g_fin = args.in[15];
    F.out = args.out; F.ws = args.ws;
    unsigned char* ws = args.ws;
    PG8_LAS unsigned char* glds = (PG8_LAS unsigned char*)lds_raw;
    volatile LAS unsigned* xst = (volatile LAS unsigned*)(F.lds + LDS_BYTES - 16);
    if (F.tid < 4) xst[F.tid] = 0u;
    __syncthreads();
    XcdBarrier xbar = xcd_barrier_post((unsigned*)ws, xst);
    if (args.ws == nullptr) grid.sync();
    const int gw = F.bid * 8 + F.wave, NGW = F.G * 8;

#if PROBE_PH
    unsigned long long stamp_[16]; int ns_ = 1; stamp_[0] = __builtin_amdgcn_s_memrealtime();
#endif
    REP(9) p0_prologue(F);
#if REPEAT_PH == 10
    for (int q_ = 0; q_ < 10; ++q_) grid.sync();
#endif
    xcd_barrier(xbar);
#if PROBE_PH
    stamp_[ns_ < 15 ? ns_ : 15] = __builtin_amdgcn_s_memrealtime(); ++ns_;
#endif
    asm volatile("" : "+v"(F.tid), "+v"(F.lane));
    if (PH_MAX >= 1) REP(1) {
        pg8::Gemm gm{F.U(), F.WIN(), TOK, NIN, DM}; pg8::StaticOrder S; S.init(TOK, NIN, F.G, F.bid);
        pg8::EpiInProj E{F.QKVA(), F.QB(), F.KVB(), F.GM(), F.GB(), F.CS()};
        pg8::gemm_phase<pg8::EpiInProj, pg8::StaticOrder, true, true>(glds, gm, S, E);
    }
    xcd_barrier(xbar);
#if PROBE_PH
    stamp_[ns_ < 15 ? ns_ : 15] = __builtin_amdgcn_s_memrealtime(); ++ns_;
#endif
    asm volatile("" : "+v"(F.tid), "+v"(F.lane));
    if (PH_MAX >= 2) REP(2) {
        unsigned* qctr = (unsigned*)ws + 3520 + 64 * rep_;
        volatile LAS int* qslot = (volatile LAS int*)(F.lds + LDS_BYTES - 8);
        for (;;) {
            if (F.tid == 0) *qslot = (int)__hip_atomic_fetch_add(qctr, 1u, __ATOMIC_RELAXED, __HIP_MEMORY_SCOPE_AGENT);
            __syncthreads();
            const int task = *qslot;
            __syncthreads();
            if (task >= 1600 + 128) break;
            if (task < 64) compress_task(F, task);
            else if (task < 1600) mixa_task(F, task - 64);
            else { int r = task - 1600;
                if (!ttile_job(r, F.w_a, 1024, 0, 1024, 512, F.WA(), 0, F.lds, F.tid)) if (!ttile_job(r, F.w_b, 1024, 0, 1024, 512, F.WB(), 0, F.lds, F.tid)) ttile_job(r, F.w_out, 1024, 0, 1024, 1024, F.WO(), 0, F.lds, F.tid); }
        }
    }
    xcd_barrier(xbar);
#if PROBE_PH
    stamp_[ns_ < 15 ? ns_ : 15] = __builtin_amdgcn_s_memrealtime(); ++ns_;
#endif
    asm volatile("" : "+v"(F.tid), "+v"(F.lane));
    if (PH_MAX >= 3) REP(3) {
        unsigned* qctr = (unsigned*)ws + 3520 + 128 + 64 * rep_;
        volatile LAS int* qslot = (volatile LAS int*)(F.lds + LDS_BYTES - 8);
        for (;;) {
            if (F.tid == 0) *qslot = (int)__hip_atomic_fetch_add(qctr, 1u, __ATOMIC_RELAXED, __HIP_MEMORY_SCOPE_AGENT);
            __syncthreads();
            const int task = *qslot;
            __syncthreads();
            if (task >= 512 + 256 + P3_TTILES) break;
            if (task < 512) { const int bg = task & 3; nsa_task(F, bg >> 1, bg & 1, 127 - (task >> 2)); }
            else if (task < 768) combine_ya_task(F, task - 512);
            else { int r = task - 768;
                if (!ttile_job(r, F.w_up, 4096, 0, 4096, DM, F.WUP(), 0, F.lds, F.tid)) ttile_job(r, F.w_down, 1024, 0, 1024, FF, F.WDN(), 0, F.lds, F.tid); }
        }
    }
    xcd_barrier(xbar);
#if PROBE_PH
    stamp_[ns_ < 15 ? ns_ : 15] = __builtin_amdgcn_s_memrealtime(); ++ns_;
#endif
    asm volatile("" : "+v"(F.tid), "+v"(F.lane));
    if (PH_MAX >= 4) REP(4) {
        pg8::StaticOrder S; S.init(TOK, DM, F.G, F.bid);
        { pg8::Gemm gm{F.YA(), F.WA(), TOK, DM, 512}; pg8::EpiMerge<1> E{F.GM(), F.TMP(), F.MERGED()}; pg8::gemm_phase<pg8::EpiMerge<1>, pg8::StaticOrder, true, true>(glds, gm, S, E); }
        { pg8::Gemm gm{F.YB(), F.WB(), TOK, DM, 512}; pg8::EpiMerge<2> E{F.GM(), F.TMP(), F.MERGED()}; pg8::gemm_phase<pg8::EpiMerge<2>, pg8::StaticOrder, true, true>(glds, gm, S, E); }
    }
    xcd_barrier(xbar);
#if PROBE_PH
    stamp_[ns_ < 15 ? ns_ : 15] = __builtin_amdgcn_s_memrealtime(); ++ns_;
#endif
    asm volatile("" : "+v"(F.tid), "+v"(F.lane));
    if (PH_MAX >= 5) REP(5) {
        pg8::StaticOrder S; S.init(TOK, DM, F.G, F.bid);
        pg8::Gemm gm{F.MERGED(), F.WO(), TOK, DM, DM}; pg8::EpiResNormPrep E{F.x, F.X1B(), F.U(), F.g_mlp, F.SSP()}; pg8::gemm_phase<pg8::EpiResNormPrep, pg8::StaticOrder, true, true>(glds, gm, S, E);
    }
    xcd_barrier(xbar);
#if PROBE_PH
    stamp_[ns_ < 15 ? ns_ : 15] = __builtin_amdgcn_s_memrealtime(); ++ns_;
#endif
    asm volatile("" : "+v"(F.tid), "+v"(F.lane));
    if (PH_MAX >= 7) REP(7) {
        pg8::StaticOrder S; S.init(TOK, FF, F.G, F.bid);
        pg8::Gemm gm{F.U(), F.WUP(), TOK, FF, DM}; pg8::EpiRelu2 E{F.H(), FF, F.SSP()}; pg8::gemm_phase<pg8::EpiRelu2, pg8::StaticOrder, true, true>(glds, gm, S, E);
    }
    xcd_barrier(xbar);
#if PROBE_PH
    stamp_[ns_ < 15 ? ns_ : 15] = __builtin_amdgcn_s_memrealtime(); ++ns_;
#endif
    asm volatile("" : "+v"(F.tid), "+v"(F.lane));
    if (PH_MAX >= 8) REP(8) {
        pg8::StaticOrder S; S.init(TOK, DM, F.G, F.bid);
        pg8::Gemm gm{F.H(), F.WDN(), TOK, DM, FF}; pg8::EpiResBf16In E{F.X1B(), F.U(), DM}; pg8::gemm_phase<pg8::EpiResBf16In, pg8::StaticOrder, true, true>(glds, gm, S, E);
    }
    xcd_barrier(xbar);
#if PROBE_PH
    stamp_[ns_ < 15 ? ns_ : 15] = __builtin_amdgcn_s_memrealtime(); ++ns_;
#endif
    asm volatile("" : "+v"(F.tid), "+v"(F.lane));
    for (int m = gw; m < TOK; m += NGW) rms_row_bf16_to_f32(F.U() + (size_t)m * DM, F.g_fin, F.out + (size_t)m * DM, F.lane);
#if PROBE_PH
    xcd_barrier(xbar);
    stamp_[ns_ < 15 ? ns_ : 15] = __builtin_amdgcn_s_memrealtime();
    if (F.bid == 0 && F.tid == 0) { const float us_ = (float)(unsigned)(stamp_[PROBE_PH] - stamp_[PROBE_PH - 1]) * 0.01f; F.out[0] = 1000.f * __builtin_amdgcn_exp2f(__builtin_rintf(6.f * __builtin_amdgcn_logf(us_)) * (1.f / 6.f)); }
#endif
}

extern "C" void kernel_launch(void* const* d_in, const int* in_sizes, int n_in, void* d_out, int out_size, void* d_ws, size_t ws_size, hipStream_t stream) {
    static int grid = 0;
    if (grid == 0) {
        if (n_in != 16 || out_size != TOK * DM || ws_size < WS_END) { fprintf(stderr, "kernel_launch: unexpected shapes (n_in %d out %d ws %zu)\n", n_in, out_size, ws_size); grid = -1; return; }
        int dev = 0, cus = 0, per_cu = 0;
        hipGetDevice(&dev); hipDeviceGetAttribute(&cus, hipDeviceAttributeMultiprocessorCount, dev);
        hipFuncSetAttribute((const void*)fwd_mega, hipFuncAttributeMaxDynamicSharedMemorySize, LDS_BYTES);
        if (hipOccupancyMaxActiveBlocksPerMultiprocessor(&per_cu, (const void*)fwd_mega, NTHR, LDS_BYTES) != hipSuccess || per_cu < 1) { fprintf(stderr, "kernel_launch: occupancy query gave %d\n", per_cu); per_cu = 1; }
        (void)hipGetLastError();
        grid = cus * 1;
    }
    if (grid < 0) return;
    if (hipMemsetAsync(d_ws, 0, 16384, stream) != hipSuccess) { fprintf(stderr, "kernel_launch: memset of barrier words failed\n"); return; }
    Args a{};
    for (int i = 0; i < 16; ++i) a.in[i] = (const float*)d_in[i];
    a.out = (float*)d_out; a.ws = (unsigned char*)d_ws;
    void* kargs[] = {&a};
    hipError_t e = hipLaunchCooperativeKernel((const void*)fwd_mega, dim3(grid), dim3(NTHR), kargs, LDS_BYTES, stream);
    if (e != hipSuccess) fprintf(stderr, "cooperative launch failed: %s (grid %d)\n", hipGetErrorString(e), grid);
}
```
